# Optimizing an MI355X kernel written in HIP

```python
import jax, jax.numpy as jnp
from jax import lax
import numpy as np

D_MODEL = 2048
BATCH = 2
SEQ = 16384
DEPTH = 2

CTX_LEN = 256
GRID_W = 64
EPS = 1e-6
N_MOD = 9
D_FF = 5632
HEAD_DIM = 128
ATTN_HEADS = 8
ATTN_KV_HEADS = 2
Q_BLOCK = 128
ROPE_THETA = 10000.0
GLA_HEADS = 4
GLA_DK = 64
GLA_DV = 128
GLA_GATE_RANK = 16
GLA_TAU = 16.0
CHUNK = 128
GMLP_GROUPS = 4
GMLP_GROUP_DIM = 128

ATTN_Q_W = ATTN_HEADS * HEAD_DIM
ATTN_KV_W = ATTN_KV_HEADS * HEAD_DIM
GLA_K_W = GLA_HEADS * GLA_DK
GLA_V_W = GLA_HEADS * GLA_DV
GMLP_W = GMLP_GROUPS * GMLP_GROUP_DIM
MIX_W = ATTN_Q_W + GLA_V_W + GMLP_W
IN_SIZES = (ATTN_Q_W, ATTN_KV_W, ATTN_KV_W, GLA_K_W, GLA_K_W, GLA_V_W, GLA_V_W, 2 * GLA_GATE_RANK, GMLP_W, GMLP_W)
IN_W = 4128

kernel_name = "hybrid_prefix_dit_attn_gla_gmlp"


def _rmsnorm(x, g):
    xf = x.astype(jnp.float32)
    y = xf * lax.rsqrt(jnp.mean(xf * xf, axis=-1, keepdims=True) + EPS)
    return (y * g.astype(jnp.float32)).astype(x.dtype)


def _mod_norm(x, mod, i, g):
    shift = mod[:, 3 * i][:, None, :]
    scale = mod[:, 3 * i + 1][:, None, :]
    return _rmsnorm(x, g) * (1.0 + scale) + shift


def _swiglu(h, w_gu, w_down):
    gate, up = jnp.split(h @ w_gu, 2, axis=-1)
    return (jax.nn.silu(gate) * up) @ w_down


def _ffn_sublayer(x, mod, i, g, w_gu, w_down):
    h = _mod_norm(x, mod, i, g)
    return x + mod[:, 3 * i + 2][:, None, :] * (0.5 * _swiglu(h, w_gu, w_down))


def _heads(z, n):
    b, l, w = z.shape
    return z.reshape(b, l, n, w // n).transpose(0, 2, 1, 3)


def _unheads(z):
    b, n, l, d = z.shape
    return z.transpose(0, 2, 1, 3).reshape(b, l, n * d)


def _rope_tables(length):
    rows = length // GRID_W
    row = jnp.repeat(jnp.arange(rows, dtype=jnp.float32), GRID_W)
    col = jnp.broadcast_to(jnp.arange(GRID_W, dtype=jnp.float32), (rows, GRID_W)).reshape(-1)
    nf = HEAD_DIM // 4
    inv = ROPE_THETA ** (-jnp.arange(nf, dtype=jnp.float32) / nf)
    ang = jnp.concatenate([row[:, None] * inv, col[:, None] * inv], axis=-1)
    return jnp.cos(ang), jnp.sin(ang)


def _apply_rope_2d(x, cos, sin):
    nf = HEAD_DIM // 4
    xf = x.astype(jnp.float32)
    x_row, x_col = jnp.split(xf, 2, axis=-1)

    def rot(z, cs, sn):
        z1, z2 = jnp.split(z, 2, axis=-1)
        return jnp.concatenate([z1 * cs - z2 * sn, z1 * sn + z2 * cs], axis=-1)

    out = jnp.concatenate([rot(x_row, cos[:, :nf], sin[:, :nf]), rot(x_col, cos[:, nf:], sin[:, nf:])], axis=-1)
    return out.astype(x.dtype)


def _attend(q, k, v):
    b, hq, lq, dh = q.shape
    hkv = k.shape[1]
    grp = hq // hkv
    nb = lq // Q_BLOCK
    qb = q.reshape(b, hkv, grp, nb, Q_BLOCK, dh).transpose(3, 0, 1, 2, 4, 5)
    scale = dh ** -0.5

    def block(qblk):
        s = jnp.einsum('bkgqd,bksd->bkgqs', qblk, k, preferred_element_type=jnp.float32) * scale
        p = jax.nn.softmax(s, axis=-1)
        return jnp.einsum('bkgqs,bksd->bkgqd', p.astype(v.dtype), v)

    o = lax.map(block, qb)
    return o.transpose(1, 2, 3, 0, 4, 5).reshape(b, hq, lq, dh)


def _gla_scan(q, k, v, g, s0):
    b, h, l, dk = q.shape
    dv = v.shape[-1]
    n = l // CHUNK

    def to_chunks(z):
        return z.astype(jnp.float32).reshape(b, h, n, CHUNK, z.shape[-1]).transpose(2, 0, 1, 3, 4)

    mask = jnp.tril(jnp.ones((CHUNK, CHUNK), dtype=bool))[:, :, None]

    def step(s, inp):
        qc, kc, vc, gc = inp
        bcum = jnp.cumsum(gc, axis=2)
        diff = bcum[:, :, :, None, :] - bcum[:, :, None, :, :]
        decay = jnp.exp(jnp.where(mask, diff, -jnp.inf))
        a = jnp.einsum('bhid,bhjd,bhijd->bhij', qc, kc, decay)
        o = jnp.einsum('bhid,bhde->bhie', qc * jnp.exp(bcum), s) + jnp.einsum('bhij,bhje->bhie', a, vc)
        b_last = bcum[:, :, -1:, :]
        s_new = jnp.exp(b_last[:, :, 0, :])[..., None] * s + jnp.einsum('bhjd,bhje->bhde', kc * jnp.exp(b_last - bcum), vc)
        return s_new, o

    s_fin, o = lax.scan(step, s0, (to_chunks(q), to_chunks(k), to_chunks(v), to_chunks(g)))
    o = o.transpose(1, 2, 0, 3, 4).reshape(b, h, l, dv)
    return o.astype(v.dtype), s_fin


def _gla_bidir(q, k, v, g_fwd, g_bwd, s0_fwd, s0_bwd):
    o_f, s_f = _gla_scan(q, k, v, g_fwd, s0_fwd)
    flip = lambda z: jnp.flip(z, axis=2)
    o_b, s_b = _gla_scan(flip(q), flip(k), flip(v), flip(g_bwd), s0_bwd)
    return o_f + flip(o_b), s_f, s_b


def _stream_features(h, w_in, qk_g, gate_w, gate_b, rope):
    offs = np.cumsum(IN_SIZES)[:-1].tolist()
    aq, ak, av, gq, gk, gv, gr, glr, mu, mv = jnp.split(h @ w_in, offs, axis=-1)
    q = _rmsnorm(_heads(aq, ATTN_HEADS), qk_g[0])
    k = _rmsnorm(_heads(ak, ATTN_KV_HEADS), qk_g[1])
    if rope is not None:
        q = _apply_rope_2d(q, rope[0], rope[1])
        k = _apply_rope_2d(k, rope[0], rope[1])
    lr_f, lr_b = jnp.split(glr, 2, axis=-1)

    def log_decay(lr, i):
        logits = (lr @ gate_w[i] + gate_b[i]).astype(jnp.float32)
        return _heads(jax.nn.log_sigmoid(logits) / GLA_TAU, GLA_HEADS)

    return {
        "q": q, "k": k, "v": _heads(av, ATTN_KV_HEADS),
        "gq": _heads(gq, GLA_HEADS) * (GLA_DK ** -0.5), "gk": _heads(gk, GLA_HEADS), "gv": _heads(gv, GLA_HEADS),
        "gr": gr, "gf": log_decay(lr_f, 0), "gb": log_decay(lr_b, 1),
        "mu": mu, "mv": mv,
    }


def _gla_out(o, r, g):
    ot = o.transpose(0, 2, 1, 3)
    on = _rmsnorm(ot, g.reshape(GLA_HEADS, GLA_DV))
    b, l = on.shape[:2]
    return on.reshape(b, l, GLA_V_W) * jax.nn.silu(r)


def _chunk_gmlp(u, v, w_s, b_s, g):
    b, l, _ = u.shape
    n = l // CHUNK
    vn = _rmsnorm(v, g).reshape(b, n, CHUNK, GMLP_GROUPS, GMLP_GROUP_DIM)
    z = jnp.einsum('gij,bnjgc->bnigc', w_s, vn) + b_s.T[:, :, None]
    return u * z.reshape(b, l, GMLP_W)


def _token_mixing(h_lat, h_ctx, w_in, w_out, qk_g, gate_w, gate_b, gla_g, w_s, b_s, gm_g, rope, want_ctx):
    fl = _stream_features(h_lat, w_in, qk_g, gate_w, gate_b, rope)
    fc = _stream_features(h_ctx, w_in, qk_g, gate_w, gate_b, None)
    att_l = _attend(fl["q"], jnp.concatenate([fc["k"], fl["k"]], axis=2), jnp.concatenate([fc["v"], fl["v"]], axis=2))
    bsz = h_ctx.shape[0]
    s0 = jnp.zeros((bsz, GLA_HEADS, GLA_DK, GLA_DV), jnp.float32)
    o_c, s_f, s_b = _gla_bidir(fc["gq"], fc["gk"], fc["gv"], fc["gf"], fc["gb"], s0, s0)
    o_l, _, _ = _gla_bidir(fl["gq"], fl["gk"], fl["gv"], fl["gf"], fl["gb"], s_f, s_b)
    y_l = jnp.concatenate([_unheads(att_l), _gla_out(o_l, fl["gr"], gla_g),
                           _chunk_gmlp(fl["mu"], fl["mv"], w_s, b_s, gm_g)], axis=-1) @ w_out
    y_c = None
    if want_ctx:
        att_c = _attend(fc["q"], fc["k"], fc["v"])
        y_c = jnp.concatenate([_unheads(att_c), _gla_out(o_c, fc["gr"], gla_g),
                               _chunk_gmlp(fc["mu"], fc["mv"], w_s, b_s, gm_g)], axis=-1) @ w_out
    return y_l, y_c


def setup_inputs(seed: int = 0) -> dict:
    key = jax.random.key(seed)
    ks = jax.random.split(key, 24)
    D = D_MODEL

    def nrm(k, shape, scale):
        return jax.random.normal(k, shape, jnp.float32) * scale

    return {
        "x": nrm(ks[0], (BATCH, SEQ, D), 1.0),
        "c": nrm(ks[1], (BATCH, D), 1.0),
        "ctx": nrm(ks[2], (BATCH, CTX_LEN, D), 1.0),
        "c_ctx": nrm(ks[3], (D,), 1.0),
        "mod_w": nrm(ks[4], (DEPTH, D, N_MOD * D), 0.5 * D ** -0.5),
        "mod_b": nrm(ks[5], (DEPTH, N_MOD * D), 0.02),
        "norm_g": 1.0 + nrm(ks[6], (DEPTH, 3, D), 0.02),
        "ffn1_w_gu": nrm(ks[7], (DEPTH, D, 2 * D_FF), D ** -0.5),
        "ffn1_w_down": nrm(ks[8], (DEPTH, D_FF, D), D_FF ** -0.5),
        "ffn2_w_gu": nrm(ks[9], (DEPTH, D, 2 * D_FF), D ** -0.5),
        "ffn2_w_down": nrm(ks[10], (DEPTH, D_FF, D), D_FF ** -0.5),
        "w_in": nrm(ks[11], (DEPTH, D, IN_W), D ** -0.5),
        "w_out": nrm(ks[12], (DEPTH, MIX_W, D), MIX_W ** -0.5),
        "qk_norm_g": 1.0 + nrm(ks[13], (DEPTH, 2, HEAD_DIM), 0.02),
        "gla_gate_w": nrm(ks[14], (DEPTH, 2, GLA_GATE_RANK, GLA_K_W), GLA_GATE_RANK ** -0.5),
        "gla_gate_b": 1.0 + nrm(ks[15], (DEPTH, 2, GLA_K_W), 0.1),
        "gla_norm_g": 1.0 + nrm(ks[16], (DEPTH, GLA_V_W), 0.02),
        "gmlp_w_s": nrm(ks[17], (DEPTH, GMLP_GROUPS, CHUNK, CHUNK), 0.5 * CHUNK ** -0.5),
        "gmlp_b_s": 1.0 + nrm(ks[18], (DEPTH, GMLP_GROUPS, CHUNK), 0.02),
        "gmlp_norm_g": 1.0 + nrm(ks[19], (DEPTH, GMLP_W), 0.02),
        "final_norm_g": 1.0 + nrm(ks[20], (D,), 0.02),
    }


def reference(x, c, ctx, c_ctx, mod_w, mod_b, norm_g, ffn1_w_gu, ffn1_w_down, ffn2_w_gu, ffn2_w_down,
              w_in, w_out, qk_norm_g, gla_gate_w, gla_gate_b, gla_norm_g, gmlp_w_s, gmlp_b_s, gmlp_norm_g,
              final_norm_g):
    length = x.shape[1]
    rope = _rope_tables(length)
    sc = jax.nn.silu(c)
    scc = jax.nn.silu(c_ctx)
    xl, xc = x, ctx
    for l in range(DEPTH):
        last = l == DEPTH - 1
        mod_l = (sc @ mod_w[l] + mod_b[l]).reshape(-1, N_MOD, D_MODEL)
        mod_c = (scc @ mod_w[l] + mod_b[l]).reshape(1, N_MOD, D_MODEL)
        xl = _ffn_sublayer(xl, mod_l, 0, norm_g[l, 0], ffn1_w_gu[l], ffn1_w_down[l])
        xc = _ffn_sublayer(xc, mod_c, 0, norm_g[l, 0], ffn1_w_gu[l], ffn1_w_down[l])
        hl = _mod_norm(xl, mod_l, 1, norm_g[l, 1])
        hc = _mod_norm(xc, mod_c, 1, norm_g[l, 1])
        yl, yc = _token_mixing(hl, hc, w_in[l], w_out[l], qk_norm_g[l], gla_gate_w[l], gla_gate_b[l],
                               gla_norm_g[l], gmlp_w_s[l], gmlp_b_s[l], gmlp_norm_g[l], rope, not last)
        xl = xl + mod_l[:, 5][:, None, :] * yl
        xl = _ffn_sublayer(xl, mod_l, 2, norm_g[l, 2], ffn2_w_gu[l], ffn2_w_down[l])
        if not last:
            xc = xc + mod_c[:, 5][:, None, :] * yc
            xc = _ffn_sublayer(xc, mod_c, 2, norm_g[l, 2], ffn2_w_gu[l], ffn2_w_down[l])
    return _rmsnorm(xl, final_norm_g)
```

```cpp
#include <hip/hip_runtime.h>
#include <cstdio>
#include <cstdint>
#include <cmath>
namespace pg8 {
#define PG8_LAS __attribute__((address_space(3)))
typedef unsigned short bf16_t;
typedef short bf16x8 __attribute__((ext_vector_type(8)));
typedef float f32x4 __attribute__((ext_vector_type(4)));
typedef unsigned u32x4 __attribute__((ext_vector_type(4)));
constexpr int BM = 256, BK = 64, HALF = 128, HTB = HALF * BK * 2  , STAGE_BYTES = 8 * HTB, NXCD = 8, WGM = 8;

__host__ __device__ __forceinline__ int lds_byte(int r, int c) { const int st = (r >> 4) * 2 + (c >> 5), rr = r & 15, cc = c & 31, ob = rr * 64 + cc * 2; return st * 1024 + (ob ^ (((ob >> 9) & 1) << 5)); }
__host__ __device__ __forceinline__ void stage_rc(int b, int& R, int& C) { const int st = b / 1024, sb = b % 1024, swz = sb ^ (((sb >> 9) & 1) << 5); R = (st >> 1) * 16 + swz / 64; C = (st & 1) * 32 + (swz % 64) / 2; }
__host__ __device__ __forceinline__ int perm32(int rho) { const int n = rho >> 4, i = rho & 15; return 8 * (i >> 2) + 4 * n + (i & 3); }

struct Unit { int pm, pn; };
struct Gemm { const bf16_t* A; const bf16_t* Bt; int M, N, K; };

struct StaticOrder {
    int nM, nN, nwg, G, c;
    __host__ __device__ void init(int M, int N, int G_, int c_) { nM = M / BM; nN = N / BM; nwg = nM * nN; G = G_; c = c_; }
    __host__ __device__ bool next(int i, Unit& u) const {
        const long L = (long)i * G + c; if (L >= nwg) return false;
        int wgid = (int)L; { const int q = nwg / NXCD, r = nwg % NXCD, xcd = wgid % NXCD, off = wgid / NXCD; wgid = (xcd < r ? xcd * (q + 1) : r * (q + 1) + (xcd - r) * q) + off; }
        const int nig = WGM * nN, gid = wgid / nig, fm = gid * WGM, gsz = (nM - fm) < WGM ? (nM - fm) : WGM;
        u.pm = fm + ((wgid % nig) % gsz); u.pn = (wgid % nig) / gsz; return true;
    }
    __device__ __forceinline__ void a_ready(const Unit&) const {}
    __device__ __forceinline__ void done(const Unit&) const {}
};

typedef float f32x2c_t __attribute__((ext_vector_type(2))); typedef __bf16 bf16x2c_t __attribute__((ext_vector_type(2)));
__device__ __forceinline__ unsigned cvt_pk_bf16(float lo, float hi) { f32x2c_t v = {lo, hi}; bf16x2c_t b = __builtin_convertvector(v, bf16x2c_t); return __builtin_bit_cast(unsigned, b); }
typedef float f32x2 __attribute__((ext_vector_type(2)));
constexpr int PAN_PER_B = 65, RES_LD = 2048;
__device__ __forceinline__ int panel_set(int pm) { const int b = pm / PAN_PER_B, jp = pm - b * PAN_PER_B; return jp == 0 ? 2 : b; }
template <class T> __device__ __forceinline__ T* panel_ptr(T* lat, T* ctx, int pm) {
    const int b = pm / PAN_PER_B, jp = pm - b * PAN_PER_B;
    return jp == 0 ? ctx + (size_t)b * 256 * RES_LD : lat + ((size_t)b * 16384 + (size_t)(jp - 1) * 256) * RES_LD;
}
struct PanelOrder {
    int nM, nN, nwg, G, c, skip;
    __device__ void init(int nM_, int nN_, int G_, int c_, int skip_) { nM = nM_; nN = nN_; nwg = nM * nN; G = G_; c = c_; skip = skip_; }
    __device__ bool next(int i, Unit& u) const {
        const long L = (long)i * G + c; if (L >= nwg) return false;
        int wgid = (int)L; { const int q = nwg / NXCD, r = nwg % NXCD, xcd = wgid % NXCD, off = wgid / NXCD; wgid = (xcd < r ? xcd * (q + 1) : r * (q + 1) + (xcd - r) * q) + off; }
        const int nig = WGM * nN, gid = wgid / nig, fm = gid * WGM, gsz = (nM - fm) < WGM ? (nM - fm) : WGM;
        int pm = fm + ((wgid % nig) % gsz); u.pn = (wgid % nig) / gsz;
        if (skip) pm += 1 + (pm >= 64 ? 1 : 0);
        u.pm = pm; return true;
    }
    __device__ __forceinline__ void a_ready(const Unit&) const {}
    __device__ __forceinline__ void done(const Unit&) const {}
};
struct EpiBf16Plain {
    static constexpr bool PERM = true, AFTER_DRAIN = false;
    bf16_t* O; int ldc;
    __device__ __forceinline__ void operator()(const f32x4 (&acc)[2][2][4][2], const Unit& u, int wr, int wc, int fr, int fq) const {
        const int row0 = u.pm * BM + wr * 64 + fr, col0 = u.pn * BM + wc * 32 + 8 * fq;
#pragma unroll
        for (int ai = 0; ai < 2; ++ai)
#pragma unroll
            for (int m = 0; m < 4; ++m) { bf16_t* rowp = O + (size_t)(row0 + ai * HALF + m * 16) * ldc + col0;
#pragma unroll
                for (int bj = 0; bj < 2; ++bj) { const f32x4 v0 = acc[ai][bj][m][0], v1 = acc[ai][bj][m][1];
                    u32x4 w; w.x = cvt_pk_bf16(v0[0], v0[1]); w.y = cvt_pk_bf16(v0[2], v0[3]); w.z = cvt_pk_bf16(v1[0], v1[1]); w.w = cvt_pk_bf16(v1[2], v1[3]);
                    *(u32x4*)(rowp + bj * HALF) = w; } }
    }
};
__device__ __forceinline__ float silu_f(float g) { return g * __builtin_amdgcn_rcpf(1.0f + __builtin_amdgcn_exp2f(-1.4426950408889634f * g)); }
struct EpiSwiglu {
    static constexpr bool PERM = true, AFTER_DRAIN = false;
    bf16_t* H; int ldh;
    __device__ __forceinline__ void operator()(const f32x4 (&acc)[2][2][4][2], const Unit& u, int wr, int wc, int fr, int fq) const {
        const int row0 = u.pm * BM + wr * 64 + fr, col0 = u.pn * HALF + wc * 32 + 8 * fq;
#pragma unroll
        for (int ai = 0; ai < 2; ++ai)
#pragma unroll
            for (int m = 0; m < 4; ++m) { bf16_t* rowp = H + (size_t)(row0 + ai * HALF + m * 16) * ldh + col0;
                const f32x4 g0 = acc[ai][0][m][0], g1 = acc[ai][0][m][1], u0 = acc[ai][1][m][0], u1 = acc[ai][1][m][1];
                u32x4 w; w.x = cvt_pk_bf16(silu_f(g0[0]) * u0[0], silu_f(g0[1]) * u0[1]); w.y = cvt_pk_bf16(silu_f(g0[2]) * u0[2], silu_f(g0[3]) * u0[3]);
                w.z = cvt_pk_bf16(silu_f(g1[0]) * u1[0], silu_f(g1[1]) * u1[1]); w.w = cvt_pk_bf16(silu_f(g1[2]) * u1[2], silu_f(g1[3]) * u1[3]);
                *(u32x4*)rowp = w; }
    }
};
struct EpiResid {
    static constexpr bool PERM = false, AFTER_DRAIN = false;
    const float* base_lat; const float* base_ctx; float* out_lat; float* out_ctx; const float* gate  ; int gidx; float scale;
    __device__ __forceinline__ void operator()(const f32x4 (&acc)[2][2][4][2], const Unit& u, int wr, int wc, int fr, int fq) const {
        const int col0 = u.pn * BM + wc * 32 + 4 * fq, set = panel_set(u.pm);
        const float* base = panel_ptr(base_lat, base_ctx, u.pm); float* out = panel_ptr(out_lat, out_ctx, u.pm);
        const float* gp = gate + (size_t)(set * 9 + gidx) * 2048 + col0;
        f32x4 gv[2][2];
#pragma unroll
        for (int bj = 0; bj < 2; ++bj)
#pragma unroll
            for (int n = 0; n < 2; ++n) gv[bj][n] = *(const f32x4*)(gp + bj * HALF + n * 16) * scale;
#pragma unroll
        for (int ai = 0; ai < 2; ++ai)
#pragma unroll
            for (int m = 0; m < 4; ++m) { const size_t off = (size_t)(ai * HALF + wr * 64 + m * 16 + fr) * RES_LD + col0;
#pragma unroll
                for (int bj = 0; bj < 2; ++bj)
#pragma unroll
                    for (int n = 0; n < 2; ++n) { const f32x4 bs = *(const f32x4*)(base + off + bj * HALF + n * 16);
                        *(f32x4*)(out + off + bj * HALF + n * 16) = bs + gv[bj][n] * acc[ai][bj][m][n]; }
                asm volatile("" ::: "memory"); }
    }
};
template <class Epi, class Sched, bool ALIGN_EPI = false, bool SP2 = false>
__device__ __forceinline__ void gemm_phase(PG8_LAS unsigned char* lds, const Gemm g, const Sched& S, const Epi& E) {
    int tid_ = threadIdx.x; asm volatile("" : "+v"(tid_));
    const int tid = tid_, wid = __builtin_amdgcn_readfirstlane(tid >> 6), lane = tid & 63, wr = wid >> 2, wc = wid & 3, fr = lane & 15, fq = lane >> 4;
    const int K = g.K, nt = K / BK;
    unsigned voffA[2], voffB[2];
#pragma unroll
    for (int i = 0; i < 2; ++i) { int R, C; stage_rc(tid * 16 + i * 8192, R, C); const int Rb = Epi::PERM ? ((R & ~31) + perm32(R & 31)) : R;
        voffA[i] = (unsigned)(R * K + C) * 2u; voffB[i] = (unsigned)(Rb * K + C) * 2u; }
    const size_t kstep = (size_t)(BK * 2);
    const size_t hstep = (size_t)HALF * K * 2;
    const size_t tstep = 2 * hstep;
    const unsigned ldsw = (unsigned)wid * 1024u;
    const int aoff = lds_byte(wr * 64 + fr, fq * 8), boff = lds_byte(wc * 32 + fr, fq * 8);
#define PG8_SA(b, h) (((b) * 2 + (h)) * HTB)
#define PG8_SB(b, h) ((4 + (b) * 2 + (h)) * HTB)
#define PG8_STAGE(bufoff, gbase, voff) do { _Pragma("unroll") for (int _i = 0; _i < 2; ++_i) \
        __builtin_amdgcn_global_load_lds((const unsigned*)((const char*)(gbase) + (voff)[_i]), (PG8_LAS unsigned*)(lds + (bufoff) + ldsw + _i * 8192), 16, 0, 0); } while (0)
#define PG8_LDA(dst, b, h) do { _Pragma("unroll") for (int m = 0; m < 4; ++m) _Pragma("unroll") for (int k = 0; k < 2; ++k) dst[m][k] = *(const PG8_LAS bf16x8*)(lds + PG8_SA(b, h) + aoff + m * 2048 + k * 1024); } while (0)
#define PG8_LDB(dst, b, h) do { _Pragma("unroll") for (int n = 0; n < 2; ++n) _Pragma("unroll") for (int k = 0; k < 2; ++k) dst[n][k] = *(const PG8_LAS bf16x8*)(lds + PG8_SB(b, h) + boff + n * 2048 + k * 1024); } while (0)
#define PG8_MMA(ai, bj, At, Bt) do { __builtin_amdgcn_s_setprio(1); _Pragma("unroll") for (int m = 0; m < 4; ++m) _Pragma("unroll") for (int n = 0; n < 2; ++n) _Pragma("unroll") for (int k = 0; k < 2; ++k) \
        acc[ai][bj][m][n] = __builtin_amdgcn_mfma_f32_16x16x32_bf16(Bt[n][k], At[m][k], acc[ai][bj][m][n], 0, 0, 0); __builtin_amdgcn_s_setprio(0); } while (0)
#define PG8_WAIT_V(n) asm volatile("s_waitcnt vmcnt(" #n ")" ::: "memory")
#define PG8_WAIT_L(n) asm volatile("s_waitcnt lgkmcnt(" #n ")" ::: "memory")
#define PG8_BAR __builtin_amdgcn_s_barrier()
#define PG8_SCHED __builtin_amdgcn_sched_barrier(0)
    Unit cur, nxt; int ui = 0;
    if (!S.next(0, cur)) return;
    f32x4 acc[2][2][4][2];
#pragma unroll
    for (int a = 0; a < 2; ++a)
#pragma unroll
        for (int b = 0; b < 2; ++b)
#pragma unroll
            for (int m = 0; m < 4; ++m)
#pragma unroll
                for (int n = 0; n < 2; ++n) acc[a][b][m][n] = (f32x4){0.f, 0.f, 0.f, 0.f};
    bf16x8 At[4][2], B0[2][2], B1[2][2];
    const char* cA = (const char*)g.A + (size_t)cur.pm * tstep; const char* cB = (const char*)g.Bt + (size_t)cur.pn * tstep;
    S.a_ready(cur);
    if constexpr (SP2) {
        PG8_STAGE(PG8_SB(0, 0), cB, voffB); PG8_STAGE(PG8_SB(0, 1), cB + hstep, voffB); PG8_STAGE(PG8_SA(0, 0), cA, voffA); PG8_STAGE(PG8_SA(0, 1), cA + hstep, voffA);
        if (wr == 1) PG8_BAR;
        PG8_WAIT_V(2); PG8_BAR;
        PG8_STAGE(PG8_SB(1, 0), cB + kstep, voffB); PG8_STAGE(PG8_SA(1, 0), cA + kstep, voffA); PG8_STAGE(PG8_SB(1, 1), cB + hstep + kstep, voffB);
        PG8_WAIT_V(6); PG8_BAR;
    } else {
        PG8_STAGE(PG8_SB(0, 0), cB, voffB); PG8_STAGE(PG8_SA(0, 0), cA, voffA); PG8_STAGE(PG8_SB(0, 1), cB + hstep, voffB); PG8_STAGE(PG8_SA(0, 1), cA + hstep, voffA);
        if (wr == 1) PG8_BAR;
        PG8_WAIT_V(4); PG8_BAR;
        PG8_STAGE(PG8_SB(1, 0), cB + kstep, voffB); PG8_STAGE(PG8_SA(1, 0), cA + kstep, voffA); PG8_STAGE(PG8_SB(1, 1), cB + hstep + kstep, voffB);
        PG8_WAIT_V(6); PG8_BAR;
    }
    for (;;) {
        const bool has_next = S.next(ui + 1, nxt);
        const char* nA = has_next ? (const char*)g.A + (size_t)nxt.pm * tstep : cA; const char* nB = has_next ? (const char*)g.Bt + (size_t)nxt.pn * tstep : cB;
        for (int t = 0; t < nt; t += 2) {
            const bool last = (t == nt - 2);
            const char* a1 = cA + (size_t)(t + 1) * kstep;
            const char* a2 = last ? nA : cA + (size_t)(t + 2) * kstep; const char* b2 = last ? nB : cB + (size_t)(t + 2) * kstep;
            const char* a3 = a2 + kstep; const char* b3 = b2 + kstep;
            if (last && has_next) S.a_ready(nxt);
            if constexpr (SP2) {
            PG8_LDB(B0, 0, 0); PG8_LDB(B1, 0, 1); PG8_SCHED; PG8_LDA(At, 0, 0); PG8_STAGE(PG8_SA(1, 1), a1 + hstep, voffA);
            PG8_WAIT_V(8); PG8_WAIT_L(0); PG8_BAR; PG8_MMA(0, 0, At, B0); PG8_MMA(0, 1, At, B1); PG8_BAR; PG8_SCHED;
            PG8_LDA(At, 0, 1); PG8_STAGE(PG8_SB(0, 0), b2, voffB); PG8_STAGE(PG8_SB(0, 1), b2 + hstep, voffB); PG8_STAGE(PG8_SA(0, 0), a2, voffA);
            PG8_WAIT_V(8); PG8_WAIT_L(0); PG8_BAR; PG8_MMA(1, 0, At, B0); PG8_MMA(1, 1, At, B1); PG8_BAR; PG8_SCHED;
            PG8_LDB(B0, 1, 0); PG8_LDB(B1, 1, 1); PG8_SCHED; PG8_LDA(At, 1, 0); PG8_STAGE(PG8_SA(0, 1), a2 + hstep, voffA);
            PG8_WAIT_V(8); PG8_WAIT_L(0); PG8_BAR; PG8_MMA(0, 0, At, B0); PG8_MMA(0, 1, At, B1); PG8_BAR; PG8_SCHED;
            PG8_LDA(At, 1, 1); PG8_STAGE(PG8_SB(1, 0), b3, voffB); PG8_STAGE(PG8_SB(1, 1), b3 + hstep, voffB); PG8_STAGE(PG8_SA(1, 0), a3, voffA);
            PG8_WAIT_V(8); PG8_WAIT_L(0); PG8_BAR; PG8_MMA(1, 0, At, B0); PG8_MMA(1, 1, At, B1); PG8_BAR; PG8_SCHED;
            } else {
            PG8_LDB(B0, 0, 0); PG8_SCHED; PG8_LDA(At, 0, 0); PG8_STAGE(PG8_SA(1, 1), a1 + hstep, voffA);
            PG8_WAIT_L(8); PG8_BAR; PG8_WAIT_L(0); PG8_MMA(0, 0, At, B0); PG8_BAR; PG8_SCHED;
            PG8_LDB(B1, 0, 1); PG8_STAGE(PG8_SB(0, 0), b2, voffB);
            PG8_BAR; PG8_WAIT_L(0); PG8_MMA(0, 1, At, B1); PG8_BAR;
            PG8_LDA(At, 0, 1); PG8_STAGE(PG8_SA(0, 0), a2, voffA);
            PG8_BAR; PG8_WAIT_L(0); PG8_MMA(1, 0, At, B0); PG8_BAR; PG8_SCHED;
            PG8_STAGE(PG8_SB(0, 1), b2 + hstep, voffB);
            PG8_WAIT_V(6); PG8_BAR; PG8_MMA(1, 1, At, B1); PG8_BAR;
            PG8_LDB(B0, 1, 0); PG8_SCHED; PG8_LDA(At, 1, 0); PG8_STAGE(PG8_SA(0, 1), a2 + hstep, voffA);
            PG8_WAIT_L(8); PG8_BAR; PG8_WAIT_L(0); PG8_MMA(0, 0, At, B0); PG8_BAR; PG8_SCHED;
            PG8_LDB(B1, 1, 1); PG8_STAGE(PG8_SB(1, 0), b3, voffB);
            PG8_BAR; PG8_WAIT_L(0); PG8_MMA(0, 1, At, B1); PG8_BAR;
            PG8_LDA(At, 1, 1); PG8_STAGE(PG8_SA(1, 0), a3, voffA);
            PG8_BAR; PG8_WAIT_L(0); PG8_MMA(1, 0, At, B0); PG8_BAR; PG8_SCHED;
            PG8_STAGE(PG8_SB(1, 1), b3 + hstep, voffB);
            PG8_WAIT_V(6); PG8_BAR; PG8_MMA(1, 1, At, B1); PG8_BAR;
            }
        }
        if constexpr (ALIGN_EPI) { if (wr == 0) PG8_BAR; }
        if constexpr (!Epi::AFTER_DRAIN) { E(acc, cur, wr, wc, fr, fq); S.done(cur); }
        if (!has_next) break;
#pragma unroll
        for (int a = 0; a < 2; ++a)
#pragma unroll
            for (int b = 0; b < 2; ++b)
#pragma unroll
                for (int m = 0; m < 4; ++m)
#pragma unroll
                    for (int n = 0; n < 2; ++n) acc[a][b][m][n] = (f32x4){0.f, 0.f, 0.f, 0.f};
        cur = nxt; cA = nA; cB = nB; ++ui;
        if constexpr (ALIGN_EPI) { if (wr == 1) PG8_BAR; }
    }
    PG8_WAIT_V(0);
    if constexpr (!ALIGN_EPI) { if (wr == 0) PG8_BAR; }
    PG8_BAR;
    if constexpr (Epi::AFTER_DRAIN) { E.fused(acc, cur, wr, wc, fr, fq, lds, wid, lane); S.done(cur); }
#undef PG8_SA
#undef PG8_SB
#undef PG8_STAGE
#undef PG8_LDA
#undef PG8_LDB
#undef PG8_MMA
#undef PG8_WAIT_V
#undef PG8_WAIT_L
#undef PG8_BAR
#undef PG8_SCHED
}
}
#define GAS __attribute__((address_space(1)))
#define LAS __attribute__((address_space(3)))
typedef unsigned short bf16;
typedef unsigned v4u __attribute__((ext_vector_type(4)));
typedef float f32x4 __attribute__((ext_vector_type(4)));
typedef short bf16x8 __attribute__((ext_vector_type(8)));
typedef GAS unsigned gu32;
typedef GAS unsigned long long gu64;
#define RLX_AGENT __ATOMIC_RELAXED, __HIP_MEMORY_SCOPE_AGENT
#define LDS_WAIT() asm volatile("s_waitcnt lgkmcnt(0)" ::: "memory")
#define VM_WAIT() asm volatile("s_waitcnt vmcnt(0)" ::: "memory")
__device__ __forceinline__ unsigned long long rt() { return __builtin_amdgcn_s_memrealtime(); }
__device__ __forceinline__ unsigned f2bf(float f) { unsigned u = __builtin_bit_cast(unsigned, f); return (u + 0x7fffu + ((u >> 16) & 1u)) >> 16; }
__device__ __forceinline__ unsigned pk2(float lo, float hi) { return f2bf(lo) | (f2bf(hi) << 16); }

#define XB_TMO      128
#define XB_XCNT(j)  (256  + 64 * (j))
#define XB_XSUB(j)  (1280 + 64 * (j))
#define XB_XGEN(j)  (2304 + 64 * (j))
#define XB_TOP      3328
#define XB_TOPGEN   3392
#define XCD_BAR_WORDS 3456
#define XB_SPIN_CAP (1u << 18)

__device__ __forceinline__ unsigned xb_ld(unsigned* p)              { return __hip_atomic_load(p, __ATOMIC_RELAXED, __HIP_MEMORY_SCOPE_AGENT); }
__device__ __forceinline__ unsigned xb_add(unsigned* p, unsigned v) { return __hip_atomic_fetch_add(p, v, __ATOMIC_RELAXED, __HIP_MEMORY_SCOPE_AGENT); }
__device__ __forceinline__ unsigned xb_xcc_id() { return (unsigned)__builtin_amdgcn_s_getreg((3 << 11) | 20) & 0xFu; }
#define XB_SPIN(cond, bar) do { unsigned _sp = 0; while (cond) { __builtin_amdgcn_s_sleep(1); \
    if ((++_sp & 255u) == 0u) { if (xb_ld(&(bar)[XB_TMO])) break; if (_sp > XB_SPIN_CAP) { atomicAdd(&(bar)[XB_TMO], 1u); break; } } } } while (0)

struct XcdBarrier {
    unsigned* bar; unsigned x;
    volatile LAS unsigned* st;
};

__device__ __forceinline__ XcdBarrier xcd_barrier_post(unsigned* bar, volatile LAS unsigned* st) {
    XcdBarrier b; b.bar = bar; b.x = xb_xcc_id(); b.st = st;
    if (threadIdx.x == 0) (void)xb_add(&bar[XB_XCNT(b.x)], 1u);
    return b;
}
__device__ __forceinline__ void xcd_barrier_complete(unsigned* bar, unsigned x, unsigned& nloc, unsigned& nx) {
    const unsigned G = gridDim.x * gridDim.y * gridDim.z;
    unsigned sum, cnt, mine, sp = 0u;
    for (;;) {
        sum = 0u; cnt = 0u; mine = 0u;
#pragma unroll
        for (unsigned j = 0; j < 16; ++j) { const unsigned c = xb_ld(&bar[XB_XCNT(j)]); sum += c; cnt += (c > 0u) ? 1u : 0u; mine = (j == x) ? c : mine; }
        if (sum == G) break;
        __builtin_amdgcn_s_sleep(1);
        if ((++sp & 255u) == 0u) { if (xb_ld(&bar[XB_TMO])) break; if (sp > XB_SPIN_CAP) { atomicAdd(&bar[XB_TMO], 1u); break; } }
    }
    nloc = mine > 0u ? mine : 1u; nx = cnt > 0u ? cnt : 1u;
}

__device__ __forceinline__ void xcd_barrier(const XcdBarrier& b) {
    asm volatile("s_waitcnt vmcnt(0)" ::: "memory");
    __syncthreads();
    if (threadIdx.x == 0) {
        unsigned* bar = b.bar;
        __builtin_amdgcn_s_waitcnt(0);
        unsigned nloc = b.st[0], nx = b.st[1];
        if (nloc == 0u) { xcd_barrier_complete(bar, b.x, nloc, nx); b.st[0] = nloc; b.st[1] = nx; }
        const unsigned old = xb_add(&bar[XB_XSUB(b.x)], 1u);
        const unsigned gen = old / nloc;
        if (old + 1u == (gen + 1u) * nloc) {
            __builtin_amdgcn_fence(__ATOMIC_RELEASE, "agent");
            asm volatile("s_waitcnt vmcnt(0)" ::: "memory");
            const unsigned og = xb_add(&bar[XB_TOP], 1u);
            const unsigned tg = og / nx;
            if (og + 1u == (tg + 1u) * nx) xb_add(&bar[XB_TOPGEN], 1u);
            else XB_SPIN(xb_ld(&bar[XB_TOPGEN]) == tg, bar);
            __builtin_amdgcn_fence(__ATOMIC_ACQUIRE, "agent");
            xb_add(&bar[XB_XGEN(b.x)], 1u);
            asm volatile("s_waitcnt vmcnt(0)" ::: "memory");
        } else {
            XB_SPIN(xb_ld(&bar[XB_XGEN(b.x)]) == gen, bar);
            __builtin_amdgcn_fence(__ATOMIC_ACQUIRE, "agent");
            asm volatile("s_waitcnt vmcnt(0)" ::: "memory");
        }
    }
    __syncthreads();
}

constexpr int NWAVES = 8;
constexpr int DM = 2048, NB = 2, SEQ = 16384, CTXL = 256, DEPTH = 2, DFF = 5632, NMOD = 9;
constexpr int TOKB = SEQ + CTXL;
constexpr int M_ALL = NB * TOKB;
constexpr int NPAN = M_ALL / 256;
constexpr int NGU = 2 * DFF;
constexpr int NZ = 4352;
constexpr int NW_IN = 4128;
constexpr int CHB = TOKB / 128;
constexpr int NCH = NB * CHB;
constexpr int MODW = NMOD * DM;
constexpr float EPSN = 1e-6f;
constexpr int ZQ = 0, ZK = 1024, ZV = 1280, ZGQ = 1536, ZGK = 1792, ZGV = 2048, ZGR = 2560, ZMU = 3072, ZMV = 3584, ZLR = 4096;
constexpr int MXA = 0, MXG = 1024, MXM = 1536;

constexpr size_t MiB = 1u << 20;
constexpr size_t WS_CTL = 0, CTL_ZERO_BYTES = 64 * 1024;
constexpr size_t WS_MODP = 1 * MiB;
constexpr size_t WS_MOD = 5 * MiB;
constexpr size_t WS_ROPE = 6 * MiB;
constexpr size_t WS_CTXRES = 8 * MiB;
constexpr size_t WS_W = 16 * MiB;
constexpr size_t W_GU1 = 0, W_D1 = 44 * MiB, W_GU2 = 66 * MiB, W_D2 = 110 * MiB, W_IN = 132 * MiB, W_OUT = 149 * MiB, W_LAYER = 157 * MiB;
constexpr size_t WS_XN = 330 * MiB;
constexpr size_t WS_MIX = 460 * MiB;
constexpr size_t WS_H = 590 * MiB;
constexpr size_t WS_Z = WS_H;
constexpr size_t WS_UT = WS_H + 277 * MiB;
constexpr size_t WS_ST = 948 * MiB;
constexpr size_t WS_DV = 981 * MiB;
constexpr size_t WS_QG = 982 * MiB;
constexpr size_t WS_END = 1015 * MiB;
static_assert(WS_UT + (size_t)2080 * 8192 * 4 <= WS_H + (size_t)M_ALL * DFF * 2 + MiB, "UT inside the H overlay (+slack below WS_ST)");
static_assert(WS_H + (size_t)M_ALL * DFF * 2 <= WS_ST && WS_UT + (size_t)2080 * 8192 * 4 <= WS_ST, "d_ws map");
constexpr int CW_TMO = 0, CW_BAR = 4096;

constexpr int RING_OFF = 0, RING_BYTES = 139264;
constexpr int LDSCTL_OFF = RING_BYTES, MISC_OFF = LDSCTL_OFF + 320;
constexpr int LDS_BYTES = 147456;

typedef short s16x4 __attribute__((ext_vector_type(4)));
typedef float f32x16 __attribute__((ext_vector_type(16)));
typedef float f32x8 __attribute__((ext_vector_type(8)));
typedef unsigned u32x2 __attribute__((ext_vector_type(2)));
__device__ __forceinline__ float bf2f(unsigned short x) { return __uint_as_float((unsigned)x << 16); }
__device__ __forceinline__ float bflo(unsigned w) { return __uint_as_float(w << 16); }
__device__ __forceinline__ float bfhi(unsigned w) { return __uint_as_float(w & 0xffff0000u); }
typedef float f32x2_t __attribute__((ext_vector_type(2))); typedef __bf16 bf16x2_t __attribute__((ext_vector_type(2)));
__device__ __forceinline__ unsigned cvtpk(float lo, float hi) { f32x2_t v = {lo, hi}; bf16x2_t b = __builtin_convertvector(v, bf16x2_t); return __builtin_bit_cast(unsigned, b); }
__device__ __forceinline__ float wave_sum(float v) {
#pragma unroll
    for (int o = 1; o < 64; o <<= 1) v += __shfl_xor(v, o);
    return v;
}
__device__ __forceinline__ int crow(int r, int hi) { return (r & 3) + 8 * (r >> 2) + 4 * hi; }
__device__ __forceinline__ float silu_acc(float x) { return x / (1.0f + __expf(-x)); }

struct Frame {
    LAS unsigned char* lds;
    volatile LAS unsigned* MISC;
    gu32* ctl;
    int tid, lane, wave, vcu, G;
};

__device__ __forceinline__ void p0_transpose_item(const float* W, int K, int N, bf16* WT, int k0, int n0, int orow0, LAS float* scr, int lane) {
#pragma unroll 8
    for (int i = 0; i < 32; ++i) { const int kk = 2 * i + (lane >> 5); scr[kk * 33 + (lane & 31)] = W[(size_t)(k0 + kk) * N + n0 + (lane & 31)]; }
    LDS_WAIT(); asm volatile("" ::: "memory");
    const int c = lane & 7;
#pragma unroll
    for (int j = 0; j < 4; ++j) { const int n = (lane >> 3) + 8 * j; const LAS float* s = scr + (8 * c) * 33 + n;
        v4u o; o.x = pk2(s[0 * 33], s[1 * 33]); o.y = pk2(s[2 * 33], s[3 * 33]); o.z = pk2(s[4 * 33], s[5 * 33]); o.w = pk2(s[6 * 33], s[7 * 33]);
        *(GAS v4u*)(WT + (size_t)(orow0 + n) * K + k0 + 8 * c) = o; }
    LDS_WAIT(); asm volatile("" ::: "memory");
}
__device__ __forceinline__ int gu_row(int n0) { return n0 < DFF ? (n0 / 128) * 256 + (n0 % 128) : ((n0 - DFF) / 128) * 256 + 128 + ((n0 - DFF) % 128); }
__device__ __forceinline__ int win_row(int n0) { return n0 < 3072 ? n0 : (n0 < 3104 ? ZLR + (n0 - 3072) : (n0 < 3616 ? ZMU + (n0 - 3104) : ZMV + (n0 - 3616))); }

struct Args { const float* in[21]; float* out; unsigned char* ws; int ph_lo, ph_hi; };

__device__ __forceinline__ void p0_prologue(Frame& F, const Args& a) {
    LAS float* scr = (LAS float*)(F.lds + RING_OFF + F.wave * 16384);
    const int gw = F.vcu * NWAVES + F.wave, NGW = F.G * NWAVES, lane = F.lane;
    unsigned char* ws = a.ws;
    constexpr int I_GU = (DM / 64) * (NGU / 32), I_D = (DFF / 64) * (DM / 32), I_IN = (DM / 64) * (NW_IN / 32), I_OUT = (DM / 64) * (DM / 32);
    constexpr int I_LAYER = 2 * I_GU + 2 * I_D + I_IN + I_OUT;
    for (int it = gw; it < DEPTH * I_LAYER; it += NGW) {
        const int l = it / I_LAYER; int r = it - l * I_LAYER;
        unsigned char* wl = ws + WS_W + (size_t)l * W_LAYER;
        if (r < 2 * I_GU) { const int f = r / I_GU; r -= f * I_GU; const int nblk = NGU / 32, kb = r / nblk, nb = r % nblk;
            p0_transpose_item(a.in[f ? 9 : 7] + (size_t)l * DM * NGU, DM, NGU, (bf16*)(wl + (f ? W_GU2 : W_GU1)), 64 * kb, 32 * nb, gu_row(32 * nb), scr, lane); continue; }
        r -= 2 * I_GU;
        if (r < 2 * I_D) { const int f = r / I_D; r -= f * I_D; const int nblk = DM / 32, kb = r / nblk, nb = r % nblk;
            p0_transpose_item(a.in[f ? 10 : 8] + (size_t)l * DFF * DM, DFF, DM, (bf16*)(wl + (f ? W_D2 : W_D1)), 64 * kb, 32 * nb, 32 * nb, scr, lane); continue; }
        r -= 2 * I_D;
        if (r < I_IN) { const int nblk = NW_IN / 32, kb = r / nblk, nb = r % nblk;
            p0_transpose_item(a.in[11] + (size_t)l * DM * NW_IN, DM, NW_IN, (bf16*)(wl + W_IN), 64 * kb, 32 * nb, win_row(32 * nb), scr, lane); continue; }
        r -= I_IN;
        { const int nblk = DM / 32, kb = r / nblk, nb = r % nblk;
            p0_transpose_item(a.in[12] + (size_t)l * DM * DM, DM, DM, (bf16*)(wl + W_OUT), 64 * kb, 32 * nb, 32 * nb, scr, lane); }
    }
    {
        const int per_layer = (NZ - NW_IN) * DM / 8;
        for (int i = gw * 64 + lane; i < DEPTH * per_layer; i += NGW * 64) { const int l = i / per_layer, r = i - l * per_layer;
            *(GAS v4u*)(ws + WS_W + (size_t)l * W_LAYER + W_IN + (size_t)NW_IN * DM * 2 + (size_t)r * 16) = (v4u){0u, 0u, 0u, 0u}; }
    }
    {
        const float* c = a.in[1]; const float* cctx = a.in[3]; const float* mw = a.in[4];
        float* modp = (float*)(ws + WS_MODP);
        LAS float* sv = scr;
        for (int it = gw; it < DEPTH * 8 * 72; it += NGW) {
            const int l = it / (8 * 72), r = it % (8 * 72), ks = r / 72, nb = r % 72, k0 = ks * 256, n = nb * 256 + lane * 4;
#pragma unroll
            for (int j = 0; j < 4; ++j) { const int k = k0 + lane + 64 * j;
                sv[0 * 256 + lane + 64 * j] = silu_acc(c[k]); sv[1 * 256 + lane + 64 * j] = silu_acc(c[DM + k]); sv[2 * 256 + lane + 64 * j] = silu_acc(cctx[k]); }
            LDS_WAIT(); asm volatile("" ::: "memory");
            f32x4 a0 = {0.f, 0.f, 0.f, 0.f}, a1 = a0, a2 = a0;
            const float* wp = mw + ((size_t)l * DM + k0) * MODW + n;
#pragma unroll 8
            for (int k = 0; k < 256; ++k) { const f32x4 w = *(const f32x4*)(wp + (size_t)k * MODW); a0 += w * sv[k]; a1 += w * sv[256 + k]; a2 += w * sv[512 + k]; }
            float* op = modp + ((size_t)(l * 8 + ks) * 3) * MODW + n;
            *(f32x4*)(op) = a0; *(f32x4*)(op + MODW) = a1; *(f32x4*)(op + 2 * MODW) = a2;
            LDS_WAIT(); asm volatile("" ::: "memory");
        }
    }
    {
        float* rc = (float*)(ws + WS_ROPE); float* rs = rc + 256 * 32;
        for (int i = gw * 64 + lane; i < 256 * 32; i += NGW * 64) { const int p = i >> 5, f = i & 31;
            const double inv = pow(10000.0, -(double)f / 32.0); const double ang = (double)p * inv;
            rc[i] = (float)cos(ang); rs[i] = (float)sin(ang); }
    }
}
__device__ __forceinline__ void p1_modreduce(Frame& F, const Args& a) {
    const float* modp = (const float*)(a.ws + WS_MODP); float* mod = (float*)(a.ws + WS_MOD); const float* mb = a.in[5];
    for (int i = F.vcu * 512 + F.tid; i < DEPTH * 3 * MODW; i += F.G * 512) { const int l = i / (3 * MODW), r = i % (3 * MODW), set = r / MODW, n = r % MODW;
        float s = mb[l * MODW + n];
#pragma unroll
        for (int ks = 0; ks < 8; ++ks) s += modp[((size_t)(l * 8 + ks) * 3 + set) * MODW + n];
        mod[i] = s; }
}

__device__ __forceinline__ void norm_phase(Frame& F, const float* src_lat, const float* src_ctx, const float* g, const float* mod  , int sub, bf16* XN, int skip_ctx) {
    const int gw = F.vcu * NWAVES + F.wave, NGW = F.G * NWAVES, lane = F.lane;
    int cur = -1; f32x4 A[8], B[8];
    for (int row = gw; row < M_ALL; row += NGW) {
        const int b = row / TOKB, j = row - b * TOKB; const bool isctx = j < CTXL;
        if (skip_ctx && isctx) continue;
        const int set = isctx ? 2 : b;
        if (set != cur) { cur = set; const float* sh = mod + (size_t)(set * 9 + 3 * sub) * DM; const float* sc = sh + DM;
#pragma unroll
            for (int q = 0; q < 8; ++q) { const int c = (q * 64 + lane) * 4; const f32x4 gg = *(const f32x4*)(g + c), ss = *(const f32x4*)(sc + c); A[q] = gg * (ss + 1.0f); B[q] = *(const f32x4*)(sh + c); } }
        const float* src = isctx ? src_ctx + ((size_t)b * CTXL + j) * DM : src_lat + ((size_t)b * SEQ + (j - CTXL)) * DM;
        f32x4 v[8]; float s = 0.f;
#pragma unroll
        for (int q = 0; q < 8; ++q) { v[q] = *(const GAS f32x4*)(src + (q * 64 + lane) * 4); s += (v[q].x * v[q].x + v[q].y * v[q].y) + (v[q].z * v[q].z + v[q].w * v[q].w); }
        const float rstd = 1.0f / sqrtf(wave_sum(s) * (1.0f / DM) + EPSN);
        bf16* orow = XN + (size_t)row * DM;
#pragma unroll
        for (int q = 0; q < 8; ++q) { const f32x4 o = v[q] * rstd * A[q] + B[q]; u32x2 w; w.x = cvtpk(o.x, o.y); w.y = cvtpk(o.z, o.w); *(GAS u32x2*)(orow + (q * 64 + lane) * 4) = w; }
    }
}
__device__ __forceinline__ void final_norm_phase(Frame& F, float* x, const float* g) {
    const int gw = F.vcu * NWAVES + F.wave, NGW = F.G * NWAVES, lane = F.lane;
    f32x4 A[8];
#pragma unroll
    for (int q = 0; q < 8; ++q) A[q] = *(const f32x4*)(g + (q * 64 + lane) * 4);
    for (int row = gw; row < NB * SEQ; row += NGW) {
        float* p = x + (size_t)row * DM; f32x4 v[8]; float s = 0.f;
#pragma unroll
        for (int q = 0; q < 8; ++q) { v[q] = *(const GAS f32x4*)(p + (q * 64 + lane) * 4); s += (v[q].x * v[q].x + v[q].y * v[q].y) + (v[q].z * v[q].z + v[q].w * v[q].w); }
        const float rstd = 1.0f / sqrtf(wave_sum(s) * (1.0f / DM) + EPSN);
#pragma unroll
        for (int q = 0; q < 8; ++q) *(GAS f32x4*)(p + (q * 64 + lane) * 4) = v[q] * rstd * A[q];
    }
}

typedef short v4i16_t __attribute__((ext_vector_type(4)));
__device__ __forceinline__ s16x4 vtr(LAS const unsigned char* p) { return __builtin_bit_cast(s16x4, __builtin_amdgcn_ds_read_tr16_b64_v4i16((LAS v4i16_t*)p)); }
template <int KSTEPS>
__device__ __forceinline__ void mm32_tr(f32x16& acc, LAS const unsigned char* At, int sa, int m0, LAS const unsigned char* Bn, int sb, int n0, int lane) {
    const int h = lane >> 5, blk = (lane >> 4) & 1, q = (lane & 15) >> 2, p = lane & 3, r = lane & 31;
    LAS const unsigned char* ap = At + (8 * h + q) * sa + (m0 + 16 * blk + 4 * p) * 2;
    LAS const unsigned char* bp = Bn + (n0 + r) * sb + 16 * h;
#pragma unroll
    for (int ks = 0; ks < KSTEPS; ++ks) {
        const s16x4 lo = vtr(ap + (16 * ks) * sa), hi4 = vtr(ap + (16 * ks + 4) * sa);
        const bf16x8 af = (bf16x8){lo[0], lo[1], lo[2], lo[3], hi4[0], hi4[1], hi4[2], hi4[3]};
        const bf16x8 bfv = *(LAS const bf16x8*)(bp + 32 * ks);
        acc = __builtin_amdgcn_mfma_f32_32x32x16_bf16(af, bfv, acc, 0, 0, 0);
    }
}
template <int KSTEPS>
__device__ __forceinline__ void mm32_rr(f32x16& acc, LAS const unsigned char* Am, int sa, int m0, LAS const unsigned char* Bn, int sb, int n0, int lane) {
    const int h = lane >> 5, r = lane & 31;
    LAS const unsigned char* ap = Am + (m0 + r) * sa + 16 * h;
    LAS const unsigned char* bp = Bn + (n0 + r) * sb + 16 * h;
#pragma unroll
    for (int ks = 0; ks < KSTEPS; ++ks) {
        const bf16x8 af = *(LAS const bf16x8*)(ap + 32 * ks);
        const bf16x8 bfv = *(LAS const bf16x8*)(bp + 32 * ks);
        acc = __builtin_amdgcn_mfma_f32_32x32x16_bf16(af, bfv, acc, 0, 0, 0);
    }
}

__device__ __forceinline__ void qknorm_row(bf16* Z, int row, const float* qkg  , const float* rc, const float* rs, int lane) {
    const int b = row / TOKB, j = row - b * TOKB; const bool isctx = j < CTXL; const int t = j - CTXL, prow = t >> 6, pcol = t & 63;
    bf16* zr = Z + (size_t)row * NZ;
#pragma unroll
    for (int pass = 0; pass < 3; ++pass) {
        const int ch = lane + 64 * pass; const bool act = ch < 160;
        const int head = ch >> 4, j16 = ch & 15;
        v4u w = {0u, 0u, 0u, 0u};
        if (act) w = *(const GAS v4u*)(zr + ch * 8);
        float y[8] = {bflo(w.x), bfhi(w.x), bflo(w.y), bfhi(w.y), bflo(w.z), bfhi(w.z), bflo(w.w), bfhi(w.w)};
        float ss = 0.f;
#pragma unroll
        for (int e = 0; e < 8; ++e) ss += y[e] * y[e];
        ss += __shfl_xor(ss, 1); ss += __shfl_xor(ss, 2); ss += __shfl_xor(ss, 4); ss += __shfl_xor(ss, 8);
        const float rstd = 1.0f / sqrtf(ss * (1.0f / 128.0f) + EPSN);
        const float* gp = qkg + (head < 8 ? 0 : 128) + j16 * 8;
#pragma unroll
        for (int e = 0; e < 8; ++e) y[e] = y[e] * rstd * gp[e];
        float pr[8];
#pragma unroll
        for (int e = 0; e < 8; ++e) pr[e] = __shfl_xor(y[e], 4);
        if (!isctx) {
            const int pos = (j16 & 8) ? pcol : prow; const int f0 = 8 * (j16 & 3);
            const float* cp = rc + pos * 32 + f0; const float* sp = rs + pos * 32 + f0;
            const bool second = (j16 & 4) != 0;
#pragma unroll
            for (int e = 0; e < 8; ++e) { const float cs = cp[e], sn = sp[e]; y[e] = second ? (pr[e] * sn + y[e] * cs) : (y[e] * cs - pr[e] * sn); }
        }
        if (act) { v4u o; o.x = cvtpk(y[0], y[1]); o.y = cvtpk(y[2], y[3]); o.z = cvtpk(y[4], y[5]); o.w = cvtpk(y[6], y[7]); *(GAS v4u*)(zr + ch * 8) = o; }
    }
}

constexpr int ST272 = 272, ST144 = 144;
__device__ __forceinline__ void gmlp_unit(Frame& F, const bf16* Z, bf16* MIX, int chunk, int grp, const float* ws_l  , const float* bs_l  , const float* gm  ) {
    int tid_ = threadIdx.x; asm volatile("" : "+v"(tid_));
    const int tid = tid_, lane = tid & 63, wave = __builtin_amdgcn_readfirstlane(tid >> 6);
    const int b = chunk / CHB, c = chunk - b * CHB, r0 = b * TOKB + c * 128;
    LAS unsigned char* VN = F.lds + RING_OFF;
    LAS unsigned char* WS = VN + 128 * ST272;
    LAS float* RS = (LAS float*)(WS + 128 * ST272);
    { const int row = tid >> 2, part = tid & 3; const bf16* p = Z + (size_t)(r0 + row) * NZ + ZMV + part * 128; float ss = 0.f;
#pragma unroll
        for (int q = 0; q < 16; ++q) { const v4u w = *(const GAS v4u*)(p + q * 8);
            const float y0 = bflo(w.x), y1 = bfhi(w.x), y2 = bflo(w.y), y3 = bfhi(w.y), y4 = bflo(w.z), y5 = bfhi(w.z), y6 = bflo(w.w), y7 = bfhi(w.w);
            ss += (y0 * y0 + y1 * y1) + (y2 * y2 + y3 * y3) + (y4 * y4 + y5 * y5) + (y6 * y6 + y7 * y7); }
        ss += __shfl_xor(ss, 1); ss += __shfl_xor(ss, 2);
        if (part == 0) RS[row] = 1.0f / sqrtf(ss * (1.0f / 512.0f) + EPSN); }
#pragma unroll
    for (int q = 0; q < 8; ++q) { const int idx = tid + 512 * q, i = idx >> 5, j4 = (idx & 31) * 4; const f32x4 w = *(const f32x4*)(ws_l + (size_t)grp * 16384 + i * 128 + j4);
        u32x2 o; o.x = cvtpk(w.x, w.y); o.y = cvtpk(w.z, w.w); *(LAS u32x2*)(WS + i * ST272 + j4 * 2) = o; }
    __syncthreads();
#pragma unroll
    for (int q = 0; q < 4; ++q) { const int idx = tid + 512 * q, jrow = idx >> 4, c8 = (idx & 15) * 8; const v4u w = *(const GAS v4u*)(Z + (size_t)(r0 + jrow) * NZ + ZMV + grp * 128 + c8);
        const float rstd = RS[jrow]; const float* gp = gm + grp * 128 + c8;
        v4u o; o.x = cvtpk(bflo(w.x) * rstd * gp[0], bfhi(w.x) * rstd * gp[1]); o.y = cvtpk(bflo(w.y) * rstd * gp[2], bfhi(w.y) * rstd * gp[3]);
        o.z = cvtpk(bflo(w.z) * rstd * gp[4], bfhi(w.z) * rstd * gp[5]); o.w = cvtpk(bflo(w.w) * rstd * gp[6], bfhi(w.w) * rstd * gp[7]);
        *(LAS v4u*)(VN + jrow * ST272 + c8 * 2) = o; }
    __syncthreads();
    const int it = wave & 3, ct0 = (wave >> 2) * 2, hi = lane >> 5, i = it * 32 + (lane & 31);
    const float bias = bs_l[grp * 128 + i];
#pragma unroll
    for (int cc = 0; cc < 2; ++cc) { const int ct = ct0 + cc; f32x16 acc = {};
        mm32_tr<8>(acc, VN, ST272, ct * 32, WS, ST272, it * 32, lane);
        const bf16* mup = Z + (size_t)(r0 + i) * NZ + ZMU + grp * 128 + ct * 32 + 4 * hi; bf16* op = MIX + (size_t)(r0 + i) * DM + MXM + grp * 128 + ct * 32 + 4 * hi;
#pragma unroll
        for (int rg = 0; rg < 4; ++rg) { const u32x2 mu = *(const GAS u32x2*)(mup + 8 * rg);
            u32x2 o; o.x = cvtpk(bflo(mu.x) * (acc[4 * rg + 0] + bias), bfhi(mu.x) * (acc[4 * rg + 1] + bias)); o.y = cvtpk(bflo(mu.y) * (acc[4 * rg + 2] + bias), bfhi(mu.y) * (acc[4 * rg + 3] + bias));
            *(GAS u32x2*)(op + 8 * rg) = o; } }
    __syncthreads();
}

__device__ __forceinline__ float log_sigmoid_f(float x) { return fminf(x, 0.f) - log1pf(__expf(-fabsf(x))); }
__device__ __forceinline__ void gla_a_unit(Frame& F, bf16* Z, bf16* QG, float* UT, float* DV, int chunk, int hd, const float* gw_l  , const float* gb_l  ) {
    int tid_ = threadIdx.x; asm volatile("" : "+v"(tid_));
    const int tid = tid_, lane = tid & 63, wave = __builtin_amdgcn_readfirstlane(tid >> 6);
    const int b = chunk / CHB, c = chunk - b * CHB, r0 = b * TOKB + c * 128;
    LAS unsigned char* QT = F.lds + RING_OFF;
    LAS unsigned char* KT = QT + 128 * ST144;
    LAS unsigned char* KTT = KT + 128 * ST144;
    LAS unsigned char* VV = KTT + 64 * ST272;
    LAS unsigned char* ATT = VV + 128 * ST272;
    LAS unsigned char* QRAW = ATT; LAS unsigned char* KRAW = ATT + 16384;
    LAS float* SEG = (LAS float*)(ATT + 128 * ST272);
    LAS unsigned char* LR = (LAS unsigned char*)(SEG + 512);
#pragma unroll
    for (int q = 0; q < 4; ++q) { const int idx = tid + 512 * q, jrow = idx >> 4, c8 = (idx & 15) * 8;
        *(LAS v4u*)(VV + jrow * ST272 + c8 * 2) = *(const GAS v4u*)(Z + (size_t)(r0 + jrow) * NZ + ZGV + hd * 128 + c8); }
#pragma unroll
    for (int q = 0; q < 2; ++q) { const int idx = tid + 512 * q, jrow = idx >> 3, c8 = (idx & 7) * 8;
        *(LAS v4u*)(QRAW + jrow * 128 + c8 * 2) = *(const GAS v4u*)(Z + (size_t)(r0 + jrow) * NZ + ZGQ + hd * 64 + c8);
        *(LAS v4u*)(KRAW + jrow * 128 + c8 * 2) = *(const GAS v4u*)(Z + (size_t)(r0 + jrow) * NZ + ZGK + hd * 64 + c8); }
    { const int jrow = tid >> 2, c8 = (tid & 3) * 8; *(LAS v4u*)(LR + jrow * 64 + c8 * 2) = *(const GAS v4u*)(Z + (size_t)(r0 + jrow) * NZ + ZLR + c8); }
    __syncthreads();
    const int d = lane, jb = wave;
    f32x16 att0 = {}, att1 = {};
    const int jt = wave & 3, it0 = (wave >> 2) * 2, hi = lane >> 5, r32 = lane & 31;
#pragma unroll
    for (int dir = 0; dir < 2; ++dir) {
        float cs[16];
        { float wv[16];
#pragma unroll
          for (int r = 0; r < 16; ++r) wv[r] = gw_l[(dir * 16 + r) * 256 + hd * 64 + d];
          const float gbias = gb_l[dir * 256 + hd * 64 + d];
#pragma unroll
          for (int i = 0; i < 16; ++i) { LAS const unsigned char* lr = LR + (jb * 16 + i) * 64 + dir * 32;
            const v4u w0 = *(LAS const v4u*)(lr), w1 = *(LAS const v4u*)(lr + 16);
            float lg = gbias;
            lg += bflo(w0.x) * wv[0] + bfhi(w0.x) * wv[1] + bflo(w0.y) * wv[2] + bfhi(w0.y) * wv[3] + bflo(w0.z) * wv[4] + bfhi(w0.z) * wv[5] + bflo(w0.w) * wv[6] + bfhi(w0.w) * wv[7];
            lg += bflo(w1.x) * wv[8] + bfhi(w1.x) * wv[9] + bflo(w1.y) * wv[10] + bfhi(w1.y) * wv[11] + bflo(w1.z) * wv[12] + bfhi(w1.z) * wv[13] + bflo(w1.w) * wv[14] + bfhi(w1.w) * wv[15];
            cs[i] = log_sigmoid_f(lg) * (1.0f / 16.0f); } }
        if (dir == 0) {
#pragma unroll
            for (int i = 1; i < 16; ++i) cs[i] += cs[i - 1];
            SEG[jb * 64 + d] = cs[15];
        } else {
#pragma unroll
            for (int i = 14; i >= 0; --i) cs[i] += cs[i + 1];
            SEG[jb * 64 + d] = cs[0];
        }
        __syncthreads();
        float offs = 0.f;
#pragma unroll
        for (int s = 0; s < 8; ++s) { const float sv = SEG[s * 64 + d]; if (dir == 0 ? (s < jb) : (s > jb)) offs += sv; }
#pragma unroll
        for (int i = 0; i < 16; ++i) { const int j = jb * 16 + i; const float cc = cs[i] + offs;
            const float qraw = bf2f(*(LAS const unsigned short*)(QRAW + j * 128 + d * 2)) * 0.125f, kraw = bf2f(*(LAS const unsigned short*)(KRAW + j * 128 + d * 2));
            const float qt = qraw * __expf(cc), kt = kraw * __expf(-cc);
            const unsigned short qb = (unsigned short)(cvtpk(qt, 0.f) & 0xffffu), kb = (unsigned short)(cvtpk(kt, 0.f) & 0xffffu);
            *(LAS unsigned short*)(QT + j * ST144 + d * 2) = qb; *(LAS unsigned short*)(KT + j * ST144 + d * 2) = kb; *(LAS unsigned short*)(KTT + d * ST272 + j * 2) = kb; }
        __syncthreads();
#pragma unroll
        for (int q = 0; q < 2; ++q) { const int idx = tid + 512 * q, jrow = idx >> 3, c8 = (idx & 7) * 8;
            *(GAS v4u*)(QG + (size_t)(r0 + jrow) * 512 + dir * 256 + hd * 64 + c8) = *(LAS const v4u*)(QT + jrow * ST144 + c8 * 2); }
#pragma unroll
        for (int cc = 0; cc < 2; ++cc) { f32x16 acc = {};
            mm32_rr<4>(acc, KT, ST144, jt * 32, QT, ST144, (it0 + cc) * 32, lane);
            const int ii = (it0 + cc) * 32 + r32;
#pragma unroll
            for (int r = 0; r < 16; ++r) { const int jj = jt * 32 + crow(r, hi); const int df = dir == 0 ? (ii - jj) : (jj - ii);
                const float v = __uint_as_float(__float_as_uint(acc[r]) & ~(unsigned)(df >> 31)); if (cc == 0) att0[r] += v; else att1[r] += v; } }
        { const int et = wave & 3, dt = wave >> 2; f32x16 acc = {};
            mm32_tr<8>(acc, VV, ST272, et * 32, KTT, ST272, dt * 32, lane);
            const int dd = dt * 32 + r32; float tot = 0.f;
#pragma unroll
            for (int s = 0; s < 8; ++s) tot += SEG[s * 64 + dd];
            const float ex = __expf(tot);
            const size_t cidx = ((size_t)(b * CHB + c) * 4 + hd) * 2 + dir;
            float* up = UT + cidx * 8192 + dd;
#pragma unroll
            for (int r = 0; r < 16; ++r) up[(et * 32 + crow(r, hi)) * 64] = acc[r] * ex;
            if (et == 0 && hi == 0) DV[cidx * 64 + dd] = ex; }
        __syncthreads();
    }
#pragma unroll
    for (int cc = 0; cc < 2; ++cc) { const int ii = (it0 + cc) * 32 + r32;
#pragma unroll
        for (int rg = 0; rg < 4; ++rg) { u32x2 o;
            if (cc == 0) { o.x = cvtpk(att0[4 * rg], att0[4 * rg + 1]); o.y = cvtpk(att0[4 * rg + 2], att0[4 * rg + 3]); } else { o.x = cvtpk(att1[4 * rg], att1[4 * rg + 1]); o.y = cvtpk(att1[4 * rg + 2], att1[4 * rg + 3]); }
            *(LAS u32x2*)(ATT + ii * ST272 + (jt * 32 + 8 * rg + 4 * hi) * 2) = o; } }
    __syncthreads();
    { const int itile = wave & 3, et0 = (wave >> 2) * 2; const int ii = itile * 32 + r32;
#pragma unroll
        for (int cc = 0; cc < 2; ++cc) { const int et = et0 + cc; f32x16 acc = {};
            mm32_tr<8>(acc, VV, ST272, et * 32, ATT, ST272, itile * 32, lane);
            bf16* op = Z + (size_t)(r0 + ii) * NZ + ZGV + hd * 128 + et * 32 + 4 * hi;
#pragma unroll
            for (int rg = 0; rg < 4; ++rg) { u32x2 o; o.x = cvtpk(acc[4 * rg], acc[4 * rg + 1]); o.y = cvtpk(acc[4 * rg + 2], acc[4 * rg + 3]); *(GAS u32x2*)(op + 8 * rg) = o; } } }
    __syncthreads();
}

__device__ __forceinline__ void gla_scan_phase(Frame& F, const float* UT, const float* DV, bf16* ST) {
    for (int gt = F.vcu * 512 + F.tid; gt < 16 * 8192; gt += F.G * 512) {
        const int chain = gt >> 13, elem = gt & 8191, d = elem & 63, dir = chain & 1, hd = (chain >> 1) & 3, b = chain >> 3;
        float state = 0.f;
#pragma unroll 10
        for (int s = 0; s < CHB; ++s) {
            const int c = dir == 0 ? s : (s == 0 ? 1 : (s == 1 ? 0 : 131 - s));
            const size_t cidx = ((size_t)(b * CHB + c) * 4 + hd) * 2 + dir;
            const float u = UT[cidx * 8192 + elem], dv = DV[cidx * 64 + d];
            ST[cidx * 8192 + elem] = (bf16)(cvtpk(state, 0.f) & 0xffffu);
            state = dv * state + u;
        }
    }
}

__device__ __forceinline__ void gla_c_item(const bf16* Z, const bf16* QG, const bf16* ST, bf16* MIX, int chunk, int hd, int itile, const float* gg  , int lane) {
    const int b = chunk / CHB, c = chunk - b * CHB, r0 = b * TOKB + c * 128, r32 = lane & 31, hi = lane >> 5;
    const size_t row = (size_t)(r0 + itile * 32 + r32);
    bf16x8 bq[2][4];
#pragma unroll
    for (int dir = 0; dir < 2; ++dir)
#pragma unroll
        for (int ks = 0; ks < 4; ++ks) bq[dir][ks] = *(const GAS bf16x8*)(QG + row * 512 + dir * 256 + hd * 64 + 16 * ks + 8 * hi);
    f32x16 acc[4] = {};
#pragma unroll
    for (int dir = 0; dir < 2; ++dir) { const size_t cidx = ((size_t)(b * CHB + c) * 4 + hd) * 2 + dir; const bf16* sp = ST + cidx * 8192 + (size_t)r32 * 64 + 8 * hi;
#pragma unroll
        for (int et = 0; et < 4; ++et)
#pragma unroll
            for (int ks = 0; ks < 4; ++ks) { const bf16x8 af = *(const GAS bf16x8*)(sp + et * 32 * 64 + 16 * ks);
#ifndef DBG_GLA_NOINTER
                acc[et] = __builtin_amdgcn_mfma_f32_32x32x16_bf16(af, bq[dir][ks], acc[et], 0, 0, 0);
#endif
            } }
    float ss = 0.f;
#pragma unroll
    for (int et = 0; et < 4; ++et)
#pragma unroll
        for (int rg = 0; rg < 4; ++rg) { const u32x2 w = *(const GAS u32x2*)(Z + row * NZ + ZGV + hd * 128 + et * 32 + 8 * rg + 4 * hi);
#ifndef DBG_GLA_NOINTRA
            acc[et][4 * rg + 0] += bflo(w.x); acc[et][4 * rg + 1] += bfhi(w.x); acc[et][4 * rg + 2] += bflo(w.y); acc[et][4 * rg + 3] += bfhi(w.y);
#endif
            ss += (acc[et][4 * rg] * acc[et][4 * rg] + acc[et][4 * rg + 1] * acc[et][4 * rg + 1]) + (acc[et][4 * rg + 2] * acc[et][4 * rg + 2] + acc[et][4 * rg + 3] * acc[et][4 * rg + 3]); }
    ss += __shfl_xor(ss, 32);
    const float rstd = 1.0f / sqrtf(ss * (1.0f / 128.0f) + EPSN);
#pragma unroll
    for (int et = 0; et < 4; ++et)
#pragma unroll
        for (int rg = 0; rg < 4; ++rg) { const int e0 = et * 32 + 8 * rg + 4 * hi; const u32x2 rw = *(const GAS u32x2*)(Z + row * NZ + ZGR + hd * 128 + e0); const f32x4 g4 = *(const f32x4*)(gg + hd * 128 + e0);
            const float r0v = bflo(rw.x), r1v = bfhi(rw.x), r2v = bflo(rw.y), r3v = bfhi(rw.y);
            float y0 = acc[et][4 * rg] * rstd * g4.x * silu_acc(r0v), y1 = acc[et][4 * rg + 1] * rstd * g4.y * silu_acc(r1v), y2 = acc[et][4 * rg + 2] * rstd * g4.z * silu_acc(r2v), y3 = acc[et][4 * rg + 3] * rstd * g4.w * silu_acc(r3v);
#ifdef DBG_SANITIZE
            if (!(fabsf(y0) < 1e30f)) y0 = 100.f; if (!(fabsf(y1) < 1e30f)) y1 = 100.f; if (!(fabsf(y2) < 1e30f)) y2 = 100.f; if (!(fabsf(y3) < 1e30f)) y3 = 100.f;
#endif
            u32x2 o; o.x = cvtpk(y0, y1); o.y = cvtpk(y2, y3);
            *(GAS u32x2*)(MIX + row * DM + MXG + hd * 128 + e0) = o; }
}

namespace att {
constexpr int D = 128, NW = 8, QBLK = 32, KVBLK = 64;
constexpr float SCALE = 0.088388347648318440f;
constexpr float THR = 8.f;
constexpr int LDQ = NZ, LDK = NZ, LDO = DM;
constexpr int SHM_V = KVBLK * D * 2, SHM_K = KVBLK * D * 2, SHM_ATTN = 2 * SHM_V + 2 * SHM_K + NW * 64 * 4;
#define KSWZ(row, colB) ((row) * 256 + ((colB) ^ (((row) & 7) << 4)))
#define SBAR() __builtin_amdgcn_sched_barrier(0)
__device__ __forceinline__ void partialSM(f32x16& p0, f32x16& p1, float& m_reg, float& mn, float& alpha) {
  constexpr float C = SCALE * 1.4426950408889634f;
  float pmax = p0[0];
#pragma unroll
  for (int r = 1; r < 16; ++r) pmax = fmaxf(pmax, p0[r]);
#pragma unroll
  for (int r = 0; r < 16; ++r) pmax = fmaxf(pmax, p1[r]);
  { auto rr = __builtin_amdgcn_permlane32_swap(__float_as_uint(pmax), __float_as_uint(pmax), false, false);
    pmax = fmaxf(__uint_as_float(rr[0]), __uint_as_float(rr[1])); }
  if (__builtin_expect(__all(pmax - m_reg <= THR / SCALE), 1)) { mn = m_reg; alpha = 1.f; }
  else { mn = fmaxf(m_reg, pmax); alpha = __builtin_amdgcn_exp2f((m_reg - mn) * C); m_reg = mn; }
  float mnC = -mn * C;
#pragma unroll
  for (int r = 0; r < 16; ++r) p0[r] = fmaf(p0[r], C, mnC);
#pragma unroll
  for (int r = 0; r < 16; ++r) p1[r] = fmaf(p1[r], C, mnC);
#pragma unroll
  for (int r = 0; r < 16; ++r) p0[r] = __builtin_amdgcn_exp2f(p0[r]);
}
__device__ __forceinline__ void finishSM(f32x16& p0, f32x16& p1, float alpha, float& l_reg, bf16x8& pa0, bf16x8& pa1, bf16x8& pa2, bf16x8& pa3) {
#pragma unroll
  for (int r = 0; r < 16; ++r) p1[r] = __builtin_amdgcn_exp2f(p1[r]);
  float ps = 0;
#pragma unroll
  for (int r = 0; r < 16; ++r) ps += p0[r];
#pragma unroll
  for (int r = 0; r < 16; ++r) ps += p1[r];
  { auto rr = __builtin_amdgcn_permlane32_swap(__float_as_uint(ps), __float_as_uint(ps), false, false);
    ps = __uint_as_float(rr[0]) + __uint_as_float(rr[1]); }
  l_reg = l_reg * alpha + ps;
#define PK4(P, BASE, OUT) do { unsigned a0 = cvtpk(P[BASE + 0], P[BASE + 1]), a1 = cvtpk(P[BASE + 2], P[BASE + 3]);   \
    unsigned b0 = cvtpk(P[BASE + 4], P[BASE + 5]), b1 = cvtpk(P[BASE + 6], P[BASE + 7]);                              \
    auto r0 = __builtin_amdgcn_permlane32_swap(a0, b0, false, false); auto r1 = __builtin_amdgcn_permlane32_swap(a1, b1, false, false); \
    v4u w = {r0[0], r1[0], r0[1], r1[1]}; OUT = __builtin_bit_cast(bf16x8, w); } while (0)
  PK4(p0, 0, pa0); PK4(p0, 8, pa1); PK4(p1, 0, pa2); PK4(p1, 8, pa3);
#undef PK4
}
__device__ __forceinline__ void qkt(f32x16& p0, f32x16& p1, LAS const unsigned char* Ks, const bf16x8* qr, int r32, int hi) {
  p0 = f32x16{}; p1 = f32x16{};
#pragma unroll
  for (int d0 = 0; d0 < 8; ++d0) { int cb = (d0 * 16 + hi * 8) * 2;
    bf16x8 b0 = *(LAS const bf16x8*)(Ks + KSWZ(r32, cb));
    bf16x8 b1 = *(LAS const bf16x8*)(Ks + KSWZ(32 + r32, cb));
    p0 = __builtin_amdgcn_mfma_f32_32x32x16_bf16(b0, qr[d0], p0, 0, 0, 0);
    p1 = __builtin_amdgcn_mfma_f32_32x32x16_bf16(b1, qr[d0], p1, 0, 0, 0); }
}
__device__ __forceinline__ int v_st(int k, int c) { const int kk = (k & ~0xC) | ((k & 4) << 1) | ((k & 8) >> 1); return ((kk >> 3) * 4 + (c >> 5)) * 512 + ((kk & 7) * 32 + (c & 31)) * 2; }
__device__ __forceinline__ int v_rd_base(int lane) { return ((lane & 3) << 3) | (((lane >> 2) & 3) << 6) | (((lane >> 4) & 1) << 5) | (((lane >> 5) & 1) << 8); }
constexpr int v_rd_off(int d0, int ks, int half) { return d0 * 512 + ks * 4096 + half * 2048; }
template <int OFF> __device__ __forceinline__ s16x4 tr_read(int vb) {
  s16x4 r; asm volatile("ds_read_b64_tr_b16 %0, %1 offset:%2" : "=&v"(r) : "v"(vb), "i"(OFF) : "memory"); return r;
}
template <int D0> __device__ __forceinline__ void pv_one(f32x16& od, int vb, bf16x8 pa0, bf16x8 pa1, bf16x8 pa2, bf16x8 pa3) {
  const s16x4 l0 = tr_read<v_rd_off(D0, 0, 0)>(vb), h0 = tr_read<v_rd_off(D0, 0, 1)>(vb), l1 = tr_read<v_rd_off(D0, 1, 0)>(vb), h1 = tr_read<v_rd_off(D0, 1, 1)>(vb);
  const s16x4 l2 = tr_read<v_rd_off(D0, 2, 0)>(vb), h2 = tr_read<v_rd_off(D0, 2, 1)>(vb), l3 = tr_read<v_rd_off(D0, 3, 0)>(vb), h3 = tr_read<v_rd_off(D0, 3, 1)>(vb);
  asm volatile("s_waitcnt lgkmcnt(0)" ::: "memory"); SBAR();
#define PK(L, H) (bf16x8){L[0], L[1], L[2], L[3], H[0], H[1], H[2], H[3]}
  od = __builtin_amdgcn_mfma_f32_32x32x16_bf16(pa0, PK(l0, h0), od, 0, 0, 0);
  od = __builtin_amdgcn_mfma_f32_32x32x16_bf16(pa1, PK(l1, h1), od, 0, 0, 0);
  od = __builtin_amdgcn_mfma_f32_32x32x16_bf16(pa2, PK(l2, h2), od, 0, 0, 0);
  od = __builtin_amdgcn_mfma_f32_32x32x16_bf16(pa3, PK(l3, h3), od, 0, 0, 0);
#undef PK
}
__device__ __forceinline__ void pv_d0(f32x16* o, int vb, bf16x8 pa0, bf16x8 pa1, bf16x8 pa2, bf16x8 pa3) {
  pv_one<0>(o[0], vb, pa0, pa1, pa2, pa3); pv_one<1>(o[1], vb, pa0, pa1, pa2, pa3); pv_one<2>(o[2], vb, pa0, pa1, pa2, pa3); pv_one<3>(o[3], vb, pa0, pa1, pa2, pa3);
}
__device__ __forceinline__ void attn_dense_body(const bf16* __restrict__ Qb, const bf16* __restrict__ Kh, const bf16* __restrict__ Vh, bf16* __restrict__ Ob, int seq, LAS unsigned char* lds) {
  int tid_ = threadIdx.x; asm volatile("" : "+v"(tid_));
  const int tid = tid_, wid = __builtin_amdgcn_readfirstlane(tid >> 6), lane = tid & 63, r32 = lane & 31, hi = lane >> 5;
  LAS unsigned char* V_lds = lds; LAS unsigned char* K_lds = lds + 2 * SHM_V;
  LAS float* wsp = (LAS float*)(lds + 2 * SHM_V + 2 * SHM_K) + wid * 64; LAS float* li_l = wsp; LAS float* al_l = wsp + 32;
  float m_reg = -1e30f, l_reg = 0; f32x16 o[4] = {}; bf16x8 qr[8];
  const bf16* Qw = Qb + (long)(wid * QBLK + r32) * LDQ + hi * 8;
#pragma unroll
  for (int d0 = 0; d0 < 8; ++d0) qr[d0] = *(const GAS bf16x8*)(Qw + d0 * 16);
  const int sr = tid >> 4, sc = (tid & 15) * 8, vst0 = v_st(sr, sc), vst1 = v_st(32 + sr, sc);
  const int vb0 = (int)(unsigned)(uintptr_t)V_lds + v_rd_base(lane);
  struct { bf16x8 vs0, vs1, ks0, ks1; } sr_[2];
#define SLOAD(i, k0) do { sr_[i].vs0 = *(const GAS bf16x8*)(&Vh[(long)((k0) + sr) * LDK + sc]); sr_[i].vs1 = *(const GAS bf16x8*)(&Vh[(long)((k0) + 32 + sr) * LDK + sc]); \
    sr_[i].ks0 = *(const GAS bf16x8*)(&Kh[(long)((k0) + sr) * LDK + sc]); sr_[i].ks1 = *(const GAS bf16x8*)(&Kh[(long)((k0) + 32 + sr) * LDK + sc]); } while (0)
#define SWRITE(b, i) do { *(LAS bf16x8*)(V_lds + (b) * SHM_V + vst0) = sr_[i].vs0;          \
    *(LAS bf16x8*)(V_lds + (b) * SHM_V + vst1) = sr_[i].vs1; int kc = sc * 2;               \
    *(LAS bf16x8*)(K_lds + (b) * SHM_K + KSWZ(sr, kc)) = sr_[i].ks0;                       \
    *(LAS bf16x8*)(K_lds + (b) * SHM_K + KSWZ(32 + sr, kc)) = sr_[i].ks1; } while (0)
#define SWAIT() asm volatile("s_waitcnt vmcnt(4)" ::: "memory")
#define RESC(a) do { if (__any((a) < 1.f)) { if (hi == 0) al_l[r32] = (a); asm volatile("s_waitcnt lgkmcnt(0)" ::: "memory"); \
    _Pragma("unroll") for (int d = 0; d < 4; ++d) _Pragma("unroll") for (int r = 0; r < 16; ++r) o[d][r] *= al_l[crow(r, hi)]; } } while (0)
  f32x16 pA0, pA1, pB0, pB1; float mnA, mnB, alA, alB; bf16x8 pa0, pa1, pa2, pa3; const int NT = seq / KVBLK;
  constexpr int SE = 0, SO = 1;
  SLOAD(SE, 0); asm volatile("s_waitcnt vmcnt(0)" ::: "memory"); SWRITE(0, SE); __syncthreads();
  qkt(pA0, pA1, K_lds, qr, r32, hi); partialSM(pA0, pA1, m_reg, mnA, alA);
  SLOAD(SO, KVBLK); if (2 < NT) SLOAD(SE, 2 * KVBLK);
  SWAIT(); SWRITE(1, SO); __syncthreads();
  for (int j = 1; j + 1 < NT; j += 2) {
    SBAR(); qkt(pB0, pB1, K_lds + SHM_K, qr, r32, hi);
    finishSM(pA0, pA1, alA, l_reg, pa0, pa1, pa2, pa3); SBAR();
    SLOAD(SO, (j + 2) * KVBLK); SBAR();
    pv_d0(o, vb0, pa0, pa1, pa2, pa3); partialSM(pB0, pB1, m_reg, mnB, alB);
    __syncthreads(); SWAIT(); SWRITE(0, SE);
    RESC(alB); __syncthreads();
    SBAR(); qkt(pA0, pA1, K_lds, qr, r32, hi);
    finishSM(pB0, pB1, alB, l_reg, pa0, pa1, pa2, pa3); SBAR();
    if (j + 3 < NT) SLOAD(SE, (j + 3) * KVBLK); SBAR();
    pv_d0(o, vb0 + (int)SHM_V, pa0, pa1, pa2, pa3); partialSM(pA0, pA1, m_reg, mnA, alA);
    __syncthreads(); SWAIT(); SWRITE(1, SO);
    RESC(alA); __syncthreads();
  }
  SBAR(); qkt(pB0, pB1, K_lds + SHM_K, qr, r32, hi);
  finishSM(pA0, pA1, alA, l_reg, pa0, pa1, pa2, pa3); SBAR();
  pv_d0(o, vb0, pa0, pa1, pa2, pa3); partialSM(pB0, pB1, m_reg, mnB, alB);
  __syncthreads(); RESC(alB);
  finishSM(pB0, pB1, alB, l_reg, pa0, pa1, pa2, pa3); SBAR();
  pv_d0(o, vb0 + (int)SHM_V, pa0, pa1, pa2, pa3);
  if (hi == 0) li_l[r32] = l_reg; asm volatile("s_waitcnt lgkmcnt(0)" ::: "memory");
  float rli[16];
#pragma unroll
  for (int r = 0; r < 16; ++r) rli[r] = __builtin_amdgcn_rcpf(li_l[crow(r, hi)]);
  bf16* Ow = Ob + (long)(wid * QBLK) * LDO;
#pragma unroll
  for (int r = 0; r < 16; ++r) { int orow = crow(r, hi);
#pragma unroll
    for (int d0 = 0; d0 < 4; ++d0) Ow[(long)orow * LDO + d0 * 32 + r32] = (bf16)(cvtpk(o[d0][r] * rli[r], 0.f) & 0xffffu); }
  __syncthreads();
#undef SLOAD
#undef SWRITE
#undef SWAIT
#undef RESC
}
#undef KSWZ
#undef SBAR
}

constexpr int N_PHASES = 27;
__global__ void __launch_bounds__(NWAVES * 64, 2) fwd_kernel(Args args) {
    extern __shared__ __attribute__((aligned(16))) unsigned char lds[];
    Frame F;
    F.lds = (LAS unsigned char*)lds;
    F.MISC = (volatile LAS unsigned*)(F.lds + MISC_OFF);
    F.tid = threadIdx.x; F.lane = F.tid & 63; F.wave = __builtin_amdgcn_readfirstlane(F.tid >> 6);
    F.G = gridDim.x; { const int bx = blockIdx.x; F.vcu = (F.G % 8 == 0) ? (bx % 8) * (F.G / 8) + bx / 8 : bx; }
    F.ctl = (gu32*)(args.ws + WS_CTL);
    for (int u = F.tid; u < (LDS_BYTES - LDSCTL_OFF) / 4; u += NWAVES * 64) ((LAS unsigned*)(F.lds + LDSCTL_OFF))[u] = 0u;
    __syncthreads();
    const int lo = args.ph_lo, hi = args.ph_hi;
    XcdBarrier bar; bar.bar = (unsigned*)(F.ctl + CW_BAR); bar.x = 0; bar.st = nullptr;
    if (hi - lo > 1) bar = xcd_barrier_post((unsigned*)(F.ctl + CW_BAR), F.MISC + 8);
#ifndef SITEMASK
#define SITEMASK 0xFFFFF
#endif
#define EN(s) (((SITEMASK) >> (s)) & 1)
#define IN(k) (lo <= (k) && (k) < hi)
#define SEAM(k) do { if (IN(k) && IN((k) + 1)) { XcdBarrier bb_ = bar; asm volatile("" : "+s"(bb_.x)); unsigned* bp_ = bb_.bar; asm volatile("" : "+s"(bp_)); bb_.bar = bp_; xcd_barrier(bb_); } } while (0)
#define FRESH() do { int t_ = threadIdx.x; asm volatile("" : "+v"(t_)); F.tid = t_; F.lane = t_ & 63; F.wave = __builtin_amdgcn_readfirstlane(t_ >> 6); } while (0)

    const int NGW = F.G * NWAVES;
#define WSP() unsigned char* ws = args.ws; asm volatile("" : "+s"(ws))
    if (EN(0) && IN(0)) { FRESH(); p0_prologue(F, args); }
#ifdef DBG_COPYX
    if (IN(0)) { for (size_t i = (size_t)blockIdx.x * 512 + threadIdx.x; i < (size_t)NB * SEQ * DM / 4; i += (size_t)gridDim.x * 512) ((f32x4*)args.out)[i] = ((const f32x4*)args.in[0])[i]; }
#endif
    SEAM(0);
    if (EN(1) && IN(1)) { FRESH(); p1_modreduce(F, args); }
    SEAM(1);

    for (int l = 0; l < DEPTH; ++l) {
        const int pb = 2 + 12 * l; const int last = (l == DEPTH - 1) ? 1 : 0;
        for (int half = 0; half < 2; ++half) {
            if (half == 1) {
                if (EN(2) && IN(pb + 3)) { FRESH(); WSP(); norm_phase(F, args.out, (const float*)(ws + WS_CTXRES), args.in[6] + (size_t)(l * 3 + 1) * DM, (const float*)(ws + WS_MOD) + (size_t)l * 3 * MODW, 1, (bf16*)(ws + WS_XN), 0); }
                SEAM(pb + 3);
                if (EN(3) && IN(pb + 4)) { WSP();
                    pg8::Gemm g{(const bf16*)(ws + WS_XN), (const bf16*)(ws + WS_W + (size_t)l * W_LAYER + W_IN), M_ALL, NZ, DM}; pg8::PanelOrder S; S.init(NPAN, NZ / 256, F.G, (int)blockIdx.x, 0);
                    pg8::EpiBf16Plain E{(bf16*)(ws + WS_Z), NZ};
                    pg8::gemm_phase<pg8::EpiBf16Plain, pg8::PanelOrder, true, true>(F.lds + RING_OFF, g, S, E);
                }
                SEAM(pb + 4);
                if (EN(4) && IN(pb + 5)) { FRESH(); WSP(); const int gw = F.vcu * NWAVES + F.wave;
                    bf16* Z = (bf16*)(ws + WS_Z); bf16* MIX = (bf16*)(ws + WS_MIX);
                    const float* gw_l = args.in[14] + (size_t)l * 2 * 16 * 256; const float* gb_l = args.in[15] + (size_t)l * 2 * 256;
                    const float* wsl = args.in[17] + (size_t)l * 4 * 128 * 128; const float* bsl = args.in[18] + (size_t)l * 4 * 128; const float* gml = args.in[19] + (size_t)l * 512;
                    for (int U = F.vcu; U < 2 * NCH * 4; U += F.G) {
                        if (U < NCH * 4) { if (EN(12)) gla_a_unit(F, Z, (bf16*)(ws + WS_QG), (float*)(ws + WS_UT), (float*)(ws + WS_DV), U >> 2, U & 3, gw_l, gb_l); }
                        else { const int V = U - NCH * 4, chunk = V >> 2; const int c = chunk % CHB; if (EN(13) && !(last && c < 2)) gmlp_unit(F, Z, MIX, chunk, V & 3, wsl, bsl, gml); }
                    }
                    const float* qkg = args.in[13] + (size_t)l * 256; const float* rope_c = (const float*)(ws + WS_ROPE);
                    if (EN(14)) for (int row = gw; row < M_ALL; row += NGW) qknorm_row(Z, row, qkg, rope_c, rope_c + 256 * 32, F.lane);
                }
                SEAM(pb + 5);
                if (EN(5) && IN(pb + 6)) { FRESH(); WSP(); gla_scan_phase(F, (const float*)(ws + WS_UT), (const float*)(ws + WS_DV), (bf16*)(ws + WS_ST)); }
                SEAM(pb + 6);
                if (EN(6) && IN(pb + 7)) { FRESH(); WSP(); const int gw = F.vcu * NWAVES + F.wave;
                    bf16* Z = (bf16*)(ws + WS_Z); bf16* MIX = (bf16*)(ws + WS_MIX);
                    if (EN(15)) { const int nU = last ? 1024 : 1040;
                        for (int U = F.vcu; U < nU; U += F.G) {
                            int b, hq, kvh, seq; size_t row0;
                            if (U < 1024) { const int i = U >> 8, v = U & 255, grp = v >> 6; b = grp >> 1; kvh = grp & 1; hq = kvh * 4 + i; row0 = (size_t)b * TOKB + CTXL + (size_t)(v & 63) * 256; seq = TOKB; }
                            else { const int V = U - 1024; b = V >> 3; hq = V & 7; kvh = hq >> 2; row0 = (size_t)b * TOKB; seq = CTXL; }
                            const size_t kv0 = (size_t)b * TOKB;
                            att::attn_dense_body(Z + row0 * NZ + ZQ + hq * 128, Z + kv0 * NZ + ZK + kvh * 128, Z + kv0 * NZ + ZV + kvh * 128, MIX + row0 * DM + MXA + hq * 128, seq, F.lds + RING_OFF); } }
                    const float* gg = args.in[16] + (size_t)l * 512;
                    if (EN(16)) for (int w = gw; w < NCH * 16; w += NGW) { const int chunk = w >> 4, c = chunk % CHB; if (last && c < 2) continue; gla_c_item(Z, (const bf16*)(ws + WS_QG), (const bf16*)(ws + WS_ST), MIX, chunk, (w >> 2) & 3, w & 3, gg, F.lane); }
                }
                SEAM(pb + 7);
                if (EN(7) && IN(pb + 8)) { WSP(); float* ctxres = (float*)(ws + WS_CTXRES);
                    pg8::Gemm g{(const bf16*)(ws + WS_MIX), (const bf16*)(ws + WS_W + (size_t)l * W_LAYER + W_OUT), M_ALL, DM, DM}; pg8::PanelOrder S; S.init(last ? NPAN - 2 : NPAN, DM / 256, F.G, (int)blockIdx.x, last);
                    pg8::EpiResid E{args.out, ctxres, args.out, ctxres, (const float*)(ws + WS_MOD) + (size_t)l * 3 * MODW, 5, 1.0f};
                    pg8::gemm_phase<pg8::EpiResid, pg8::PanelOrder, true, true>(F.lds + RING_OFF, g, S, E);
                }
                SEAM(pb + 8);
            }
            const int pf = pb + 9 * half, sub = 2 * half, first = (l == 0 && half == 0) ? 1 : 0, skipc = (last && half == 1) ? 1 : 0;
            if (EN(8) && IN(pf + 0)) { FRESH(); WSP(); const float* blat = first ? args.in[0] : args.out; const float* bctx = first ? args.in[2] : (const float*)(ws + WS_CTXRES);
                norm_phase(F, blat, bctx, args.in[6] + (size_t)(l * 3 + sub) * DM, (const float*)(ws + WS_MOD) + (size_t)l * 3 * MODW, sub, (bf16*)(ws + WS_XN), skipc); }
            SEAM(pf + 0);
            if (EN(9) && IN(pf + 1)) { WSP();
                pg8::Gemm g{(const bf16*)(ws + WS_XN), (const bf16*)(ws + WS_W + (size_t)l * W_LAYER + (half ? W_GU2 : W_GU1)), M_ALL, NGU, DM}; pg8::PanelOrder S; S.init(skipc ? NPAN - 2 : NPAN, NGU / 256, F.G, (int)blockIdx.x, skipc);
                pg8::EpiSwiglu E{(bf16*)(ws + WS_H), DFF};
                pg8::gemm_phase<pg8::EpiSwiglu, pg8::PanelOrder, true, true>(F.lds + RING_OFF, g, S, E);
            }
            SEAM(pf + 1);
            if (EN(10) && IN(pf + 2)) { WSP(); float* ctxres = (float*)(ws + WS_CTXRES); const float* blat = first ? args.in[0] : args.out; const float* bctx = first ? args.in[2] : ctxres;
                pg8::Gemm g{(const bf16*)(ws + WS_H), (const bf16*)(ws + WS_W + (size_t)l * W_LAYER + (half ? W_D2 : W_D1)), M_ALL, DM, DFF}; pg8::PanelOrder S; S.init(skipc ? NPAN - 2 : NPAN, DM / 256, F.G, (int)blockIdx.x, skipc);
                pg8::EpiResid E{blat, bctx, args.out, ctxres, (const float*)(ws + WS_MOD) + (size_t)l * 3 * MODW, 3 * sub + 2, 0.5f};
                pg8::gemm_phase<pg8::EpiResid, pg8::PanelOrder, true, true>(F.lds + RING_OFF, g, S, E);
            }
            SEAM(pf + 2);
        }
    }
    if (EN(11) && IN(26)) { FRESH(); final_norm_phase(F, args.out, args.in[20]); }
#undef IN
#undef SEAM
}

#ifndef MK_ONE_LAUNCH
#define MK_ONE_LAUNCH 0
#endif
extern "C" void kernel_launch(void* const* d_in, const int* in_sizes, int n_in, void* d_out, int out_size, void* d_ws, size_t ws_size, hipStream_t stream) {
    static int grid = 0;
    if (grid == 0) {
        if (n_in != 21 || in_sizes[0] != NB * SEQ * DM || out_size != NB * SEQ * DM || ws_size < WS_END) {
            fprintf(stderr, "kernel_launch: shape mismatch: n_in %d in0 %d out %d ws %zu (need %zu)\n", n_in, n_in > 0 ? in_sizes[0] : -1, out_size, ws_size, (size_t)WS_END); grid = -1; return; }
        int dev = 0, cus = 0, per_cu = 0;
        if (hipGetDevice(&dev) != hipSuccess || hipDeviceGetAttribute(&cus, hipDeviceAttributeMultiprocessorCount, dev) != hipSuccess) { fprintf(stderr, "kernel_launch: device query failed\n"); grid = -1; return; }
        if (hipFuncSetAttribute((const void*)fwd_kernel, hipFuncAttributeMaxDynamicSharedMemorySize, LDS_BYTES) != hipSuccess) { fprintf(stderr, "kernel_launch: hipFuncSetAttribute failed\n"); grid = -1; return; }
        if (hipOccupancyMaxActiveBlocksPerMultiprocessor(&per_cu, (const void*)fwd_kernel, NWAVES * 64, LDS_BYTES) != hipSuccess || per_cu < 1)
            fprintf(stderr, "kernel_launch: note: occupancy query reports %d workgroups per CU\n", per_cu);
        (void)hipGetLastError();
        grid = cus;
    }
    if (grid < 0) return;
    if (hipMemsetAsync((char*)d_ws + WS_CTL, 0, CTL_ZERO_BYTES, stream) != hipSuccess) { fprintf(stderr, "kernel_launch: memset failed\n"); return; }
    Args a{};
    for (int i = 0; i < 21; ++i) a.in[i] = (const float*)d_in[i];
    a.out = (float*)d_out; a.ws = (unsigned char*)d_ws;
#if MK_ONE_LAUNCH
    a.ph_lo = 0; a.ph_hi = N_PHASES;
    hipLaunchKernelGGL(fwd_kernel, dim3(grid), dim3(NWAVES * 64), LDS_BYTES, stream, a);
#else
#ifndef PHLIMIT
#define PHLIMIT N_PHASES
#endif
    for (int p = 0; p < N_PHASES; ++p) { if (!(p < PHLIMIT || p == N_PHASES - 1)) continue; a.ph_lo = p; a.ph_hi = p + 1; hipLaunchKernelGGL(fwd_kernel, dim3(grid), dim3(NWAVES * 64), LDS_BYTES, stream, a); }
#endif
    const hipError_t le = hipPeekAtLastError();
    if (le != hipSuccess) fprintf(stderr, "kernel_launch: launch failed: %s\n", hipGetErrorName(le));
}
```

```cpp
#include <hip/hip_runtime.h>
#include <cstdio>
#include <cstdint>
#include <cmath>
namespace pg8 {
#define PG8_LAS __attribute__((address_space(3)))
typedef unsigned short bf16_t;
typedef short bf16x8 __attribute__((ext_vector_type(8)));
typedef float f32x4 __attribute__((ext_vector_type(4)));
typedef unsigned u32x4 __attribute__((ext_vector_type(4)));
constexpr int BM = 256, BK = 64, HALF = 128, HTB = HALF * BK * 2  , STAGE_BYTES = 8 * HTB, NXCD = 8, WGM = 4;

__host__ __device__ __forceinline__ int lds_byte(int r, int c) { const int st = (r >> 4) * 2 + (c >> 5), rr = r & 15, cc = c & 31, ob = rr * 64 + cc * 2; return st * 1024 + (ob ^ (((ob >> 9) & 1) << 5)); }
__host__ __device__ __forceinline__ void stage_rc(int b, int& R, int& C) { const int st = b / 1024, sb = b % 1024, swz = sb ^ (((sb >> 9) & 1) << 5); R = (st >> 1) * 16 + swz / 64; C = (st & 1) * 32 + (swz % 64) / 2; }
__host__ __device__ __forceinline__ int perm32(int rho) { const int n = rho >> 4, i = rho & 15; return 8 * (i >> 2) + 4 * n + (i & 3); }

struct Unit { int pm, pn, ko, ks; };
struct Gemm { const bf16_t* A; const bf16_t* Bt; int M, N, K, ld; };

struct StaticOrder {
    static constexpr bool DYN = false;
    int nM, nN, nwg, G, c;
    __host__ __device__ void init(int M, int N, int G_, int c_) { nM = M / BM; nN = N / BM; nwg = nM * nN; G = G_; c = c_; }
    __host__ __device__ bool next(int i, Unit& u) const {
        const long L = (long)i * G + c; if (L >= nwg) return false;
        int wgid = (int)L; { const int q = nwg / NXCD, r = nwg % NXCD, xcd = wgid % NXCD, off = wgid / NXCD; wgid = (xcd < r ? xcd * (q + 1) : r * (q + 1) + (xcd - r) * q) + off; }
        const int nig = WGM * nN, gid = wgid / nig, fm = gid * WGM, gsz = (nM - fm) < WGM ? (nM - fm) : WGM;
        u.pm = fm + ((wgid % nig) % gsz); u.pn = (wgid % nig) / gsz; u.ko = 0; u.ks = 0; return true;
    }
    __device__ __forceinline__ void a_ready(const Unit&) const {}
    __device__ __forceinline__ void done(const Unit&) const {}
};

typedef float f32x2c_t __attribute__((ext_vector_type(2))); typedef __bf16 bf16x2c_t __attribute__((ext_vector_type(2)));
__device__ __forceinline__ unsigned cvt_pk_bf16(float lo, float hi) { f32x2c_t v = {lo, hi}; bf16x2c_t b = __builtin_convertvector(v, bf16x2c_t); return __builtin_bit_cast(unsigned, b); }
typedef float f32x2 __attribute__((ext_vector_type(2)));
constexpr int PAN_PER_B = 65, RES_LD = 2048;
__device__ __forceinline__ int panel_set(int pm) { const int b = pm / PAN_PER_B, jp = pm - b * PAN_PER_B; return jp == 0 ? 2 : b; }
template <class T> __device__ __forceinline__ T* panel_ptr(T* lat, T* ctx, int pm) {
    const int b = pm / PAN_PER_B, jp = pm - b * PAN_PER_B;
    return jp == 0 ? ctx + (size_t)b * 256 * RES_LD : lat + ((size_t)b * 16384 + (size_t)(jp - 1) * 256) * RES_LD;
}
struct PanelOrder {
    static constexpr bool DYN = true;
    int nM, nN, nwg, G, c, skip, rev;
    unsigned* dyn; volatile PG8_LAS unsigned* slot;
    __device__ void init(int nM_, int nN_, int G_, int c_, int skip_) { nM = nM_; nN = nN_; nwg = nM * nN; G = G_; c = c_; skip = skip_; rev = 0; dyn = nullptr; slot = nullptr; }
    __device__ bool is_dyn(int i) const { return dyn != nullptr && rev == 0 && (nwg % G) != 0 && i == nwg / G; }
    __device__ void dyn_request(int lane) const { if (lane == 0) { const unsigned k = __hip_atomic_fetch_add(dyn, 1u, __ATOMIC_RELAXED, __HIP_MEMORY_SCOPE_AGENT); *slot = k; } }
    __device__ bool dyn_fetch(Unit& u) const { const unsigned k = *slot; const long L = (long)(nwg / G) * G + (long)k; if (L >= nwg) return false; return map(L, u); }
    __device__ void reverse_rounds() { rev = (nwg % G == 0) ? nwg / G : 0; }
    __device__ bool next(int i, Unit& u) const {
        if (rev) { if (i >= rev) return false; i = rev - 1 - i; }
        const long L = (long)i * G + c; if (L >= nwg) return false;
        return map(L, u);
    }
    __device__ bool map(long L, Unit& u) const {
        int wgid = (int)L; { const int q = nwg / NXCD, r = nwg % NXCD, xcd = wgid % NXCD, off = wgid / NXCD; wgid = (xcd < r ? xcd * (q + 1) : r * (q + 1) + (xcd - r) * q) + off; }
        const int nig = WGM * nN, gid = wgid / nig, fm = gid * WGM, gsz = (nM - fm) < WGM ? (nM - fm) : WGM;
        int pm = fm + ((wgid % nig) % gsz); u.pn = (wgid % nig) / gsz;
        if (skip) pm += 1 + (pm >= 64 ? 1 : 0);
        u.pm = pm; u.ko = 0; u.ks = 0; return true;
    }
    __device__ __forceinline__ void a_ready(const Unit&) const {}
    __device__ __forceinline__ void done(const Unit&) const {}
};
struct EpiBf16Plain {
    static constexpr bool PERM = true, AFTER_DRAIN = false;
    bf16_t* O; int ldc;
    __device__ __forceinline__ void operator()(const f32x4 (&acc)[2][2][4][2], const Unit& u, int wr, int wc, int fr, int fq) const {
        const int row0 = u.pm * BM + wr * 64 + fr, col0 = u.pn * BM + wc * 32 + 8 * fq;
#pragma unroll
        for (int ai = 0; ai < 2; ++ai)
#pragma unroll
            for (int m = 0; m < 4; ++m) { bf16_t* rowp = O + (size_t)(row0 + ai * HALF + m * 16) * ldc + col0;
#pragma unroll
                for (int bj = 0; bj < 2; ++bj) { const f32x4 v0 = acc[ai][bj][m][0], v1 = acc[ai][bj][m][1];
                    u32x4 w; w.x = cvt_pk_bf16(v0[0], v0[1]); w.y = cvt_pk_bf16(v0[2], v0[3]); w.z = cvt_pk_bf16(v1[0], v1[1]); w.w = cvt_pk_bf16(v1[2], v1[3]);
                    *(u32x4*)(rowp + bj * HALF) = w; } }
    }
};
__device__ __forceinline__ float silu_f(float g) { return g * __builtin_amdgcn_rcpf(1.0f + __builtin_amdgcn_exp2f(-1.4426950408889634f * g)); }
struct EpiSwiglu {
    static constexpr bool PERM = true, AFTER_DRAIN = false;
    bf16_t* H; int ldh;
    __device__ __forceinline__ void operator()(const f32x4 (&acc)[2][2][4][2], const Unit& u, int wr, int wc, int fr, int fq) const {
        const int row0 = u.pm * BM + wr * 64 + fr, col0 = u.pn * HALF + wc * 32 + 8 * fq;
#pragma unroll
        for (int ai = 0; ai < 2; ++ai)
#pragma unroll
            for (int m = 0; m < 4; ++m) { bf16_t* rowp = H + (size_t)(row0 + ai * HALF + m * 16) * ldh + col0;
                const f32x4 g0 = acc[ai][0][m][0], g1 = acc[ai][0][m][1], u0 = acc[ai][1][m][0], u1 = acc[ai][1][m][1];
                u32x4 w; w.x = cvt_pk_bf16(silu_f(g0[0]) * u0[0], silu_f(g0[1]) * u0[1]); w.y = cvt_pk_bf16(silu_f(g0[2]) * u0[2], silu_f(g0[3]) * u0[3]);
                w.z = cvt_pk_bf16(silu_f(g1[0]) * u1[0], silu_f(g1[1]) * u1[1]); w.w = cvt_pk_bf16(silu_f(g1[2]) * u1[2], silu_f(g1[3]) * u1[3]);
                __builtin_nontemporal_store(w, (u32x4*)rowp); }
    }
};
typedef _Float16 h16x2 __attribute__((ext_vector_type(2)));
__device__ __forceinline__ unsigned pk_h16(float lo, float hi) { const _Float16 a = (_Float16)lo, b = (_Float16)hi; return (unsigned)__builtin_bit_cast(unsigned short, a) | ((unsigned)__builtin_bit_cast(unsigned short, b) << 16); }
__device__ __forceinline__ void unpack8(const u32x4 w, float (&y)[8]) {
    const unsigned wx = w.x, wy = w.y, wz = w.z, ww = w.w;
    const h16x2 a = __builtin_bit_cast(h16x2, wx), b = __builtin_bit_cast(h16x2, wy), c = __builtin_bit_cast(h16x2, wz), d = __builtin_bit_cast(h16x2, ww);
    y[0] = (float)a[0]; y[1] = (float)a[1]; y[2] = (float)b[0]; y[3] = (float)b[1]; y[4] = (float)c[0]; y[5] = (float)c[1]; y[6] = (float)d[0]; y[7] = (float)d[1]; }
struct EpiResid {
    static constexpr bool PERM = true, AFTER_DRAIN = false;
    const float* base_f32  ; float* out_f32  ; bf16_t* res  ;
    const float* gate  ; int gidx; float scale;
    __device__ __forceinline__ void operator()(const f32x4 (&acc)[2][2][4][2], const Unit& u, int wr, int wc, int fr, int fq) const {
        const int col0 = u.pn * BM + wc * 32 + 8 * fq, set = panel_set(u.pm), r0 = wr * 64 + fr;
        const float* gp = gate + (size_t)(set * 9 + gidx) * 2048 + col0;
        f32x4 gv[2][2];
#pragma unroll
        for (int bj = 0; bj < 2; ++bj)
#pragma unroll
            for (int n = 0; n < 2; ++n) gv[bj][n] = *(const f32x4*)(gp + bj * HALF + n * 4) * scale;
        bf16_t* rp = res + ((size_t)u.pm * BM + r0) * RES_LD + col0;
        const float* bf = base_f32 ? panel_ptr(base_f32, base_f32, u.pm) + (size_t)r0 * RES_LD + col0 : nullptr;
        float* of = out_f32 ? panel_ptr(out_f32, out_f32, u.pm) + (size_t)r0 * RES_LD + col0 : nullptr;
        f32x4 cur[2][2], nxt[2][2];
        if (bf) {
#pragma unroll
            for (int bj = 0; bj < 2; ++bj)
#pragma unroll
                for (int n = 0; n < 2; ++n) cur[bj][n] = *(const f32x4*)(bf + bj * HALF + n * 4);
        } else {
#pragma unroll
            for (int bj = 0; bj < 2; ++bj) { float y[8]; unpack8(*(const u32x4*)(rp + bj * HALF), y); cur[bj][0] = (f32x4){y[0], y[1], y[2], y[3]}; cur[bj][1] = (f32x4){y[4], y[5], y[6], y[7]}; }
        }
#pragma unroll
        for (int g = 0; g < 8; ++g) { const int ai = g >> 2, m = g & 3; const size_t off = (size_t)(ai * HALF + m * 16) * RES_LD;
            if (g < 7) { const size_t offn = (size_t)(((g + 1) >> 2) * HALF + ((g + 1) & 3) * 16) * RES_LD;
                if (bf) {
#pragma unroll
                    for (int bj = 0; bj < 2; ++bj)
#pragma unroll
                        for (int n = 0; n < 2; ++n) nxt[bj][n] = *(const f32x4*)(bf + offn + bj * HALF + n * 4);
                } else {
#pragma unroll
                    for (int bj = 0; bj < 2; ++bj) { float y[8]; unpack8(*(const u32x4*)(rp + offn + bj * HALF), y); nxt[bj][0] = (f32x4){y[0], y[1], y[2], y[3]}; nxt[bj][1] = (f32x4){y[4], y[5], y[6], y[7]}; }
                } }
#pragma unroll
            for (int bj = 0; bj < 2; ++bj) { const f32x4 o0 = cur[bj][0] + gv[bj][0] * acc[ai][bj][m][0], o1 = cur[bj][1] + gv[bj][1] * acc[ai][bj][m][1];
                if (of) { *(f32x4*)(of + off + bj * HALF) = o0; *(f32x4*)(of + off + bj * HALF + 4) = o1; }
                else { u32x4 w; w.x = pk_h16(o0[0], o0[1]); w.y = pk_h16(o0[2], o0[3]); w.z = pk_h16(o1[0], o1[1]); w.w = pk_h16(o1[2], o1[3]); *(u32x4*)(rp + off + bj * HALF) = w; } }
            asm volatile("" ::: "memory");
#pragma unroll
            for (int bj = 0; bj < 2; ++bj)
#pragma unroll
                for (int n = 0; n < 2; ++n) cur[bj][n] = nxt[bj][n]; }
    }
};

struct CtxSplitOrder {
    static constexpr bool DYN = false;
    int nN, NS, Ks, nwg, G, c;
    unsigned* dyn; volatile PG8_LAS unsigned* slot;
    __device__ void init(int nN_, int NS_, int Ks_, int G_, int c_) { nN = nN_; NS = NS_; Ks = Ks_; nwg = 2 * nN * NS; G = G_; c = c_; dyn = nullptr; slot = nullptr; }
    __device__ bool next(int i, Unit& u) const {
        int L;
        if (dyn != nullptr && nwg <= G) {
            if (i != 0) return false;
            if (threadIdx.x == 0) *slot = __hip_atomic_fetch_add(dyn, 1u, __ATOMIC_RELAXED, __HIP_MEMORY_SCOPE_AGENT);
            __syncthreads(); L = (int)*slot;
        } else L = i * G + c;
        if (L >= nwg) return false;
        const int ks = L % NS, t = L / NS; u.pn = t % nN; u.pm = (t / nN) * PAN_PER_B; u.ks = ks; u.ko = ks * Ks; return true;
    }
    __device__ __forceinline__ void a_ready(const Unit&) const {}
    __device__ __forceinline__ void done(const Unit&) const {}
};
struct EpiCtxPartial {
    static constexpr bool PERM = false, AFTER_DRAIN = false;
    float* part  ; const float* gate  ; int gidx; float scale;
    __device__ __forceinline__ void operator()(const f32x4 (&acc)[2][2][4][2], const Unit& u, int wr, int wc, int fr, int fq) const {
        const int col0 = u.pn * BM + wc * 32 + 4 * fq, b = u.pm / PAN_PER_B;
        float* out = part + ((size_t)u.ks * 512 + (size_t)b * 256) * RES_LD;
        const float* gp = gate + (size_t)(2 * 9 + gidx) * 2048 + col0;
        f32x4 gv[2][2];
#pragma unroll
        for (int bj = 0; bj < 2; ++bj)
#pragma unroll
            for (int n = 0; n < 2; ++n) gv[bj][n] = *(const f32x4*)(gp + bj * HALF + n * 16) * scale;
#pragma unroll
        for (int ai = 0; ai < 2; ++ai)
#pragma unroll
            for (int m = 0; m < 4; ++m) { const size_t off = (size_t)(ai * HALF + wr * 64 + m * 16 + fr) * RES_LD + col0;
#pragma unroll
                for (int bj = 0; bj < 2; ++bj)
#pragma unroll
                    for (int n = 0; n < 2; ++n) *(f32x4*)(out + off + bj * HALF + n * 16) = gv[bj][n] * acc[ai][bj][m][n]; }
    }
};
template <class Epi, class Sched, bool ALIGN_EPI = false, bool SP2 = false>
__device__ __forceinline__ void gemm_phase(PG8_LAS unsigned char* lds, const Gemm g, const Sched& S, const Epi& E) {
    int tid_ = threadIdx.x; asm volatile("" : "+v"(tid_));
    const int tid = tid_, wid = __builtin_amdgcn_readfirstlane(tid >> 6), lane = tid & 63, wr = wid >> 2, wc = wid & 3, fr = lane & 15, fq = lane >> 4;
    const int K = g.K, ld = g.ld, nt = K / BK;
    unsigned voffA[2], voffB[2];
#pragma unroll
    for (int i = 0; i < 2; ++i) { int R, C; stage_rc(tid * 16 + i * 8192, R, C); const int Rb = Epi::PERM ? ((R & ~31) + perm32(R & 31)) : R;
        voffA[i] = (unsigned)(R * ld + C) * 2u; voffB[i] = (unsigned)(Rb * ld + C) * 2u; }
    const size_t kstep = (size_t)(BK * 2);
    const size_t hstep = (size_t)HALF * ld * 2;
    const size_t tstep = 2 * hstep;
    const unsigned ldsw = (unsigned)wid * 1024u;
    const int aoff = lds_byte(wr * 64 + fr, fq * 8), boff = lds_byte(wc * 32 + fr, fq * 8);
#define PG8_SA(b, h) (((b) * 2 + (h)) * HTB)
#define PG8_SB(b, h) ((4 + (b) * 2 + (h)) * HTB)
#define PG8_STAGE(bufoff, gbase, voff) do { _Pragma("unroll") for (int _i = 0; _i < 2; ++_i) \
        __builtin_amdgcn_global_load_lds((const unsigned*)((const char*)(gbase) + (voff)[_i]), (PG8_LAS unsigned*)(lds + (bufoff) + ldsw + _i * 8192), 16, 0, 0); } while (0)
#define PG8_LDA(dst, b, h) do { _Pragma("unroll") for (int m = 0; m < 4; ++m) _Pragma("unroll") for (int k = 0; k < 2; ++k) dst[m][k] = *(const PG8_LAS bf16x8*)(lds + PG8_SA(b, h) + aoff + m * 2048 + k * 1024); } while (0)
#define PG8_LDB(dst, b, h) do { _Pragma("unroll") for (int n = 0; n < 2; ++n) _Pragma("unroll") for (int k = 0; k < 2; ++k) dst[n][k] = *(const PG8_LAS bf16x8*)(lds + PG8_SB(b, h) + boff + n * 2048 + k * 1024); } while (0)
#define PG8_MMA(ai, bj, At, Bt) do { __builtin_amdgcn_s_setprio(1); _Pragma("unroll") for (int m = 0; m < 4; ++m) _Pragma("unroll") for (int n = 0; n < 2; ++n) _Pragma("unroll") for (int k = 0; k < 2; ++k) \
        acc[ai][bj][m][n] = __builtin_amdgcn_mfma_f32_16x16x32_bf16(Bt[n][k], At[m][k], acc[ai][bj][m][n], 0, 0, 0); __builtin_amdgcn_s_setprio(0); } while (0)
#define PG8_WAIT_V(n) asm volatile("s_waitcnt vmcnt(" #n ")" ::: "memory")
#define PG8_WAIT_L(n) asm volatile("s_waitcnt lgkmcnt(" #n ")" ::: "memory")
#define PG8_BAR __builtin_amdgcn_s_barrier()
#define PG8_SCHED __builtin_amdgcn_sched_barrier(0)
    Unit cur, nxt; int ui = 0;
    if (!S.next(0, cur)) return;
    f32x4 acc[2][2][4][2];
#pragma unroll
    for (int a = 0; a < 2; ++a)
#pragma unroll
        for (int b = 0; b < 2; ++b)
#pragma unroll
            for (int m = 0; m < 4; ++m)
#pragma unroll
                for (int n = 0; n < 2; ++n) acc[a][b][m][n] = (f32x4){0.f, 0.f, 0.f, 0.f};
    bf16x8 At[4][2], B0[2][2], B1[2][2];
    const char* cA = (const char*)g.A + (size_t)cur.pm * tstep + (size_t)cur.ko * 2; const char* cB = (const char*)g.Bt + (size_t)cur.pn * tstep + (size_t)cur.ko * 2;
    S.a_ready(cur);
    if constexpr (SP2) {
        PG8_STAGE(PG8_SB(0, 0), cB, voffB); PG8_STAGE(PG8_SB(0, 1), cB + hstep, voffB); PG8_STAGE(PG8_SA(0, 0), cA, voffA); PG8_STAGE(PG8_SA(0, 1), cA + hstep, voffA);
        if (wr == 1) PG8_BAR;
        PG8_WAIT_V(2); PG8_BAR;
        PG8_STAGE(PG8_SB(1, 0), cB + kstep, voffB); PG8_STAGE(PG8_SA(1, 0), cA + kstep, voffA); PG8_STAGE(PG8_SB(1, 1), cB + hstep + kstep, voffB);
        PG8_WAIT_V(6); PG8_BAR;
    } else {
        PG8_STAGE(PG8_SB(0, 0), cB, voffB); PG8_STAGE(PG8_SA(0, 0), cA, voffA); PG8_STAGE(PG8_SB(0, 1), cB + hstep, voffB); PG8_STAGE(PG8_SA(0, 1), cA + hstep, voffA);
        if (wr == 1) PG8_BAR;
        PG8_WAIT_V(4); PG8_BAR;
        PG8_STAGE(PG8_SB(1, 0), cB + kstep, voffB); PG8_STAGE(PG8_SA(1, 0), cA + kstep, voffA); PG8_STAGE(PG8_SB(1, 1), cB + hstep + kstep, voffB);
        PG8_WAIT_V(6); PG8_BAR;
    }
    for (;;) {
        bool has_next, pending = false;
        if constexpr (Sched::DYN) { if (S.is_dyn(ui + 1)) { pending = true; has_next = true; if (wid == 0) S.dyn_request(lane); } else has_next = S.next(ui + 1, nxt); }
        else has_next = S.next(ui + 1, nxt);
        const char* nA = cA; const char* nB = cB;
        if (has_next && !pending) { nA = (const char*)g.A + (size_t)nxt.pm * tstep + (size_t)nxt.ko * 2; nB = (const char*)g.Bt + (size_t)nxt.pn * tstep + (size_t)nxt.ko * 2; }
        for (int t = 0; t < nt; t += 2) {
            const bool last = (t == nt - 2);
            if constexpr (Sched::DYN) { if (last && pending) { pending = false; has_next = S.dyn_fetch(nxt);
                if (has_next) { nA = (const char*)g.A + (size_t)nxt.pm * tstep + (size_t)nxt.ko * 2; nB = (const char*)g.Bt + (size_t)nxt.pn * tstep + (size_t)nxt.ko * 2; } } }
            const char* a1 = cA + (size_t)(t + 1) * kstep;
            const char* a2 = last ? nA : cA + (size_t)(t + 2) * kstep; const char* b2 = last ? nB : cB + (size_t)(t + 2) * kstep;
            const char* a3 = a2 + kstep; const char* b3 = b2 + kstep;
            if (last && has_next) S.a_ready(nxt);
            if constexpr (SP2) {
            PG8_LDB(B0, 0, 0); PG8_LDB(B1, 0, 1); PG8_SCHED; PG8_LDA(At, 0, 0); PG8_STAGE(PG8_SA(1, 1), a1 + hstep, voffA);
            PG8_WAIT_V(8); PG8_WAIT_L(0); PG8_BAR; PG8_MMA(0, 0, At, B0); PG8_MMA(0, 1, At, B1); PG8_BAR; PG8_SCHED;
            PG8_LDA(At, 0, 1); PG8_STAGE(PG8_SB(0, 0), b2, voffB); PG8_STAGE(PG8_SB(0, 1), b2 + hstep, voffB); PG8_STAGE(PG8_SA(0, 0), a2, voffA);
            PG8_WAIT_V(8); PG8_WAIT_L(0); PG8_BAR; PG8_MMA(1, 0, At, B0); PG8_MMA(1, 1, At, B1); PG8_BAR; PG8_SCHED;
            PG8_LDB(B0, 1, 0); PG8_LDB(B1, 1, 1); PG8_SCHED; PG8_LDA(At, 1, 0); PG8_STAGE(PG8_SA(0, 1), a2 + hstep, voffA);
            PG8_WAIT_V(8); PG8_WAIT_L(0); PG8_BAR; PG8_MMA(0, 0, At, B0); PG8_MMA(0, 1, At, B1); PG8_BAR; PG8_SCHED;
            PG8_LDA(At, 1, 1); PG8_STAGE(PG8_SB(1, 0), b3, voffB); PG8_STAGE(PG8_SB(1, 1), b3 + hstep, voffB); PG8_STAGE(PG8_SA(1, 0), a3, voffA);
            PG8_WAIT_V(8); PG8_WAIT_L(0); PG8_BAR; PG8_MMA(1, 0, At, B0); PG8_MMA(1, 1, At, B1); PG8_BAR; PG8_SCHED;
            } else {
            PG8_LDB(B0, 0, 0); PG8_SCHED; PG8_LDA(At, 0, 0); PG8_STAGE(PG8_SA(1, 1), a1 + hstep, voffA);
            PG8_WAIT_L(8); PG8_BAR; PG8_WAIT_L(0); PG8_MMA(0, 0, At, B0); PG8_BAR; PG8_SCHED;
            PG8_LDB(B1, 0, 1); PG8_STAGE(PG8_SB(0, 0), b2, voffB);
            PG8_BAR; PG8_WAIT_L(0); PG8_MMA(0, 1, At, B1); PG8_BAR;
            PG8_LDA(At, 0, 1); PG8_STAGE(PG8_SA(0, 0), a2, voffA);
            PG8_BAR; PG8_WAIT_L(0); PG8_MMA(1, 0, At, B0); PG8_BAR; PG8_SCHED;
            PG8_STAGE(PG8_SB(0, 1), b2 + hstep, voffB);
            PG8_WAIT_V(6); PG8_BAR; PG8_MMA(1, 1, At, B1); PG8_BAR;
            PG8_LDB(B0, 1, 0); PG8_SCHED; PG8_LDA(At, 1, 0); PG8_STAGE(PG8_SA(0, 1), a2 + hstep, voffA);
            PG8_WAIT_L(8); PG8_BAR; PG8_WAIT_L(0); PG8_MMA(0, 0, At, B0); PG8_BAR; PG8_SCHED;
            PG8_LDB(B1, 1, 1); PG8_STAGE(PG8_SB(1, 0), b3, voffB);
            PG8_BAR; PG8_WAIT_L(0); PG8_MMA(0, 1, At, B1); PG8_BAR;
            PG8_LDA(At, 1, 1); PG8_STAGE(PG8_SA(1, 0), a3, voffA);
            PG8_BAR; PG8_WAIT_L(0); PG8_MMA(1, 0, At, B0); PG8_BAR; PG8_SCHED;
            PG8_STAGE(PG8_SB(1, 1), b3 + hstep, voffB);
            PG8_WAIT_V(6); PG8_BAR; PG8_MMA(1, 1, At, B1); PG8_BAR;
            }
        }
        if constexpr (ALIGN_EPI) { if (wr == 0) PG8_BAR; }
        if constexpr (!Epi::AFTER_DRAIN) { E(acc, cur, wr, wc, fr, fq); S.done(cur); }
        if (!has_next) break;
#pragma unroll
        for (int a = 0; a < 2; ++a)
#pragma unroll
            for (int b = 0; b < 2; ++b)
#pragma unroll
                for (int m = 0; m < 4; ++m)
#pragma unroll
                    for (int n = 0; n < 2; ++n) acc[a][b][m][n] = (f32x4){0.f, 0.f, 0.f, 0.f};
        cur = nxt; cA = nA; cB = nB; ++ui;
        if constexpr (ALIGN_EPI) { if (wr == 1) PG8_BAR; }
    }
    PG8_WAIT_V(0);
    if constexpr (!ALIGN_EPI) { if (wr == 0) PG8_BAR; }
    PG8_BAR;
    if constexpr (Epi::AFTER_DRAIN) { E.fused(acc, cur, wr, wc, fr, fq, lds, wid, lane); S.done(cur); }
#undef PG8_SA
#undef PG8_SB
#undef PG8_STAGE
#undef PG8_LDA
#undef PG8_LDB
#undef PG8_MMA
#undef PG8_WAIT_V
#undef PG8_WAIT_L
#undef PG8_BAR
#undef PG8_SCHED
}
}
#define GAS __attribute__((address_space(1)))
#define LAS __attribute__((address_space(3)))
typedef unsigned short bf16;
typedef unsigned v4u __attribute__((ext_vector_type(4)));
typedef float f32x4 __attribute__((ext_vector_type(4)));
typedef short bf16x8 __attribute__((ext_vector_type(8)));
typedef GAS unsigned gu32;
typedef GAS unsigned long long gu64;
#define RLX_AGENT __ATOMIC_RELAXED, __HIP_MEMORY_SCOPE_AGENT
#define LDS_WAIT() asm volatile("s_waitcnt lgkmcnt(0)" ::: "memory")
#define VM_WAIT() asm volatile("s_waitcnt vmcnt(0)" ::: "memory")
__device__ __forceinline__ unsigned long long rt() { return __builtin_amdgcn_s_memrealtime(); }
__device__ __forceinline__ unsigned f2bf(float f) { unsigned u = __builtin_bit_cast(unsigned, f); return (u + 0x7fffu + ((u >> 16) & 1u)) >> 16; }
__device__ __forceinline__ unsigned pk2(float lo, float hi) { return f2bf(lo) | (f2bf(hi) << 16); }

#define XB_TMO      128
#define XB_XCNT(j)  (256  + 64 * (j))
#define XB_XSUB(j)  (1280 + 64 * (j))
#define XB_XGEN(j)  (2304 + 64 * (j))
#define XB_TOP      3328
#define XB_TOPGEN   3392
#define XCD_BAR_WORDS 3456
#define XB_SPIN_CAP (1u << 18)

__device__ __forceinline__ unsigned xb_ld(unsigned* p)              { return __hip_atomic_load(p, __ATOMIC_RELAXED, __HIP_MEMORY_SCOPE_AGENT); }
__device__ __forceinline__ unsigned xb_add(unsigned* p, unsigned v) { return __hip_atomic_fetch_add(p, v, __ATOMIC_RELAXED, __HIP_MEMORY_SCOPE_AGENT); }
__device__ __forceinline__ unsigned xb_xcc_id() { return (unsigned)__builtin_amdgcn_s_getreg((3 << 11) | 20) & 0xFu; }
#define XB_SPIN(cond, bar) do { unsigned _sp = 0; while (cond) { __builtin_amdgcn_s_sleep(1); \
    if ((++_sp & 255u) == 0u) { if (xb_ld(&(bar)[XB_TMO])) break; if (_sp > XB_SPIN_CAP) { atomicAdd(&(bar)[XB_TMO], 1u); break; } } } } while (0)

struct XcdBarrier {
    unsigned* bar; unsigned x;
    volatile LAS unsigned* st;
};

__device__ __forceinline__ XcdBarrier xcd_barrier_post(unsigned* bar, volatile LAS unsigned* st) {
    XcdBarrier b; b.bar = bar; b.x = xb_xcc_id(); b.st = st;
    if (threadIdx.x == 0) (void)xb_add(&bar[XB_XCNT(b.x)], 1u);
    return b;
}
__device__ __forceinline__ void xcd_barrier_complete(unsigned* bar, unsigned x, unsigned& nloc, unsigned& nx) {
    const unsigned G = gridDim.x * gridDim.y * gridDim.z;
    unsigned sum, cnt, mine, sp = 0u;
    for (;;) {
        sum = 0u; cnt = 0u; mine = 0u;
#pragma unroll
        for (unsigned j = 0; j < 16; ++j) { const unsigned c = xb_ld(&bar[XB_XCNT(j)]); sum += c; cnt += (c > 0u) ? 1u : 0u; mine = (j == x) ? c : mine; }
        if (sum == G) break;
        __builtin_amdgcn_s_sleep(1);
        if ((++sp & 255u) == 0u) { if (xb_ld(&bar[XB_TMO])) break; if (sp > XB_SPIN_CAP) { atomicAdd(&bar[XB_TMO], 1u); break; } }
    }
    nloc = mine > 0u ? mine : 1u; nx = cnt > 0u ? cnt : 1u;
}

__device__ __forceinline__ void xcd_barrier(const XcdBarrier& b) {
    asm volatile("s_waitcnt vmcnt(0)" ::: "memory");
    __syncthreads();
    if (threadIdx.x == 0) {
        unsigned* bar = b.bar;
        __builtin_amdgcn_s_waitcnt(0);
        unsigned nloc = b.st[0], nx = b.st[1];
        if (nloc == 0u) { xcd_barrier_complete(bar, b.x, nloc, nx); b.st[0] = nloc; b.st[1] = nx; }
        const unsigned old = xb_add(&bar[XB_XSUB(b.x)], 1u);
        const unsigned gen = old / nloc;
        if (old + 1u == (gen + 1u) * nloc) {
            __builtin_amdgcn_fence(__ATOMIC_RELEASE, "agent");
            asm volatile("s_waitcnt vmcnt(0)" ::: "memory");
            const unsigned og = xb_add(&bar[XB_TOP], 1u);
            const unsigned tg = og / nx;
            if (og + 1u == (tg + 1u) * nx) xb_add(&bar[XB_TOPGEN], 1u);
            else XB_SPIN(xb_ld(&bar[XB_TOPGEN]) == tg, bar);
            __builtin_amdgcn_fence(__ATOMIC_ACQUIRE, "agent");
            xb_add(&bar[XB_XGEN(b.x)], 1u);
            asm volatile("s_waitcnt vmcnt(0)" ::: "memory");
        } else {
            XB_SPIN(xb_ld(&bar[XB_XGEN(b.x)]) == gen, bar);
            __builtin_amdgcn_fence(__ATOMIC_ACQUIRE, "agent");
            asm volatile("s_waitcnt vmcnt(0)" ::: "memory");
        }
    }
    __syncthreads();
}

constexpr int NWAVES = 8;
constexpr int DM = 2048, NB = 2, SEQ = 16384, CTXL = 256, DEPTH = 2, DFF = 5632, NMOD = 9;
constexpr int TOKB = SEQ + CTXL;
constexpr int M_ALL = NB * TOKB;
constexpr int NPAN = M_ALL / 256;
constexpr int NGU = 2 * DFF;
constexpr int NZ = 4352;
constexpr int NW_IN = 4128;
constexpr int CHB = TOKB / 128;
constexpr int NCH = NB * CHB;
constexpr int MODW = NMOD * DM;
constexpr float EPSN = 1e-6f;
constexpr int ZQ = 0, ZK = 1024, ZV = 1280, ZGQ = 1536, ZGK = 1792, ZGV = 2048, ZGR = 2560, ZMU = 3072, ZMV = 3584, ZLR = 4096;
constexpr int MXA = 0, MXG = 1024, MXM = 1536;

constexpr size_t MiB = 1u << 20;
constexpr size_t WS_CTL = 0, CTL_ZERO_BYTES = 64 * 1024;
constexpr size_t WS_MODP = 1 * MiB;
constexpr size_t WS_MOD = 5 * MiB;
constexpr size_t WS_ROPE = 6 * MiB;
constexpr size_t WS_CTXRES = 8 * MiB;
constexpr size_t WS_W = 16 * MiB;
constexpr size_t W_GU1 = 0, W_D1 = 44 * MiB, W_GU2 = 66 * MiB, W_D2 = 110 * MiB, W_IN = 132 * MiB, W_OUT = 149 * MiB, W_LAYER = 157 * MiB;
constexpr size_t WS_RES = 330 * MiB;
constexpr size_t WS_MIX = 460 * MiB;
constexpr size_t WS_H = 590 * MiB;
constexpr size_t WS_Z = WS_H;
constexpr size_t WS_UT = WS_H + 277 * MiB;
constexpr size_t WS_ST = 948 * MiB;
constexpr size_t WS_DV = 981 * MiB;
constexpr size_t WS_QG = 982 * MiB;
constexpr size_t WS_PART = 1015 * MiB;
constexpr size_t WS_END = 1031 * MiB;
constexpr int CTX_NS = 4;
static_assert(WS_UT + (size_t)2080 * 8192 * 4 <= WS_H + (size_t)M_ALL * DFF * 2 + MiB, "UT inside the H overlay (+slack below WS_ST)");
static_assert(WS_H + (size_t)M_ALL * DFF * 2 <= WS_ST && WS_UT + (size_t)2080 * 8192 * 4 <= WS_ST, "d_ws map");
constexpr int CW_TMO = 0, CW_BAR = 4096;

constexpr int RING_OFF = 0, RING_BYTES = 139264;
constexpr int LDSCTL_OFF = RING_BYTES, MISC_OFF = LDSCTL_OFF + 320;
constexpr int LDS_BYTES = 147456;

typedef short s16x4 __attribute__((ext_vector_type(4)));
typedef float f32x16 __attribute__((ext_vector_type(16)));
typedef float f32x8 __attribute__((ext_vector_type(8)));
typedef unsigned u32x2 __attribute__((ext_vector_type(2)));
typedef unsigned u32x4 __attribute__((ext_vector_type(4)));
typedef float f32x2_t __attribute__((ext_vector_type(2)));
typedef _Float16 h16x2_t __attribute__((ext_vector_type(2)));
__device__ __forceinline__ unsigned pkh(float lo, float hi) { const _Float16 a = (_Float16)lo, b = (_Float16)hi; return (unsigned)__builtin_bit_cast(unsigned short, a) | ((unsigned)__builtin_bit_cast(unsigned short, b) << 16); }
__device__ __forceinline__ float hlo(unsigned w) { return (float)__builtin_bit_cast(h16x2_t, w)[0]; }
__device__ __forceinline__ float hhi(unsigned w) { return (float)__builtin_bit_cast(h16x2_t, w)[1]; }
__device__ __forceinline__ float bf2f(unsigned short x) { return __uint_as_float((unsigned)x << 16); }
__device__ __forceinline__ float bflo(unsigned w) { return __uint_as_float(w << 16); }
__device__ __forceinline__ float bfhi(unsigned w) { return __uint_as_float(w & 0xffff0000u); }
typedef __bf16 bf16x2_t __attribute__((ext_vector_type(2)));
__device__ __forceinline__ unsigned cvtpk(float lo, float hi) { f32x2_t v = {lo, hi}; bf16x2_t b = __builtin_convertvector(v, bf16x2_t); return __builtin_bit_cast(unsigned, b); }
__device__ __forceinline__ float wave_sum(float v) {
#pragma unroll
    for (int o = 1; o < 64; o <<= 1) v += __shfl_xor(v, o);
    return v;
}
__device__ __forceinline__ int crow(int r, int hi) { return (r & 3) + 8 * (r >> 2) + 4 * hi; }
__device__ __forceinline__ float silu_acc(float x) { return x / (1.0f + __expf(-x)); }

struct Frame {
    LAS unsigned char* lds;
    volatile LAS unsigned* MISC;
    gu32* ctl;
    int tid, lane, wave, vcu, G;
};

__device__ __forceinline__ void p0_transpose_item(const float* W, int K, int N, bf16* WT, int k0, int n0, int orow0, LAS float* scr, int lane) {
#pragma unroll 8
    for (int i = 0; i < 32; ++i) { const int kk = 2 * i + (lane >> 5); scr[kk * 33 + (lane & 31)] = W[(size_t)(k0 + kk) * N + n0 + (lane & 31)]; }
    LDS_WAIT(); asm volatile("" ::: "memory");
    const int c = lane & 7;
#pragma unroll
    for (int j = 0; j < 4; ++j) { const int n = (lane >> 3) + 8 * j; const LAS float* s = scr + (8 * c) * 33 + n;
        v4u o; o.x = pk2(s[0 * 33], s[1 * 33]); o.y = pk2(s[2 * 33], s[3 * 33]); o.z = pk2(s[4 * 33], s[5 * 33]); o.w = pk2(s[6 * 33], s[7 * 33]);
        *(GAS v4u*)(WT + (size_t)(orow0 + n) * K + k0 + 8 * c) = o; }
    LDS_WAIT(); asm volatile("" ::: "memory");
}
__device__ __forceinline__ int gu_row(int n0) { return n0 < DFF ? (n0 / 128) * 256 + (n0 % 128) : ((n0 - DFF) / 128) * 256 + 128 + ((n0 - DFF) % 128); }
__device__ __forceinline__ int win_row(int n0) { return n0 < 3072 ? n0 : (n0 < 3104 ? ZLR + (n0 - 3072) : (n0 < 3616 ? ZMU + (n0 - 3104) : ZMV + (n0 - 3616))); }

struct Args { const float* in[21]; float* out; unsigned char* ws; int ph_lo, ph_hi; };

__device__ __forceinline__ void p0_prologue(Frame& F, const Args& a) {
    LAS float* scr = (LAS float*)(F.lds + RING_OFF + F.wave * 16384);
    const int gw = F.vcu * NWAVES + F.wave, NGW = F.G * NWAVES, lane = F.lane;
    unsigned char* ws = a.ws;
    constexpr int I_GU = (DM / 64) * (NGU / 32), I_D = (DFF / 64) * (DM / 32), I_IN = (DM / 64) * (NW_IN / 32), I_OUT = (DM / 64) * (DM / 32);
    constexpr int I_LAYER = 2 * I_GU + 2 * I_D + I_IN + I_OUT;
    for (int it = gw; it < DEPTH * I_LAYER; it += NGW) {
        const int l = it / I_LAYER; int r = it - l * I_LAYER;
        unsigned char* wl = ws + WS_W + (size_t)l * W_LAYER;
        if (r < 2 * I_GU) { const int f = r / I_GU; r -= f * I_GU; const int nblk = NGU / 32, kb = r / nblk, nb = r % nblk;
            p0_transpose_item(a.in[f ? 9 : 7] + (size_t)l * DM * NGU, DM, NGU, (bf16*)(wl + (f ? W_GU2 : W_GU1)), 64 * kb, 32 * nb, gu_row(32 * nb), scr, lane); continue; }
        r -= 2 * I_GU;
        if (r < 2 * I_D) { const int f = r / I_D; r -= f * I_D; const int nblk = DM / 32, kb = r / nblk, nb = r % nblk;
            p0_transpose_item(a.in[f ? 10 : 8] + (size_t)l * DFF * DM, DFF, DM, (bf16*)(wl + (f ? W_D2 : W_D1)), 64 * kb, 32 * nb, 32 * nb, scr, lane); continue; }
        r -= 2 * I_D;
        if (r < I_IN) { const int nblk = NW_IN / 32, kb = r / nblk, nb = r % nblk;
            p0_transpose_item(a.in[11] + (size_t)l * DM * NW_IN, DM, NW_IN, (bf16*)(wl + W_IN), 64 * kb, 32 * nb, win_row(32 * nb), scr, lane); continue; }
        r -= I_IN;
        { const int nblk = DM / 32, kb = r / nblk, nb = r % nblk;
            p0_transpose_item(a.in[12] + (size_t)l * DM * DM, DM, DM, (bf16*)(wl + W_OUT), 64 * kb, 32 * nb, 32 * nb, scr, lane); }
    }
    {
        const int per_layer = (NZ - NW_IN) * DM / 8;
        for (int i = gw * 64 + lane; i < DEPTH * per_layer; i += NGW * 64) { const int l = i / per_layer, r = i - l * per_layer;
            *(GAS v4u*)(ws + WS_W + (size_t)l * W_LAYER + W_IN + (size_t)NW_IN * DM * 2 + (size_t)r * 16) = (v4u){0u, 0u, 0u, 0u}; }
    }
    {
        const float* c = a.in[1]; const float* cctx = a.in[3]; const float* mw = a.in[4];
        float* modp = (float*)(ws + WS_MODP);
        LAS float* sv = scr;
        for (int it = gw; it < DEPTH * 8 * 72; it += NGW) {
            const int l = it / (8 * 72), r = it % (8 * 72), ks = r / 72, nb = r % 72, k0 = ks * 256, n = nb * 256 + lane * 4;
#pragma unroll
            for (int j = 0; j < 4; ++j) { const int k = k0 + lane + 64 * j;
                sv[0 * 256 + lane + 64 * j] = silu_acc(c[k]); sv[1 * 256 + lane + 64 * j] = silu_acc(c[DM + k]); sv[2 * 256 + lane + 64 * j] = silu_acc(cctx[k]); }
            LDS_WAIT(); asm volatile("" ::: "memory");
            f32x4 a0 = {0.f, 0.f, 0.f, 0.f}, a1 = a0, a2 = a0;
            const float* wp = mw + ((size_t)l * DM + k0) * MODW + n;
#pragma unroll 8
            for (int k = 0; k < 256; ++k) { const f32x4 w = *(const f32x4*)(wp + (size_t)k * MODW); a0 += w * sv[k]; a1 += w * sv[256 + k]; a2 += w * sv[512 + k]; }
            float* op = modp + ((size_t)(l * 8 + ks) * 3) * MODW + n;
            *(f32x4*)(op) = a0; *(f32x4*)(op + MODW) = a1; *(f32x4*)(op + 2 * MODW) = a2;
            LDS_WAIT(); asm volatile("" ::: "memory");
        }
    }
    {
        float* rc = (float*)(ws + WS_ROPE); float* rs = rc + 256 * 32;
        for (int i = gw * 64 + lane; i < 256 * 32; i += NGW * 64) { const int p = i >> 5, f = i & 31;
            const double inv = pow(10000.0, -(double)f / 32.0); const double ang = (double)p * inv;
            rc[i] = (float)cos(ang); rs[i] = (float)sin(ang); }
    }
}
__device__ __forceinline__ void p1_modreduce(Frame& F, const Args& a) {
    const float* modp = (const float*)(a.ws + WS_MODP); float* mod = (float*)(a.ws + WS_MOD); const float* mb = a.in[5];
    for (int i = F.vcu * 512 + F.tid; i < DEPTH * 3 * MODW; i += F.G * 512) { const int l = i / (3 * MODW), r = i % (3 * MODW), set = r / MODW, n = r % MODW;
        float s = mb[l * MODW + n];
#pragma unroll
        for (int ks = 0; ks < 8; ++ks) s += modp[((size_t)(l * 8 + ks) * 3 + set) * MODW + n];
        mod[i] = s; }
}

struct NRow { u32x4 h[4]; f32x4 f[8]; const float* fsrc; bool isf; };
template <bool LAZYF>
__device__ __forceinline__ void norm_load(NRow& r, const float* src_lat, const float* src_ctx, const bf16* RES, int row, int lane) {
    const int b = row / TOKB, j = row - b * TOKB; const bool isctx = j < CTXL;
    const float* src = isctx ? (src_ctx ? src_ctx + ((size_t)b * CTXL + j) * DM : (const float*)nullptr) : (src_lat ? src_lat + ((size_t)b * SEQ + (j - CTXL)) * DM : (const float*)nullptr);
    r.isf = src != nullptr; r.fsrc = src;
    if (src) { if constexpr (!LAZYF) {
#pragma unroll
        for (int q = 0; q < 4; ++q) { r.f[2 * q] = *(const GAS f32x4*)(src + (q * 64 + lane) * 8); r.f[2 * q + 1] = *(const GAS f32x4*)(src + (q * 64 + lane) * 8 + 4); } } }
    else {
#pragma unroll
        for (int q = 0; q < 4; ++q) r.h[q] = __builtin_nontemporal_load((const GAS u32x4*)(RES + (size_t)row * DM + (q * 64 + lane) * 8)); }
}
template <bool LAZYF = false>
__device__ __forceinline__ void norm_phase(Frame& F, const float* src_lat, const float* src_ctx, bf16* RES, const float* g, const float* mod  , int sub, bf16* XN, int skip_ctx, const float* part) {
    const int gw = F.vcu * NWAVES + F.wave, NGW = F.G * NWAVES, lane = F.lane;
    int cur = -1; f32x4 A[8], B[8]; NRow rc, rn;
    int row = gw;
    if (skip_ctx) while (row < M_ALL && (row % TOKB) < CTXL) row += NGW;
    if (row < M_ALL) norm_load<LAZYF>(rc, src_lat, src_ctx, RES, row, lane);
    while (row < M_ALL) {
        int nrow = row + NGW;
        if (skip_ctx) while (nrow < M_ALL && (nrow % TOKB) < CTXL) nrow += NGW;
        if (nrow < M_ALL) norm_load<LAZYF>(rn, src_lat, src_ctx, RES, nrow, lane);
        const int b = row / TOKB, j = row - b * TOKB; const bool isctx = j < CTXL;
        const int set = isctx ? 2 : b;
        if (set != cur) { cur = set; const float* sh = mod + (size_t)(set * 9 + 3 * sub) * DM; const float* sc = sh + DM;
#pragma unroll
            for (int q = 0; q < 8; ++q) { const int c = ((q >> 1) * 64 + lane) * 8 + (q & 1) * 4; const f32x4 gg = *(const f32x4*)(g + c), ss = *(const f32x4*)(sc + c); A[q] = gg * (ss + 1.0f); B[q] = *(const f32x4*)(sh + c); } }
        f32x4 v[8];
        if (rc.isf) {
            if constexpr (LAZYF) {
#pragma unroll
                for (int q = 0; q < 4; ++q) { v[2 * q] = *(const GAS f32x4*)(rc.fsrc + (q * 64 + lane) * 8); v[2 * q + 1] = *(const GAS f32x4*)(rc.fsrc + (q * 64 + lane) * 8 + 4); }
            } else {
#pragma unroll
            for (int q = 0; q < 8; ++q) v[q] = rc.f[q]; }
        } else {
#pragma unroll
            for (int q = 0; q < 4; ++q) { const u32x4 w = rc.h[q]; v[2 * q] = (f32x4){hlo(w.x), hhi(w.x), hlo(w.y), hhi(w.y)}; v[2 * q + 1] = (f32x4){hlo(w.z), hhi(w.z), hlo(w.w), hhi(w.w)}; }
        }
        if (isctx && part) { const size_t ro = ((size_t)b * CTXL + j) * DM;
#pragma unroll
            for (int ks = 0; ks < CTX_NS; ++ks)
#pragma unroll
                for (int q = 0; q < 8; ++q) v[q] += *(const GAS f32x4*)(part + (size_t)ks * 512 * DM + ro + ((q >> 1) * 64 + lane) * 8 + (q & 1) * 4);
#pragma unroll
            for (int q = 0; q < 4; ++q) { u32x4 w; w.x = pkh(v[2 * q].x, v[2 * q].y); w.y = pkh(v[2 * q].z, v[2 * q].w); w.z = pkh(v[2 * q + 1].x, v[2 * q + 1].y); w.w = pkh(v[2 * q + 1].z, v[2 * q + 1].w);
                *(GAS u32x4*)(RES + (size_t)row * DM + (q * 64 + lane) * 8) = w;
                v[2 * q] = (f32x4){hlo(w.x), hhi(w.x), hlo(w.y), hhi(w.y)}; v[2 * q + 1] = (f32x4){hlo(w.z), hhi(w.z), hlo(w.w), hhi(w.w)}; } }
        float s = 0.f;
#pragma unroll
        for (int q = 0; q < 8; ++q) s += (v[q].x * v[q].x + v[q].y * v[q].y) + (v[q].z * v[q].z + v[q].w * v[q].w);
        const float rstd = 1.0f / sqrtf(wave_sum(s) * (1.0f / DM) + EPSN);
        bf16* orow = XN + (size_t)row * DM;
#pragma unroll
        for (int q = 0; q < 4; ++q) { const f32x4 o0 = v[2 * q] * rstd * A[2 * q] + B[2 * q], o1 = v[2 * q + 1] * rstd * A[2 * q + 1] + B[2 * q + 1];
            u32x4 w; w.x = cvtpk(o0.x, o0.y); w.y = cvtpk(o0.z, o0.w); w.z = cvtpk(o1.x, o1.y); w.w = cvtpk(o1.z, o1.w); *(GAS u32x4*)(orow + (q * 64 + lane) * 8) = w; }
        rc = rn; row = nrow;
    }
}
__device__ __forceinline__ void final_norm_phase(Frame& F, const bf16* RES, float* out, const float* g) {
    const int gw = F.vcu * NWAVES + F.wave, NGW = F.G * NWAVES, lane = F.lane;
    f32x4 A[8];
#pragma unroll
    for (int q = 0; q < 8; ++q) A[q] = *(const f32x4*)(g + ((q >> 1) * 64 + lane) * 8 + (q & 1) * 4);
    u32x4 hc[4], hn[4];
#define FN_LOAD(H, R) do { const int b_ = (R) / SEQ, t_ = (R) - b_ * SEQ; const bf16* s_ = RES + ((size_t)b_ * TOKB + CTXL + t_) * DM; \
        _Pragma("unroll") for (int q = 0; q < 4; ++q) H[q] = __builtin_nontemporal_load((const GAS u32x4*)(s_ + (q * 64 + lane) * 8)); } while (0)
    int row = gw;
    if (row < NB * SEQ) FN_LOAD(hc, row);
    while (row < NB * SEQ) {
        const int nrow = row + NGW;
        if (nrow < NB * SEQ) FN_LOAD(hn, nrow);
        f32x4 v[8]; float s = 0.f;
#pragma unroll
        for (int q = 0; q < 4; ++q) { const u32x4 w = hc[q]; v[2 * q] = (f32x4){hlo(w.x), hhi(w.x), hlo(w.y), hhi(w.y)}; v[2 * q + 1] = (f32x4){hlo(w.z), hhi(w.z), hlo(w.w), hhi(w.w)}; }
#pragma unroll
        for (int q = 0; q < 8; ++q) s += (v[q].x * v[q].x + v[q].y * v[q].y) + (v[q].z * v[q].z + v[q].w * v[q].w);
        const float rstd = 1.0f / sqrtf(wave_sum(s) * (1.0f / DM) + EPSN);
        float* p = out + (size_t)row * DM;
#pragma unroll
        for (int q = 0; q < 4; ++q) { *(GAS f32x4*)(p + (q * 64 + lane) * 8) = v[2 * q] * rstd * A[2 * q]; *(GAS f32x4*)(p + (q * 64 + lane) * 8 + 4) = v[2 * q + 1] * rstd * A[2 * q + 1]; }
#pragma unroll
        for (int q = 0; q < 4; ++q) hc[q] = hn[q];
        row = nrow;
    }
#undef FN_LOAD
}

typedef short v4i16_t __attribute__((ext_vector_type(4)));
__device__ __forceinline__ s16x4 vtr(LAS const unsigned char* p) { return __builtin_bit_cast(s16x4, __builtin_amdgcn_ds_read_tr16_b64_v4i16((LAS v4i16_t*)p)); }
template <int KSTEPS>
__device__ __forceinline__ void mm32_tr(f32x16& acc, LAS const unsigned char* At, int sa, int m0, LAS const unsigned char* Bn, int sb, int n0, int lane) {
    const int h = lane >> 5, blk = (lane >> 4) & 1, q = (lane & 15) >> 2, p = lane & 3, r = lane & 31;
    LAS const unsigned char* ap = At + (8 * h + q) * sa + (m0 + 16 * blk + 4 * p) * 2;
    LAS const unsigned char* bp = Bn + (n0 + r) * sb + 16 * h;
#pragma unroll
    for (int ks = 0; ks < KSTEPS; ++ks) {
        const s16x4 lo = vtr(ap + (16 * ks) * sa), hi4 = vtr(ap + (16 * ks + 4) * sa);
        const bf16x8 af = (bf16x8){lo[0], lo[1], lo[2], lo[3], hi4[0], hi4[1], hi4[2], hi4[3]};
        const bf16x8 bfv = *(LAS const bf16x8*)(bp + 32 * ks);
        acc = __builtin_amdgcn_mfma_f32_32x32x16_bf16(af, bfv, acc, 0, 0, 0);
    }
}
template <int KSTEPS>
__device__ __forceinline__ void mm32_rr(f32x16& acc, LAS const unsigned char* Am, int sa, int m0, LAS const unsigned char* Bn, int sb, int n0, int lane) {
    const int h = lane >> 5, r = lane & 31;
    LAS const unsigned char* ap = Am + (m0 + r) * sa + 16 * h;
    LAS const unsigned char* bp = Bn + (n0 + r) * sb + 16 * h;
#pragma unroll
    for (int ks = 0; ks < KSTEPS; ++ks) {
        const bf16x8 af = *(LAS const bf16x8*)(ap + 32 * ks);
        const bf16x8 bfv = *(LAS const bf16x8*)(bp + 32 * ks);
        acc = __builtin_amdgcn_mfma_f32_32x32x16_bf16(af, bfv, acc, 0, 0, 0);
    }
}

__device__ __forceinline__ void qknorm_row(bf16* Z, int row, const float* qkg  , const float* rc, const float* rs, int lane) {
    const int b = row / TOKB, j = row - b * TOKB; const bool isctx = j < CTXL; const int t = j - CTXL, prow = t >> 6, pcol = t & 63;
    bf16* zr = Z + (size_t)row * NZ;
    v4u wv[3];
#pragma unroll
    for (int pass = 0; pass < 3; ++pass) { const int ch = lane + 64 * pass; wv[pass] = (v4u){0u, 0u, 0u, 0u}; if (ch < 160) wv[pass] = *(const GAS v4u*)(zr + ch * 8); }
    const int j16 = lane & 15; const int pos = isctx ? 0 : ((j16 & 8) ? pcol : prow); const int f0 = 8 * (j16 & 3);
    const f32x4 c0 = *(const f32x4*)(rc + pos * 32 + f0), c1 = *(const f32x4*)(rc + pos * 32 + f0 + 4), s0 = *(const f32x4*)(rs + pos * 32 + f0), s1 = *(const f32x4*)(rs + pos * 32 + f0 + 4);
    const float cs[8] = {c0.x, c0.y, c0.z, c0.w, c1.x, c1.y, c1.z, c1.w}, sn[8] = {s0.x, s0.y, s0.z, s0.w, s1.x, s1.y, s1.z, s1.w};
    const bool second = (j16 & 4) != 0;
#pragma unroll
    for (int pass = 0; pass < 3; ++pass) {
        const int ch = lane + 64 * pass; const bool act = ch < 160;
        const int head = ch >> 4;
        const v4u w = wv[pass];
        float y[8] = {bflo(w.x), bfhi(w.x), bflo(w.y), bfhi(w.y), bflo(w.z), bfhi(w.z), bflo(w.w), bfhi(w.w)};
        float ss = 0.f;
#pragma unroll
        for (int e = 0; e < 8; ++e) ss += y[e] * y[e];
        ss += __shfl_xor(ss, 1); ss += __shfl_xor(ss, 2); ss += __shfl_xor(ss, 4); ss += __shfl_xor(ss, 8);
        const float rstd = 1.0f / sqrtf(ss * (1.0f / 128.0f) + EPSN);
        const float* gp = qkg + (head < 8 ? 0 : 128) + j16 * 8;
        const f32x4 g0 = *(const f32x4*)gp, g1 = *(const f32x4*)(gp + 4);
        const float gg[8] = {g0.x, g0.y, g0.z, g0.w, g1.x, g1.y, g1.z, g1.w};
#pragma unroll
        for (int e = 0; e < 8; ++e) y[e] = y[e] * rstd * gg[e];
        float pr[8];
#pragma unroll
        for (int e = 0; e < 8; ++e) pr[e] = __shfl_xor(y[e], 4);
        if (!isctx) {
#pragma unroll
            for (int e = 0; e < 8; ++e) y[e] = second ? (pr[e] * sn[e] + y[e] * cs[e]) : (y[e] * cs[e] - pr[e] * sn[e]);
        }
        if (head < 8) {
#pragma unroll
            for (int e = 0; e < 8; ++e) y[e] *= 0.12752455f; }
        if (act) { v4u o; o.x = cvtpk(y[0], y[1]); o.y = cvtpk(y[2], y[3]); o.z = cvtpk(y[4], y[5]); o.w = cvtpk(y[6], y[7]); *(GAS v4u*)(zr + ch * 8) = o; }
    }
}

constexpr int ST272 = 272, ST144 = 144;
__device__ __forceinline__ void gmlp_unit(Frame& F, const bf16* Z, bf16* MIX, int chunk, int grp, const float* ws_l  , const float* bs_l  , const float* gm  ) {
    int tid_ = threadIdx.x; asm volatile("" : "+v"(tid_));
    const int tid = tid_, lane = tid & 63, wave = __builtin_amdgcn_readfirstlane(tid >> 6);
    const int b = chunk / CHB, c = chunk - b * CHB, r0 = b * TOKB + c * 128;
    LAS unsigned char* VN = F.lds + RING_OFF;
    LAS unsigned char* WS = VN + 128 * ST272;
    LAS float* RS = (LAS float*)(WS + 128 * ST272);
    { const int row = tid >> 2, part = tid & 3; const bf16* p = Z + (size_t)(r0 + row) * NZ + ZMV + part * 128; float ss = 0.f;
#pragma unroll
        for (int q = 0; q < 16; ++q) { const v4u w = *(const GAS v4u*)(p + q * 8);
            const float y0 = bflo(w.x), y1 = bfhi(w.x), y2 = bflo(w.y), y3 = bfhi(w.y), y4 = bflo(w.z), y5 = bfhi(w.z), y6 = bflo(w.w), y7 = bfhi(w.w);
            ss += (y0 * y0 + y1 * y1) + (y2 * y2 + y3 * y3) + (y4 * y4 + y5 * y5) + (y6 * y6 + y7 * y7); }
        ss += __shfl_xor(ss, 1); ss += __shfl_xor(ss, 2);
        if (part == 0) RS[row] = 1.0f / sqrtf(ss * (1.0f / 512.0f) + EPSN); }
#pragma unroll
    for (int q = 0; q < 8; ++q) { const int idx = tid + 512 * q, i = idx >> 5, j4 = (idx & 31) * 4; const f32x4 w = *(const f32x4*)(ws_l + (size_t)grp * 16384 + i * 128 + j4);
        u32x2 o; o.x = cvtpk(w.x, w.y); o.y = cvtpk(w.z, w.w); *(LAS u32x2*)(WS + i * ST272 + j4 * 2) = o; }
    __syncthreads();
#pragma unroll
    for (int q = 0; q < 4; ++q) { const int idx = tid + 512 * q, jrow = idx >> 4, c8 = (idx & 15) * 8; const v4u w = *(const GAS v4u*)(Z + (size_t)(r0 + jrow) * NZ + ZMV + grp * 128 + c8);
        const float rstd = RS[jrow]; const float* gp = gm + grp * 128 + c8;
        v4u o; o.x = cvtpk(bflo(w.x) * rstd * gp[0], bfhi(w.x) * rstd * gp[1]); o.y = cvtpk(bflo(w.y) * rstd * gp[2], bfhi(w.y) * rstd * gp[3]);
        o.z = cvtpk(bflo(w.z) * rstd * gp[4], bfhi(w.z) * rstd * gp[5]); o.w = cvtpk(bflo(w.w) * rstd * gp[6], bfhi(w.w) * rstd * gp[7]);
        *(LAS v4u*)(VN + jrow * ST272 + c8 * 2) = o; }
    __syncthreads();
    const int it = wave & 3, ct0 = (wave >> 2) * 2, hi = lane >> 5, i = it * 32 + (lane & 31);
    const float bias = bs_l[grp * 128 + i];
#pragma unroll
    for (int cc = 0; cc < 2; ++cc) { const int ct = ct0 + cc; f32x16 acc = {};
        mm32_tr<8>(acc, VN, ST272, ct * 32, WS, ST272, it * 32, lane);
        const bf16* mup = Z + (size_t)(r0 + i) * NZ + ZMU + grp * 128 + ct * 32 + 4 * hi; bf16* op = MIX + (size_t)(r0 + i) * DM + MXM + grp * 128 + ct * 32 + 4 * hi;
#pragma unroll
        for (int rg = 0; rg < 4; ++rg) { const u32x2 mu = *(const GAS u32x2*)(mup + 8 * rg);
            u32x2 o; o.x = cvtpk(bflo(mu.x) * (acc[4 * rg + 0] + bias), bfhi(mu.x) * (acc[4 * rg + 1] + bias)); o.y = cvtpk(bflo(mu.y) * (acc[4 * rg + 2] + bias), bfhi(mu.y) * (acc[4 * rg + 3] + bias));
            *(GAS u32x2*)(op + 8 * rg) = o; } }
    __syncthreads();
}

__device__ __forceinline__ float log_sigmoid_f(float x) { const float t = __builtin_amdgcn_exp2f(fabsf(x) * -1.4426950408889634f); return fminf(x, 0.f) - 0.6931471805599453f * __builtin_amdgcn_logf(1.0f + t); }
__device__ __forceinline__ void gla_a_unit(Frame& F, bf16* Z, bf16* QG, float* UT, float* DV, int chunk, int hd, const float* gw_l  , const float* gb_l  ) {
    int tid_ = threadIdx.x; asm volatile("" : "+v"(tid_));
    const int tid = tid_, lane = tid & 63, wave = __builtin_amdgcn_readfirstlane(tid >> 6);
    const int b = chunk / CHB, c = chunk - b * CHB, r0 = b * TOKB + c * 128;
    LAS unsigned char* QT = F.lds + RING_OFF;
    LAS unsigned char* KT = QT + 128 * ST144;
    LAS unsigned char* KTT = KT + 128 * ST144;
    LAS unsigned char* VV = KTT + 64 * ST272;
    LAS unsigned char* ATT = VV + 128 * ST272;
    LAS unsigned char* QRAW = ATT; LAS unsigned char* KRAW = ATT + 16384;
    LAS float* SEG = (LAS float*)(ATT + 128 * ST272);
    LAS unsigned char* LR = (LAS unsigned char*)(SEG + 512);
#pragma unroll
    for (int q = 0; q < 4; ++q) { const int idx = tid + 512 * q, jrow = idx >> 4, c8 = (idx & 15) * 8;
        *(LAS v4u*)(VV + jrow * ST272 + c8 * 2) = *(const GAS v4u*)(Z + (size_t)(r0 + jrow) * NZ + ZGV + hd * 128 + c8); }
#pragma unroll
    for (int q = 0; q < 2; ++q) { const int idx = tid + 512 * q, jrow = idx >> 3, c8 = (idx & 7) * 8;
        *(LAS v4u*)(QRAW + jrow * 128 + c8 * 2) = *(const GAS v4u*)(Z + (size_t)(r0 + jrow) * NZ + ZGQ + hd * 64 + c8);
        *(LAS v4u*)(KRAW + jrow * 128 + c8 * 2) = *(const GAS v4u*)(Z + (size_t)(r0 + jrow) * NZ + ZGK + hd * 64 + c8); }
    { const int jrow = tid >> 2, c8 = (tid & 3) * 8; *(LAS v4u*)(LR + jrow * 64 + c8 * 2) = *(const GAS v4u*)(Z + (size_t)(r0 + jrow) * NZ + ZLR + c8); }
    __syncthreads();
    const int d = lane, jb = wave;
    f32x16 att0 = {}, att1 = {};
    const int jt = wave & 3, it0 = (wave >> 2) * 2, hi = lane >> 5, r32 = lane & 31;
#pragma unroll
    for (int dir = 0; dir < 2; ++dir) {
        float cs[16];
        { float wv[16];
#pragma unroll
          for (int r = 0; r < 16; ++r) wv[r] = gw_l[(dir * 16 + r) * 256 + hd * 64 + d];
          const float gbias = gb_l[dir * 256 + hd * 64 + d];
#pragma unroll
          for (int i = 0; i < 16; ++i) { LAS const unsigned char* lr = LR + (jb * 16 + i) * 64 + dir * 32;
            const v4u w0 = *(LAS const v4u*)(lr), w1 = *(LAS const v4u*)(lr + 16);
            float lg = gbias;
            lg += bflo(w0.x) * wv[0] + bfhi(w0.x) * wv[1] + bflo(w0.y) * wv[2] + bfhi(w0.y) * wv[3] + bflo(w0.z) * wv[4] + bfhi(w0.z) * wv[5] + bflo(w0.w) * wv[6] + bfhi(w0.w) * wv[7];
            lg += bflo(w1.x) * wv[8] + bfhi(w1.x) * wv[9] + bflo(w1.y) * wv[10] + bfhi(w1.y) * wv[11] + bflo(w1.z) * wv[12] + bfhi(w1.z) * wv[13] + bflo(w1.w) * wv[14] + bfhi(w1.w) * wv[15];
            cs[i] = log_sigmoid_f(lg) * (1.0f / 16.0f); } }
        if (dir == 0) {
#pragma unroll
            for (int i = 1; i < 16; ++i) cs[i] += cs[i - 1];
            SEG[jb * 64 + d] = cs[15];
        } else {
#pragma unroll
            for (int i = 14; i >= 0; --i) cs[i] += cs[i + 1];
            SEG[jb * 64 + d] = cs[0];
        }
        __syncthreads();
        float offs = 0.f;
#pragma unroll
        for (int s = 0; s < 8; ++s) { const float sv = SEG[s * 64 + d]; if (dir == 0 ? (s < jb) : (s > jb)) offs += sv; }
#pragma unroll
        for (int i = 0; i < 16; ++i) { const int j = jb * 16 + i; const float cc = cs[i] + offs;
            const float qraw = bf2f(*(LAS const unsigned short*)(QRAW + j * 128 + d * 2)) * 0.125f, kraw = bf2f(*(LAS const unsigned short*)(KRAW + j * 128 + d * 2));
            const float qt = qraw * __expf(cc), kt = kraw * __expf(-cc);
            const unsigned short qb = (unsigned short)(cvtpk(qt, 0.f) & 0xffffu), kb = (unsigned short)(cvtpk(kt, 0.f) & 0xffffu);
            *(LAS unsigned short*)(QT + j * ST144 + d * 2) = qb; *(LAS unsigned short*)(KT + j * ST144 + d * 2) = kb; *(LAS unsigned short*)(KTT + d * ST272 + j * 2) = kb; }
        __syncthreads();
#pragma unroll
        for (int q = 0; q < 2; ++q) { const int idx = tid + 512 * q, jrow = idx >> 3, c8 = (idx & 7) * 8;
            *(GAS v4u*)(QG + (size_t)(r0 + jrow) * 512 + dir * 256 + hd * 64 + c8) = *(LAS const v4u*)(QT + jrow * ST144 + c8 * 2); }
#pragma unroll
        for (int cc = 0; cc < 2; ++cc) { f32x16 acc = {};
            mm32_rr<4>(acc, KT, ST144, jt * 32, QT, ST144, (it0 + cc) * 32, lane);
            const int ii = (it0 + cc) * 32 + r32;
#pragma unroll
            for (int r = 0; r < 16; ++r) { const int jj = jt * 32 + crow(r, hi); const int df = dir == 0 ? (ii - jj) : (jj - ii);
                const float v = __uint_as_float(__float_as_uint(acc[r]) & ~(unsigned)(df >> 31)); if (cc == 0) att0[r] += v; else att1[r] += v; } }
        { const int et = wave & 3, dt = wave >> 2; f32x16 acc = {};
            mm32_tr<8>(acc, VV, ST272, et * 32, KTT, ST272, dt * 32, lane);
            const int dd = dt * 32 + r32; float tot = 0.f;
#pragma unroll
            for (int s = 0; s < 8; ++s) tot += SEG[s * 64 + dd];
            const float ex = __expf(tot);
            const size_t cidx = ((size_t)(b * CHB + c) * 4 + hd) * 2 + dir;
            float* up = UT + cidx * 8192 + dd;
#pragma unroll
            for (int r = 0; r < 16; ++r) up[(et * 32 + crow(r, hi)) * 64] = acc[r] * ex;
            if (et == 0 && hi == 0) DV[cidx * 64 + dd] = ex; }
        __syncthreads();
    }
#pragma unroll
    for (int cc = 0; cc < 2; ++cc) { const int ii = (it0 + cc) * 32 + r32;
#pragma unroll
        for (int rg = 0; rg < 4; ++rg) { u32x2 o;
            if (cc == 0) { o.x = cvtpk(att0[4 * rg], att0[4 * rg + 1]); o.y = cvtpk(att0[4 * rg + 2], att0[4 * rg + 3]); } else { o.x = cvtpk(att1[4 * rg], att1[4 * rg + 1]); o.y = cvtpk(att1[4 * rg + 2], att1[4 * rg + 3]); }
            *(LAS u32x2*)(ATT + ii * ST272 + (jt * 32 + 8 * rg + 4 * hi) * 2) = o; } }
    __syncthreads();
    { const int itile = wave & 3, et0 = (wave >> 2) * 2; const int ii = itile * 32 + r32;
#pragma unroll
        for (int cc = 0; cc < 2; ++cc) { const int et = et0 + cc; f32x16 acc = {};
            mm32_tr<8>(acc, VV, ST272, et * 32, ATT, ST272, itile * 32, lane);
            bf16* op = Z + (size_t)(r0 + ii) * NZ + ZGV + hd * 128 + et * 32 + 4 * hi;
#pragma unroll
            for (int rg = 0; rg < 4; ++rg) { u32x2 o; o.x = cvtpk(acc[4 * rg], acc[4 * rg + 1]); o.y = cvtpk(acc[4 * rg + 2], acc[4 * rg + 3]); *(GAS u32x2*)(op + 8 * rg) = o; } } }
    __syncthreads();
}

__device__ __forceinline__ void gla_scan_phase(Frame& F, const float* UT, const float* DV, bf16* ST) {
    for (int gt = F.vcu * 512 + F.tid; gt < 16 * 8192; gt += F.G * 512) {
        const int chain = gt >> 13, elem = gt & 8191, d = elem & 63, dir = chain & 1, hd = (chain >> 1) & 3, b = chain >> 3;
        float state = 0.f;
#pragma unroll 1
        for (int s0 = 0; s0 < CHB; s0 += 26) {
            float u[26], dv[26]; size_t ci[26];
#pragma unroll
            for (int i = 0; i < 26; ++i) { const int s = s0 + i; const int c = dir == 0 ? s : (s == 0 ? 1 : (s == 1 ? 0 : 131 - s));
                ci[i] = ((size_t)(b * CHB + c) * 4 + hd) * 2 + dir; u[i] = UT[ci[i] * 8192 + elem]; dv[i] = DV[ci[i] * 64 + d]; }
#pragma unroll
            for (int i = 0; i < 26; ++i) { ST[ci[i] * 8192 + elem] = (bf16)(cvtpk(state, 0.f) & 0xffffu); state = dv[i] * state + u[i]; }
        }
    }
}

__device__ __forceinline__ void gla_c_item(const bf16* Z, const bf16* QG, const bf16* ST, bf16* MIX, int chunk, int hd, int itile, const float* gg  , int lane) {
    const int b = chunk / CHB, c = chunk - b * CHB, r0 = b * TOKB + c * 128, r32 = lane & 31, hi = lane >> 5;
    const size_t row = (size_t)(r0 + itile * 32 + r32);
    bf16x8 bq[2][4];
#pragma unroll
    for (int dir = 0; dir < 2; ++dir)
#pragma unroll
        for (int ks = 0; ks < 4; ++ks) bq[dir][ks] = *(const GAS bf16x8*)(QG + row * 512 + dir * 256 + hd * 64 + 16 * ks + 8 * hi);
    u32x2 oi[4][4], rw[4][4];
#pragma unroll
    for (int et = 0; et < 4; ++et)
#pragma unroll
        for (int rg = 0; rg < 4; ++rg) { const int e0 = et * 32 + 8 * rg + 4 * hi;
            oi[et][rg] = *(const GAS u32x2*)(Z + row * NZ + ZGV + hd * 128 + e0); rw[et][rg] = *(const GAS u32x2*)(Z + row * NZ + ZGR + hd * 128 + e0); }
    f32x16 acc[4] = {};
#pragma unroll
    for (int dir = 0; dir < 2; ++dir) { const size_t cidx = ((size_t)(b * CHB + c) * 4 + hd) * 2 + dir; const bf16* sp = ST + cidx * 8192 + (size_t)r32 * 64 + 8 * hi;
#pragma unroll
        for (int et = 0; et < 4; ++et)
#pragma unroll
            for (int ks = 0; ks < 4; ++ks) { const bf16x8 af = *(const GAS bf16x8*)(sp + et * 32 * 64 + 16 * ks);
                acc[et] = __builtin_amdgcn_mfma_f32_32x32x16_bf16(af, bq[dir][ks], acc[et], 0, 0, 0);
            } }
    float ss = 0.f;
#pragma unroll
    for (int et = 0; et < 4; ++et)
#pragma unroll
        for (int rg = 0; rg < 4; ++rg) { const u32x2 w = oi[et][rg];
            acc[et][4 * rg + 0] += bflo(w.x); acc[et][4 * rg + 1] += bfhi(w.x); acc[et][4 * rg + 2] += bflo(w.y); acc[et][4 * rg + 3] += bfhi(w.y);
            ss += (acc[et][4 * rg] * acc[et][4 * rg] + acc[et][4 * rg + 1] * acc[et][4 * rg + 1]) + (acc[et][4 * rg + 2] * acc[et][4 * rg + 2] + acc[et][4 * rg + 3] * acc[et][4 * rg + 3]); }
    ss += __shfl_xor(ss, 32);
    const float rstd = 1.0f / sqrtf(ss * (1.0f / 128.0f) + EPSN);
#pragma unroll
    for (int et = 0; et < 4; ++et)
#pragma unroll
        for (int rg = 0; rg < 4; ++rg) { const int e0 = et * 32 + 8 * rg + 4 * hi; const u32x2 rv = rw[et][rg]; const f32x4 g4 = *(const f32x4*)(gg + hd * 128 + e0);
            const float r0v = bflo(rv.x), r1v = bfhi(rv.x), r2v = bflo(rv.y), r3v = bfhi(rv.y);
            float y0 = acc[et][4 * rg] * rstd * g4.x * silu_acc(r0v), y1 = acc[et][4 * rg + 1] * rstd * g4.y * silu_acc(r1v), y2 = acc[et][4 * rg + 2] * rstd * g4.z * silu_acc(r2v), y3 = acc[et][4 * rg + 3] * rstd * g4.w * silu_acc(r3v);
            u32x2 o; o.x = cvtpk(y0, y1); o.y = cvtpk(y2, y3);
            *(GAS u32x2*)(MIX + row * DM + MXG + hd * 128 + e0) = o; }
}

namespace att {
constexpr int D = 128, NW = 8, QBLK = 32, KVBLK = 64;
constexpr float SCALE = 0.088388347648318440f;
constexpr float THR = 8.f;
constexpr int LDQ = NZ, LDK = NZ, LDO = DM;
constexpr int NBUF = 3, SHM_V = KVBLK * D * 2, SHM_K = KVBLK * D * 2, SHM_ATTN = NBUF * SHM_V + NBUF * SHM_K + NW * 64 * 4;
#define KSWZ(row, colB) ((row) * 256 + ((colB) ^ (((row) & 7) << 4)))
#define SBAR() __builtin_amdgcn_sched_barrier(0)
template <bool FAST>
__device__ __forceinline__ void partialSM(f32x16& p0, f32x16& p1, float& m_reg, float& mn, float& alpha) {
  if (FAST) { mn = m_reg; alpha = 1.f;
#pragma unroll
    for (int r = 0; r < 16; ++r) p0[r] = __builtin_amdgcn_exp2f(p0[r]);
    return; }
  float pmax = p0[0];
#pragma unroll
  for (int r = 1; r < 16; ++r) pmax = fmaxf(pmax, p0[r]);
#pragma unroll
  for (int r = 0; r < 16; ++r) pmax = fmaxf(pmax, p1[r]);
  { auto rr = __builtin_amdgcn_permlane32_swap(__float_as_uint(pmax), __float_as_uint(pmax), false, false);
    pmax = fmaxf(__uint_as_float(rr[0]), __uint_as_float(rr[1])); }
  float C = 1.0f; asm volatile("" : "+v"(C));
  if (__builtin_expect(__all(pmax - m_reg <= THR * 1.4426950408889634f), 1)) { mn = m_reg; alpha = 1.f; }
  else { mn = fmaxf(m_reg, pmax); alpha = __builtin_amdgcn_exp2f((m_reg - mn) * C); m_reg = mn; }
  float mnC = -mn * C;
#pragma unroll
  for (int r = 0; r < 16; ++r) p0[r] = fmaf(p0[r], C, mnC);
#pragma unroll
  for (int r = 0; r < 16; ++r) p1[r] = fmaf(p1[r], C, mnC);
#pragma unroll
  for (int r = 0; r < 16; ++r) p0[r] = __builtin_amdgcn_exp2f(p0[r]);
}
__device__ __forceinline__ void finishSM(f32x16& p0, f32x16& p1, float alpha, float& l_reg, bf16x8& pa0, bf16x8& pa1, bf16x8& pa2, bf16x8& pa3) {
#pragma unroll
  for (int r = 0; r < 16; ++r) p1[r] = __builtin_amdgcn_exp2f(p1[r]);
  float ps = 0;
#pragma unroll
  for (int r = 0; r < 16; ++r) ps += p0[r];
#pragma unroll
  for (int r = 0; r < 16; ++r) ps += p1[r];
  { auto rr = __builtin_amdgcn_permlane32_swap(__float_as_uint(ps), __float_as_uint(ps), false, false);
    ps = __uint_as_float(rr[0]) + __uint_as_float(rr[1]); }
  l_reg = l_reg * alpha + ps;
#define PK4(P, BASE, OUT) do { unsigned a0 = cvtpk(P[BASE + 0], P[BASE + 1]), a1 = cvtpk(P[BASE + 2], P[BASE + 3]);   \
    unsigned b0 = cvtpk(P[BASE + 4], P[BASE + 5]), b1 = cvtpk(P[BASE + 6], P[BASE + 7]);                              \
    auto r0 = __builtin_amdgcn_permlane32_swap(a0, b0, false, false); auto r1 = __builtin_amdgcn_permlane32_swap(a1, b1, false, false); \
    v4u w = {r0[0], r1[0], r0[1], r1[1]}; OUT = __builtin_bit_cast(bf16x8, w); } while (0)
  PK4(p0, 0, pa0); PK4(p0, 8, pa1); PK4(p1, 0, pa2); PK4(p1, 8, pa3);
#undef PK4
}
__device__ __forceinline__ void qkt(f32x16& p0, f32x16& p1, LAS const unsigned char* Ks, const bf16x8* qr, int r32, int hi) {
  p0 = f32x16{}; p1 = f32x16{};
#pragma unroll
  for (int d0 = 0; d0 < 8; ++d0) { int cb = (d0 * 16 + hi * 8) * 2;
    bf16x8 b0 = *(LAS const bf16x8*)(Ks + KSWZ(r32, cb));
    bf16x8 b1 = *(LAS const bf16x8*)(Ks + KSWZ(32 + r32, cb));
    p0 = __builtin_amdgcn_mfma_f32_32x32x16_bf16(b0, qr[d0], p0, 0, 0, 0);
    p1 = __builtin_amdgcn_mfma_f32_32x32x16_bf16(b1, qr[d0], p1, 0, 0, 0); }
}
__device__ __forceinline__ int v_st(int k, int c) { const int kk = (k & ~0xC) | ((k & 4) << 1) | ((k & 8) >> 1); return ((kk >> 3) * 4 + (c >> 5)) * 512 + ((kk & 7) * 32 + (c & 31)) * 2; }
__device__ __forceinline__ int v_rd_base(int lane) { return ((lane & 3) << 3) | (((lane >> 2) & 3) << 6) | (((lane >> 4) & 1) << 5) | (((lane >> 5) & 1) << 8); }
constexpr int v_rd_off(int d0, int ks, int half) { return d0 * 512 + ks * 4096 + half * 2048; }
template <int OFF> __device__ __forceinline__ s16x4 tr_read(int vb) {
  s16x4 r; asm volatile("ds_read_b64_tr_b16 %0, %1 offset:%2" : "=&v"(r) : "v"(vb), "i"(OFF) : "memory"); return r;
}
template <int D0> __device__ __forceinline__ void pv_one(f32x16& od, int vb, bf16x8 pa0, bf16x8 pa1, bf16x8 pa2, bf16x8 pa3) {
  const s16x4 l0 = tr_read<v_rd_off(D0, 0, 0)>(vb), h0 = tr_read<v_rd_off(D0, 0, 1)>(vb), l1 = tr_read<v_rd_off(D0, 1, 0)>(vb), h1 = tr_read<v_rd_off(D0, 1, 1)>(vb);
  const s16x4 l2 = tr_read<v_rd_off(D0, 2, 0)>(vb), h2 = tr_read<v_rd_off(D0, 2, 1)>(vb), l3 = tr_read<v_rd_off(D0, 3, 0)>(vb), h3 = tr_read<v_rd_off(D0, 3, 1)>(vb);
  asm volatile("s_waitcnt lgkmcnt(0)" ::: "memory"); SBAR();
#define PK(L, H) (bf16x8){L[0], L[1], L[2], L[3], H[0], H[1], H[2], H[3]}
  od = __builtin_amdgcn_mfma_f32_32x32x16_bf16(pa0, PK(l0, h0), od, 0, 0, 0);
  od = __builtin_amdgcn_mfma_f32_32x32x16_bf16(pa1, PK(l1, h1), od, 0, 0, 0);
  od = __builtin_amdgcn_mfma_f32_32x32x16_bf16(pa2, PK(l2, h2), od, 0, 0, 0);
  od = __builtin_amdgcn_mfma_f32_32x32x16_bf16(pa3, PK(l3, h3), od, 0, 0, 0);
#undef PK
}
__device__ __forceinline__ void pv_d0(f32x16* o, int vb, bf16x8 pa0, bf16x8 pa1, bf16x8 pa2, bf16x8 pa3) {
  pv_one<0>(o[0], vb, pa0, pa1, pa2, pa3); pv_one<1>(o[1], vb, pa0, pa1, pa2, pa3); pv_one<2>(o[2], vb, pa0, pa1, pa2, pa3); pv_one<3>(o[3], vb, pa0, pa1, pa2, pa3);
}
template <bool FAST>
__device__ __forceinline__ void attn_dense_body(const bf16* __restrict__ Qb, const bf16* __restrict__ Kh, const bf16* __restrict__ Vh, bf16* __restrict__ Ob, int seq, LAS unsigned char* lds) {
  int tid_ = threadIdx.x; asm volatile("" : "+v"(tid_));
  const int tid = tid_, wid = __builtin_amdgcn_readfirstlane(tid >> 6), lane = tid & 63, r32 = lane & 31, hi = lane >> 5;
  LAS unsigned char* V_lds = lds; LAS unsigned char* K_lds = lds + NBUF * SHM_V;
  LAS float* wsp = (LAS float*)(lds + NBUF * SHM_V + NBUF * SHM_K) + wid * 64; LAS float* li_l = wsp; LAS float* al_l = wsp + 32;
  float m_reg = FAST ? 0.f : -1e30f, l_reg = 0; f32x16 o[4] = {}; bf16x8 qr[8];
  const bf16* Qw = Qb + (long)(wid * QBLK + r32) * LDQ + hi * 8;
#pragma unroll
  for (int d0 = 0; d0 < 8; ++d0) qr[d0] = *(const GAS bf16x8*)(Qw + d0 * 16);
  const int sr = tid >> 4, sc = (tid & 15) * 8, vst0 = v_st(sr, sc), vst1 = v_st(32 + sr, sc);
  const int vb0 = (int)(unsigned)(uintptr_t)V_lds + v_rd_base(lane);
  struct { bf16x8 vs0, vs1, ks0, ks1; } sr_[2];
#define SLOAD(i, k0) do { sr_[i].vs0 = *(const GAS bf16x8*)(&Vh[(long)((k0) + sr) * LDK + sc]); sr_[i].vs1 = *(const GAS bf16x8*)(&Vh[(long)((k0) + 32 + sr) * LDK + sc]); \
    sr_[i].ks0 = *(const GAS bf16x8*)(&Kh[(long)((k0) + sr) * LDK + sc]); sr_[i].ks1 = *(const GAS bf16x8*)(&Kh[(long)((k0) + 32 + sr) * LDK + sc]); } while (0)
#define SWRITE(b, i) do { *(LAS bf16x8*)(V_lds + (b) * SHM_V + vst0) = sr_[i].vs0;          \
    *(LAS bf16x8*)(V_lds + (b) * SHM_V + vst1) = sr_[i].vs1; int kc = sc * 2;               \
    *(LAS bf16x8*)(K_lds + (b) * SHM_K + KSWZ(sr, kc)) = sr_[i].ks0;                       \
    *(LAS bf16x8*)(K_lds + (b) * SHM_K + KSWZ(32 + sr, kc)) = sr_[i].ks1; } while (0)
#define SWAIT() asm volatile("s_waitcnt vmcnt(4)" ::: "memory")
#define RESC(a) do { if (__any((a) < 1.f)) { if (hi == 0) al_l[r32] = (a); asm volatile("s_waitcnt lgkmcnt(0)" ::: "memory"); \
    _Pragma("unroll") for (int d = 0; d < 4; ++d) _Pragma("unroll") for (int r = 0; r < 16; ++r) o[d][r] *= al_l[crow(r, hi)]; } } while (0)
  f32x16 pA0, pA1, pB0, pB1; float mnA, mnB, alA, alB; bf16x8 pa0, pa1, pa2, pa3; const int NT = seq / KVBLK;
  constexpr int SE = 0, SO = 1;
  int bc = 1, bp = 0, bn = 2;
#define ROT() do { const int t_ = bp; bp = bc; bc = bn; bn = t_; } while (0)
  SLOAD(SE, 0); asm volatile("s_waitcnt vmcnt(0)" ::: "memory"); SWRITE(0, SE); __syncthreads();
  qkt(pA0, pA1, K_lds, qr, r32, hi); partialSM<FAST>(pA0, pA1, m_reg, mnA, alA);
  SLOAD(SO, KVBLK); if (2 < NT) SLOAD(SE, 2 * KVBLK);
  SWAIT(); SWRITE(1, SO); __syncthreads();
  for (int j = 1; j + 1 < NT; j += 2) {
    SBAR(); qkt(pB0, pB1, K_lds + bc * SHM_K, qr, r32, hi);
    finishSM(pA0, pA1, alA, l_reg, pa0, pa1, pa2, pa3); SBAR();
    SLOAD(SO, (j + 2) * KVBLK); SBAR();
    pv_d0(o, vb0 + bp * (int)SHM_V, pa0, pa1, pa2, pa3); partialSM<FAST>(pB0, pB1, m_reg, mnB, alB);
    SWAIT(); SWRITE(bn, SE);
    if (!FAST) RESC(alB);
    __syncthreads(); ROT();
    SBAR(); qkt(pA0, pA1, K_lds + bc * SHM_K, qr, r32, hi);
    finishSM(pB0, pB1, alB, l_reg, pa0, pa1, pa2, pa3); SBAR();
    if (j + 3 < NT) SLOAD(SE, (j + 3) * KVBLK); SBAR();
    pv_d0(o, vb0 + bp * (int)SHM_V, pa0, pa1, pa2, pa3); partialSM<FAST>(pA0, pA1, m_reg, mnA, alA);
    SWAIT(); SWRITE(bn, SO);
    if (!FAST) RESC(alA);
    __syncthreads(); ROT();
  }
  SBAR(); qkt(pB0, pB1, K_lds + bc * SHM_K, qr, r32, hi);
  finishSM(pA0, pA1, alA, l_reg, pa0, pa1, pa2, pa3); SBAR();
  pv_d0(o, vb0 + bp * (int)SHM_V, pa0, pa1, pa2, pa3); partialSM<FAST>(pB0, pB1, m_reg, mnB, alB);
  if (!FAST) RESC(alB);
  finishSM(pB0, pB1, alB, l_reg, pa0, pa1, pa2, pa3); SBAR();
  pv_d0(o, vb0 + bc * (int)SHM_V, pa0, pa1, pa2, pa3);
  if (hi == 0) li_l[r32] = l_reg; asm volatile("s_waitcnt lgkmcnt(0)" ::: "memory");
  float rli[16];
#pragma unroll
  for (int r = 0; r < 16; ++r) rli[r] = __builtin_amdgcn_rcpf(li_l[crow(r, hi)]);
  bf16* Ow = Ob + (long)(wid * QBLK) * LDO;
#pragma unroll
  for (int r = 0; r < 16; ++r) { int orow = crow(r, hi);
#pragma unroll
    for (int d0 = 0; d0 < 4; ++d0) Ow[(long)orow * LDO + d0 * 32 + r32] = (bf16)(cvtpk(o[d0][r] * rli[r], 0.f) & 0xffffu); }
  __syncthreads();
#undef SLOAD
#undef SWRITE
#undef SWAIT
#undef RESC
#undef ROT
}
constexpr int V16_LD = 288, SHM_V16 = KVBLK * V16_LD, SHM_K16 = KVBLK * D * 2;
#define KSWZ16(row, colB) ((row) * 256 + ((colB) ^ (((row) & 15) << 4)))
struct H16 { f32x4 s[2][2]; };
template <int PART, int KL> __device__ __forceinline__ void kload16(bf16x8 (&kf)[4], LAS const unsigned char* Ks, int li, int g) {
#pragma unroll
  for (int ks = 0; ks < 4; ++ks) kf[ks] = *(LAS const bf16x8*)(Ks + KSWZ16(16 * (2 * PART + KL) + li, 64 * ks + 16 * g));
}
template <int PART> __device__ __forceinline__ void qkmma16(H16& S, const bf16x8 (&ka)[4], LAS const unsigned char* Ks, const bf16x8 (&qf)[2][4], int li, int g) {
  bf16x8 kb[4]; kload16<PART, 1>(kb, Ks, li, g);
#pragma unroll
  for (int kl = 0; kl < 2; ++kl) { S.s[kl][0] = (f32x4){0.f, 0.f, 0.f, 0.f}; S.s[kl][1] = (f32x4){0.f, 0.f, 0.f, 0.f}; }
#pragma unroll
  for (int ks = 0; ks < 4; ++ks) {
    S.s[0][0] = __builtin_amdgcn_mfma_f32_16x16x32_bf16(ka[ks], qf[0][ks], S.s[0][0], 0, 0, 0);
    S.s[0][1] = __builtin_amdgcn_mfma_f32_16x16x32_bf16(ka[ks], qf[1][ks], S.s[0][1], 0, 0, 0); }
#pragma unroll
  for (int ks = 0; ks < 4; ++ks) {
    S.s[1][0] = __builtin_amdgcn_mfma_f32_16x16x32_bf16(kb[ks], qf[0][ks], S.s[1][0], 0, 0, 0);
    S.s[1][1] = __builtin_amdgcn_mfma_f32_16x16x32_bf16(kb[ks], qf[1][ks], S.s[1][1], 0, 0, 0); }
}
#define QK_SCHED() do { __builtin_amdgcn_sched_group_barrier(0x100, 4, 0); _Pragma("unroll") for (int i_ = 0; i_ < 16; ++i_) { __builtin_amdgcn_sched_group_barrier(0x008, 1, 0); __builtin_amdgcn_sched_group_barrier(0x002, 3, 0); } } while (0)
__device__ __forceinline__ void eh16(H16& S, float (&lsum)[2], bf16x8 (&pf)[2]) {
#pragma unroll
  for (int kl = 0; kl < 2; ++kl)
#pragma unroll
    for (int qb = 0; qb < 2; ++qb)
#pragma unroll
      for (int r = 0; r < 4; ++r) S.s[kl][qb][r] = __builtin_amdgcn_exp2f(S.s[kl][qb][r]);
#pragma unroll
  for (int qb = 0; qb < 2; ++qb) { const f32x4 a = S.s[0][qb], b = S.s[1][qb];
    lsum[qb] += ((a[0] + a[1]) + (a[2] + a[3])) + ((b[0] + b[1]) + (b[2] + b[3]));
    v4u w = {cvtpk(a[0], a[1]), cvtpk(a[2], a[3]), cvtpk(b[0], b[1]), cvtpk(b[2], b[3])}; pf[qb] = __builtin_bit_cast(bf16x8, w); }
}
constexpr int v16_off(int db, int part, int t) { return (32 * part + 16 * t) * V16_LD + db * 32; }
struct VF4 { s16x4 a0, a1, b0, b1, c0, c1, d0, d1; };
template <int PART, int G> __device__ __forceinline__ void vrd16(VF4& f, int vb) {
  f.a0 = tr_read<v16_off(4 * G, PART, 0)>(vb); f.a1 = tr_read<v16_off(4 * G, PART, 1)>(vb); f.b0 = tr_read<v16_off(4 * G + 1, PART, 0)>(vb); f.b1 = tr_read<v16_off(4 * G + 1, PART, 1)>(vb);
  f.c0 = tr_read<v16_off(4 * G + 2, PART, 0)>(vb); f.c1 = tr_read<v16_off(4 * G + 2, PART, 1)>(vb); f.d0 = tr_read<v16_off(4 * G + 3, PART, 0)>(vb); f.d1 = tr_read<v16_off(4 * G + 3, PART, 1)>(vb);
}
template <int G> __device__ __forceinline__ void vmma16(f32x4 (&o)[2][8], const VF4& f, const bf16x8 (&pf)[2]) {
#define PK(L, H) (bf16x8){L[0], L[1], L[2], L[3], H[0], H[1], H[2], H[3]}
  o[0][4 * G] = __builtin_amdgcn_mfma_f32_16x16x32_bf16(pf[0], PK(f.a0, f.a1), o[0][4 * G], 0, 0, 0);
  o[1][4 * G] = __builtin_amdgcn_mfma_f32_16x16x32_bf16(pf[1], PK(f.a0, f.a1), o[1][4 * G], 0, 0, 0);
  o[0][4 * G + 1] = __builtin_amdgcn_mfma_f32_16x16x32_bf16(pf[0], PK(f.b0, f.b1), o[0][4 * G + 1], 0, 0, 0);
  o[1][4 * G + 1] = __builtin_amdgcn_mfma_f32_16x16x32_bf16(pf[1], PK(f.b0, f.b1), o[1][4 * G + 1], 0, 0, 0);
  o[0][4 * G + 2] = __builtin_amdgcn_mfma_f32_16x16x32_bf16(pf[0], PK(f.c0, f.c1), o[0][4 * G + 2], 0, 0, 0);
  o[1][4 * G + 2] = __builtin_amdgcn_mfma_f32_16x16x32_bf16(pf[1], PK(f.c0, f.c1), o[1][4 * G + 2], 0, 0, 0);
  o[0][4 * G + 3] = __builtin_amdgcn_mfma_f32_16x16x32_bf16(pf[0], PK(f.d0, f.d1), o[0][4 * G + 3], 0, 0, 0);
  o[1][4 * G + 3] = __builtin_amdgcn_mfma_f32_16x16x32_bf16(pf[1], PK(f.d0, f.d1), o[1][4 * G + 3], 0, 0, 0);
#undef PK
}
typedef short v4i16_t __attribute__((ext_vector_type(4)));
__device__ __forceinline__ s16x4 vtr(LAS const unsigned char* p) { return __builtin_bit_cast(s16x4, __builtin_amdgcn_ds_read_tr16_b64_v4i16((LAS v4i16_t*)p)); }
template <int PART, int G> __device__ __forceinline__ void vld16(VF4& f, LAS const unsigned char* vp) {
  f.a0 = vtr(vp + v16_off(4 * G, PART, 0)); f.a1 = vtr(vp + v16_off(4 * G, PART, 1)); f.b0 = vtr(vp + v16_off(4 * G + 1, PART, 0)); f.b1 = vtr(vp + v16_off(4 * G + 1, PART, 1));
  f.c0 = vtr(vp + v16_off(4 * G + 2, PART, 0)); f.c1 = vtr(vp + v16_off(4 * G + 2, PART, 1)); f.d0 = vtr(vp + v16_off(4 * G + 3, PART, 0)); f.d1 = vtr(vp + v16_off(4 * G + 3, PART, 1));
}
template <int PART, int KPART> __device__ __forceinline__ void pvh16(f32x4 (&o)[2][8], LAS const unsigned char* vp, const bf16x8 (&pf)[2], bf16x8 (&kf)[4], LAS const unsigned char* Ks, int li, int g) {
  VF4 f0, f1;
  vld16<PART, 0>(f0, vp); vld16<PART, 1>(f1, vp);
  vmma16<0>(o, f0, pf); vmma16<1>(o, f1, pf);
  kload16<KPART, 0>(kf, Ks, li, g);
  __builtin_amdgcn_sched_group_barrier(0x100, 16, 0); __builtin_amdgcn_sched_group_barrier(0x008, 16, 0); __builtin_amdgcn_sched_group_barrier(0x100, 4, 0);
}
__device__ __forceinline__ void attn16_body(const bf16* __restrict__ Qb, const bf16* __restrict__ Kh, const bf16* __restrict__ Vh, bf16* __restrict__ Ob, int seq, LAS unsigned char* lds) {
  int tid_ = threadIdx.x; asm volatile("" : "+v"(tid_));
  const int tid = tid_, wid = __builtin_amdgcn_readfirstlane(tid >> 6), lane = tid & 63, li = lane & 15, g = lane >> 4;
  LAS unsigned char* V_lds = lds; LAS unsigned char* K_lds = lds + NBUF * SHM_V16;
  LAS float* li_l = (LAS float*)(lds + NBUF * SHM_V16 + NBUF * SHM_K16) + wid * 64;
  float lsum[2] = {0.f, 0.f}; f32x4 o[2][8]; bf16x8 qf[2][4];
#pragma unroll
  for (int qb = 0; qb < 2; ++qb)
#pragma unroll
    for (int db = 0; db < 8; ++db) o[qb][db] = (f32x4){0.f, 0.f, 0.f, 0.f};
#pragma unroll
  for (int qb = 0; qb < 2; ++qb)
#pragma unroll
    for (int ks = 0; ks < 4; ++ks) qf[qb][ks] = *(const GAS bf16x8*)(Qb + (long)(wid * QBLK + 16 * qb + li) * LDQ + 32 * ks + 8 * g);
  const int sr = tid >> 4, sc = (tid & 15) * 8;
  LAS const unsigned char* vp0 = V_lds + (4 * g + (li >> 2)) * V16_LD + (li & 3) * 8;
  bf16x8 vs0, vs1, ks0, ks1;
#define SLOAD(k0) do { vs0 = *(const GAS bf16x8*)(&Vh[(long)((k0) + sr) * LDK + sc]); vs1 = *(const GAS bf16x8*)(&Vh[(long)((k0) + 32 + sr) * LDK + sc]); \
    ks0 = *(const GAS bf16x8*)(&Kh[(long)((k0) + sr) * LDK + sc]); ks1 = *(const GAS bf16x8*)(&Kh[(long)((k0) + 32 + sr) * LDK + sc]); } while (0)
#define SWRITE(b) do { *(LAS bf16x8*)(V_lds + (b) * SHM_V16 + sr * V16_LD + sc * 2) = vs0; *(LAS bf16x8*)(V_lds + (b) * SHM_V16 + (32 + sr) * V16_LD + sc * 2) = vs1; const int kc = sc * 2; \
    *(LAS bf16x8*)(K_lds + (b) * SHM_K16 + KSWZ16(sr, kc)) = ks0; *(LAS bf16x8*)(K_lds + (b) * SHM_K16 + KSWZ16(32 + sr, kc)) = ks1; } while (0)
  H16 S0, S1; bf16x8 pf[2]; const int NT = seq / KVBLK;
  SLOAD(0); SWRITE(0); SLOAD(KVBLK); SWRITE(1); __syncthreads();
  bf16x8 kf[4];
  SBAR(); kload16<0, 0>(kf, K_lds, li, g); qkmma16<0>(S0, kf, K_lds, qf, li, g); kload16<1, 0>(kf, K_lds, li, g); SBAR();
  int bc = 0, bnx = 1, bw = 2;
  for (int j = 0; j < NT; ++j) {
    if (j + 2 < NT) SLOAD((j + 2) * KVBLK);
    SBAR(); qkmma16<1>(S1, kf, K_lds + bc * SHM_K16, qf, li, g); eh16(S0, lsum, pf); QK_SCHED(); SBAR();
    pvh16<0, 0>(o, vp0 + bc * SHM_V16, pf, kf, K_lds + bnx * SHM_K16, li, g); SBAR();
    if (j + 1 < NT) { qkmma16<0>(S0, kf, K_lds + bnx * SHM_K16, qf, li, g); eh16(S1, lsum, pf); QK_SCHED(); } else { eh16(S1, lsum, pf); } SBAR();
    pvh16<1, 1>(o, vp0 + bc * SHM_V16, pf, kf, K_lds + bnx * SHM_K16, li, g); SBAR();
    if (j + 2 < NT) SWRITE(bw);
    __syncthreads();
    { const int t_ = bc; bc = bnx; bnx = bw; bw = t_; }
  }
#pragma unroll
  for (int qb = 0; qb < 2; ++qb) { float v = lsum[qb]; v += __shfl_xor(v, 16); v += __shfl_xor(v, 32); if (g == 0) li_l[16 * qb + li] = v; }
  asm volatile("s_waitcnt lgkmcnt(0)" ::: "memory");
  bf16* Ow = Ob + (long)(wid * QBLK) * LDO;
#pragma unroll
  for (int qb = 0; qb < 2; ++qb)
#pragma unroll
    for (int r = 0; r < 4; ++r) { const int qrow = 16 * qb + 4 * g + r; const float rl = __builtin_amdgcn_rcpf(li_l[qrow]);
#pragma unroll
      for (int db = 0; db < 8; ++db) Ow[(long)qrow * LDO + 16 * db + li] = (bf16)(cvtpk(o[qb][db][r] * rl, 0.f) & 0xffffu); }
  __syncthreads();
#undef SLOAD
#undef SWRITE
}
#undef QK_SCHED
#undef KSWZ16
#undef KSWZ
#undef SBAR
}

constexpr int N_PHASES = 27;
template <int V> struct ICON { static constexpr int value = V; };
#ifndef MK_ONE_LAUNCH
#define MK_ONE_LAUNCH 1
#endif
__global__ void __launch_bounds__(NWAVES * 64, 2) fwd_kernel(Args args) {
    extern __shared__ __attribute__((aligned(16))) unsigned char lds[];
    Frame F;
    F.lds = (LAS unsigned char*)lds;
    F.MISC = (volatile LAS unsigned*)(F.lds + MISC_OFF);
    F.tid = threadIdx.x; F.lane = F.tid & 63; F.wave = __builtin_amdgcn_readfirstlane(F.tid >> 6);
    F.G = gridDim.x; { const int bx = blockIdx.x; F.vcu = (F.G % 8 == 0) ? (bx % 8) * (F.G / 8) + bx / 8 : bx; }
    const int vcu0 = F.vcu; int bidx = (int)blockIdx.x;
    F.ctl = (gu32*)(args.ws + WS_CTL);
    for (int u = F.tid; u < (LDS_BYTES - LDSCTL_OFF) / 4; u += NWAVES * 64) ((LAS unsigned*)(F.lds + LDSCTL_OFF))[u] = 0u;
    __syncthreads();
    const int lo = args.ph_lo, hi = args.ph_hi;
    XcdBarrier bar; bar.bar = (unsigned*)(F.ctl + CW_BAR); bar.x = 0; bar.st = nullptr;
    if (hi - lo > 1) bar = xcd_barrier_post((unsigned*)(F.ctl + CW_BAR), F.MISC + 8);
#if MK_ONE_LAUNCH
#define IN(k) true
#else
#define IN(k) (lo <= (k) && (k) < hi)
#endif
#define SEAM(k) do { if (IN(k) && IN((k) + 1)) { XcdBarrier bb_ = bar; asm volatile("" : "+s"(bb_.x)); unsigned* bp_ = bb_.bar; asm volatile("" : "+s"(bp_)); bb_.bar = bp_; xcd_barrier(bb_); } } while (0)
#define FRESH() do { int t_ = threadIdx.x; asm volatile("" : "+v"(t_)); F.tid = t_; F.lane = t_ & 63; F.wave = __builtin_amdgcn_readfirstlane(t_ >> 6); } while (0)

    const int NGW = F.G * NWAVES;
#define KARG_AS __attribute__((address_space(4)))
#define WSP() const KARG_AS Args* ka_ = (const KARG_AS Args*)__builtin_amdgcn_kernarg_segment_ptr(); asm volatile("" : "+s"(ka_)); unsigned char* ws = ka_->ws; asm volatile("" : "+s"(ws)); \
    { int v_ = vcu0; asm volatile("" : "+s"(v_)); F.vcu = v_; int b_ = (int)blockIdx.x; asm volatile("" : "+s"(b_)); bidx = b_; }
#define WSP0() unsigned char* ws = args.ws; asm volatile("" : "+s"(ws))
    if (IN(0)) { FRESH(); p0_prologue(F, args); }
    SEAM(0);
    if (IN(1)) { FRESH(); p1_modreduce(F, args); }
    SEAM(1);

    auto layer_half = [&](auto LC_, auto HC_) __attribute__((always_inline)) {
        constexpr int l = decltype(LC_)::value, half = decltype(HC_)::value;
        constexpr int pb = 2 + 12 * l; constexpr int last = (l == DEPTH - 1) ? 1 : 0;
        {
            if (half == 1) {
                if (IN(pb + 3)) { FRESH(); WSP(); norm_phase<l == 0>(F, (const float*)nullptr, l == 0 ? ka_->in[2] : (const float*)nullptr, (bf16*)(ws + WS_RES), ka_->in[6] + (size_t)(l * 3 + 1) * DM, (const float*)(ws + WS_MOD) + (size_t)l * 3 * MODW, 1, (bf16*)ka_->out, 0, (const float*)(ws + WS_PART)); }
                SEAM(pb + 3);
                if (IN(pb + 4)) { WSP();
                    pg8::Gemm g{(const bf16*)ka_->out, (const bf16*)(ws + WS_W + (size_t)l * W_LAYER + W_IN), M_ALL, NZ, DM, DM}; pg8::PanelOrder S; S.init(NPAN, NZ / 256, F.G, bidx, 0);
                    pg8::EpiBf16Plain E{(bf16*)(ws + WS_Z), NZ};
                    pg8::gemm_phase<pg8::EpiBf16Plain, pg8::PanelOrder, true, true>(F.lds + RING_OFF, g, S, E);
                }
                SEAM(pb + 4);
                if (IN(pb + 5)) { FRESH(); WSP(); const int gw = F.vcu * NWAVES + F.wave;
                    bf16* Z = (bf16*)(ws + WS_Z); bf16* MIX = (bf16*)(ws + WS_MIX);
                    const float* gw_l = ka_->in[14] + (size_t)l * 2 * 16 * 256; const float* gb_l = ka_->in[15] + (size_t)l * 2 * 256;
                    const float* wsl = ka_->in[17] + (size_t)l * 4 * 128 * 128; const float* bsl = ka_->in[18] + (size_t)l * 4 * 128; const float* gml = ka_->in[19] + (size_t)l * 512;
                    const float* qkg = ka_->in[13] + (size_t)l * 256; const float* rope_c = (const float*)(ws + WS_ROPE);
                    {
                    for (int U = F.vcu; U < NCH * 4; U += F.G) gla_a_unit(F, Z, (bf16*)(ws + WS_QG), (float*)(ws + WS_UT), (float*)(ws + WS_DV), U >> 2, U & 3, gw_l, gb_l);
                    for (int row = gw; row < M_ALL; row += NGW) qknorm_row(Z, row, qkg, rope_c, rope_c + 256 * 32, F.lane);
                    }
                }
                SEAM(pb + 5);
                if (IN(pb + 6)) { FRESH(); WSP(); gla_scan_phase(F, (const float*)(ws + WS_UT), (const float*)(ws + WS_DV), (bf16*)(ws + WS_ST)); }
                SEAM(pb + 6);
                if (IN(pb + 7)) { FRESH(); WSP();
                    bf16* Z = (bf16*)(ws + WS_Z); bf16* MIX = (bf16*)(ws + WS_MIX);
                    float nbl2;
                    { const float* qkg = ka_->in[13] + (size_t)l * 256; float gq = fmaxf(fabsf(qkg[F.lane]), fabsf(qkg[64 + F.lane])), gk = fmaxf(fabsf(qkg[128 + F.lane]), fabsf(qkg[192 + F.lane]));
#pragma unroll
                      for (int o = 1; o < 64; o <<= 1) { gq = fmaxf(gq, __shfl_xor(gq, o)); gk = fmaxf(gk, __shfl_xor(gk, o)); }
                      nbl2 = -11.313708499f * gq * gk * 1.4426950408889634f; nbl2 = __builtin_bit_cast(float, __builtin_amdgcn_readfirstlane(__builtin_bit_cast(int, nbl2))); }
                    { const int nU = last ? 1024 : 1040;
#define ATT_UNITS(FASTP) for (int U = F.vcu; U < nU; U += F.G) { \
                            int b, hq, kvh, seq; size_t row0; \
                            if (U < 1024) { const int i = U >> 8, v = U & 255, grp = v >> 6; b = grp >> 1; kvh = grp & 1; hq = kvh * 4 + i; row0 = (size_t)b * TOKB + CTXL + (size_t)(v & 63) * 256; seq = TOKB; } \
                            else { const int V = U - 1024; b = V >> 3; hq = V & 7; kvh = hq >> 2; row0 = (size_t)b * TOKB; seq = CTXL; } \
                            const size_t kv0 = (size_t)b * TOKB; \
                            if (FASTP) att::attn16_body(Z + row0 * NZ + ZQ + hq * 128, Z + kv0 * NZ + ZK + kvh * 128, Z + kv0 * NZ + ZV + kvh * 128, MIX + row0 * DM + MXA + hq * 128, seq, F.lds + RING_OFF); \
                            else att::attn_dense_body<false>(Z + row0 * NZ + ZQ + hq * 128, Z + kv0 * NZ + ZK + kvh * 128, Z + kv0 * NZ + ZV + kvh * 128, MIX + row0 * DM + MXA + hq * 128, seq, F.lds + RING_OFF); }
                        if (nbl2 >= -100.0f) { ATT_UNITS(true) } else { ATT_UNITS(false) }
#undef ATT_UNITS
                    }
                    FRESH(); const int gw = F.vcu * NWAVES + F.wave;
                    const float* gg = ka_->in[16] + (size_t)l * 512;
                    { unsigned* gcnt = (unsigned*)(ws + WS_CTL + 61440 + 64 * (12 + l)); volatile LAS unsigned* gslot = (volatile LAS unsigned*)(F.lds + MISC_OFF + 1032);
                      (void)gw;
                      for (int it_ = 0;; ++it_) {
                          if (threadIdx.x == 0) gslot[it_ & 1] = __hip_atomic_fetch_add(gcnt, 1u, __ATOMIC_RELAXED, __HIP_MEMORY_SCOPE_AGENT);
                          __syncthreads();
                          const unsigned bi = gslot[it_ & 1];
                          if (bi >= (unsigned)(NCH * 2)) break;
                          const int w = (int)bi * 8 + F.wave; const int chunk = w >> 4, c = chunk % CHB; if (last && c < 2) continue;
                          gla_c_item(Z, (const bf16*)(ws + WS_QG), (const bf16*)(ws + WS_ST), MIX, chunk, (w >> 2) & 3, w & 3, gg, F.lane); } }
                    { const float* wsl = ka_->in[17] + (size_t)l * 4 * 128 * 128; const float* bsl = ka_->in[18] + (size_t)l * 4 * 128; const float* gml = ka_->in[19] + (size_t)l * 512;
                      unsigned* qb = (unsigned*)(ws + WS_CTL + 61440 + 64 * (14 + l)); volatile LAS unsigned* qs = (volatile LAS unsigned*)(F.lds + MISC_OFF + 1040);
                      __syncthreads();
                      for (int it_ = 0;; ++it_) {
                          if (threadIdx.x == 0) qs[it_ & 1] = __hip_atomic_fetch_add(qb, 1u, __ATOMIC_RELAXED, __HIP_MEMORY_SCOPE_AGENT);
                          __syncthreads();
                          const int V = (int)qs[it_ & 1]; if (V >= NCH * 4) break;
                          const int chunk = V >> 2; if (!(last && (chunk % CHB) < 2)) gmlp_unit(F, Z, MIX, chunk, V & 3, wsl, bsl, gml); } }
                }
                SEAM(pb + 7);
                if (IN(pb + 8)) { WSP();
                    pg8::Gemm g{(const bf16*)(ws + WS_MIX), (const bf16*)(ws + WS_W + (size_t)l * W_LAYER + W_OUT), M_ALL, DM, DM, DM}; pg8::PanelOrder S; S.init(NPAN - 2, DM / 256, F.G, bidx, 1);
                    { pg8::EpiResid E{(const float*)nullptr, (float*)nullptr, (bf16*)(ws + WS_RES), (const float*)(ws + WS_MOD) + (size_t)l * 3 * MODW, 5, 1.0f};
                    pg8::gemm_phase<pg8::EpiResid, pg8::PanelOrder, true, true>(F.lds + RING_OFF, g, S, E); }
                    if (!last) {
                        pg8::Gemm gc{(const bf16*)(ws + WS_MIX), (const bf16*)(ws + WS_W + (size_t)l * W_LAYER + W_OUT), M_ALL, DM, DM / CTX_NS, DM}; pg8::CtxSplitOrder Sc; Sc.init(DM / 256, CTX_NS, DM / CTX_NS, F.G, bidx); Sc.dyn = (unsigned*)(ws + WS_CTL + 61440 + 64 * (10 + l)); Sc.slot = (volatile LAS unsigned*)(F.lds + MISC_OFF + 1028);
                        pg8::EpiCtxPartial Ec{(float*)(ws + WS_PART), (const float*)(ws + WS_MOD) + (size_t)l * 3 * MODW, 5, 1.0f};
                        pg8::gemm_phase<pg8::EpiCtxPartial, pg8::CtxSplitOrder, true, true>(F.lds + RING_OFF, gc, Sc, Ec); }
                }
                SEAM(pb + 8);
            }
            const int pf = pb + 9 * half, sub = 2 * half, first = (l == 0 && half == 0) ? 1 : 0, skipc = (last && half == 1) ? 1 : 0;
            if (IN(pf + 0)) { FRESH(); WSP();
                norm_phase(F, first ? ka_->in[0] : (const float*)nullptr, first ? ka_->in[2] : (const float*)nullptr, (bf16*)(ws + WS_RES), ka_->in[6] + (size_t)(l * 3 + sub) * DM, (const float*)(ws + WS_MOD) + (size_t)l * 3 * MODW, sub, (bf16*)ka_->out, skipc,
                           (half == 1 ? !last : l > 0) ? (const float*)(ws + WS_PART) : (const float*)nullptr); }
            SEAM(pf + 0);
            if (IN(pf + 1)) { WSP();
                pg8::Gemm g{(const bf16*)ka_->out, (const bf16*)(ws + WS_W + (size_t)l * W_LAYER + (half ? W_GU2 : W_GU1)), M_ALL, NGU, DM, DM}; pg8::PanelOrder S; S.init(skipc ? NPAN - 2 : NPAN, NGU / 256, F.G, bidx, skipc); S.dyn = (unsigned*)(ws + WS_CTL + 61440 + 64 * (l * 2 + half)); S.slot = (volatile LAS unsigned*)(F.lds + MISC_OFF + 1024);
                pg8::EpiSwiglu E{(bf16*)(ws + WS_H), DFF};
                pg8::gemm_phase<pg8::EpiSwiglu, pg8::PanelOrder, true, true>(F.lds + RING_OFF, g, S, E);
            }
            SEAM(pf + 1);
            if (IN(pf + 2)) { WSP();
                pg8::Gemm g{(const bf16*)(ws + WS_H), (const bf16*)(ws + WS_W + (size_t)l * W_LAYER + (half ? W_D2 : W_D1)), M_ALL, DM, DFF, DFF}; pg8::PanelOrder S; S.init(NPAN - 2, DM / 256, F.G, bidx, 1); S.reverse_rounds();
                { pg8::EpiResid E{first ? ka_->in[0] : (const float*)nullptr, (float*)nullptr, (bf16*)(ws + WS_RES), (const float*)(ws + WS_MOD) + (size_t)l * 3 * MODW, 3 * sub + 2, 0.5f};
                pg8::gemm_phase<pg8::EpiResid, pg8::PanelOrder, true, true>(F.lds + RING_OFF, g, S, E); }
                if (!skipc) {
                    pg8::Gemm gc{(const bf16*)(ws + WS_H), (const bf16*)(ws + WS_W + (size_t)l * W_LAYER + (half ? W_D2 : W_D1)), M_ALL, DM, DFF / CTX_NS, DFF}; pg8::CtxSplitOrder Sc; Sc.init(DM / 256, CTX_NS, DFF / CTX_NS, F.G, bidx); Sc.dyn = (unsigned*)(ws + WS_CTL + 61440 + 64 * (6 + l * 2 + half)); Sc.slot = (volatile LAS unsigned*)(F.lds + MISC_OFF + 1028);
                    pg8::EpiCtxPartial Ec{(float*)(ws + WS_PART), (const float*)(ws + WS_MOD) + (size_t)l * 3 * MODW, 3 * sub + 2, 0.5f};
                    pg8::gemm_phase<pg8::EpiCtxPartial, pg8::CtxSplitOrder, true, true>(F.lds + RING_OFF, gc, Sc, Ec); }
            }
            SEAM(pf + 2);
        }
    };
    static_assert(DEPTH == 2, "the four instantiations below");
    layer_half(ICON<0>{}, ICON<0>{}); layer_half(ICON<0>{}, ICON<1>{}); layer_half(ICON<1>{}, ICON<0>{}); layer_half(ICON<1>{}, ICON<1>{});
    if (IN(26)) { FRESH(); WSP(); final_norm_phase(F, (const bf16*)(ws + WS_RES), ka_->out, ka_->in[20]); }
#undef IN
#undef SEAM
}

extern "C" void kernel_launch(void* const* d_in, const int* in_sizes, int n_in, void* d_out, int out_size, void* d_ws, size_t ws_size, hipStream_t stream) {
    static int grid = 0;
    if (grid == 0) {
        if (n_in != 21 || in_sizes[0] != NB * SEQ * DM || out_size != NB * SEQ * DM || ws_size < WS_END) {
            fprintf(stderr, "kernel_launch: shape mismatch: n_in %d in0 %d out %d ws %zu (need %zu)\n", n_in, n_in > 0 ? in_sizes[0] : -1, out_size, ws_size, (size_t)WS_END); grid = -1; return; }
        int dev = 0, cus = 0, per_cu = 0;
        if (hipGetDevice(&dev) != hipSuccess || hipDeviceGetAttribute(&cus, hipDeviceAttributeMultiprocessorCount, dev) != hipSuccess) { fprintf(stderr, "kernel_launch: device query failed\n"); grid = -1; return; }
        if (hipFuncSetAttribute((const void*)fwd_kernel, hipFuncAttributeMaxDynamicSharedMemorySize, LDS_BYTES) != hipSuccess) { fprintf(stderr, "kernel_launch: hipFuncSetAttribute failed\n"); grid = -1; return; }
        if (hipOccupancyMaxActiveBlocksPerMultiprocessor(&per_cu, (const void*)fwd_kernel, NWAVES * 64, LDS_BYTES) != hipSuccess || per_cu < 1)
            fprintf(stderr, "kernel_launch: note: occupancy query reports %d workgroups per CU\n", per_cu);
        (void)hipGetLastError();
        grid = cus;
    }
    if (grid < 0) return;
    if (hipMemsetAsync((char*)d_ws + WS_CTL, 0, CTL_ZERO_BYTES, stream) != hipSuccess) { fprintf(stderr, "kernel_launch: memset failed\n"); return; }
    Args a{};
    for (int i = 0; i < 21; ++i) a.in[i] = (const float*)d_in[i];
    a.out = (float*)d_out; a.ws = (unsigned char*)d_ws;
#if MK_ONE_LAUNCH
    a.ph_lo = 0; a.ph_hi = N_PHASES;
    hipLaunchKernelGGL(fwd_kernel, dim3(grid), dim3(NWAVES * 64), LDS_BYTES, stream, a);
#else
    for (int p = 0; p < N_PHASES; ++p) { a.ph_lo = p; a.ph_hi = p + 1; hipLaunchKernelGGL(fwd_kernel, dim3(grid), dim3(NWAVES * 64), LDS_BYTES, stream, a); }
#endif
    const hipError_t le = hipPeekAtLastError();
    if (le != hipSuccess) fprintf(stderr, "kernel_launch: launch failed: %s\n", hipGetErrorName(le));
}
```

```cpp
#include <hip/hip_runtime.h>
#include <cstdio>
#include <cstdint>
#include <cmath>
namespace pg8 {
#define PG8_LAS __attribute__((address_space(3)))
typedef unsigned short bf16_t;
typedef short bf16x8 __attribute__((ext_vector_type(8)));
typedef float f32x4 __attribute__((ext_vector_type(4)));
typedef unsigned u32x4 __attribute__((ext_vector_type(4)));
constexpr int BM = 256, BK = 64, HALF = 128, HTB = HALF * BK * 2  , STAGE_BYTES = 8 * HTB, NXCD = 8, WGM = 4;

__host__ __device__ __forceinline__ int lds_byte(int r, int c) { const int st = (r >> 4) * 2 + (c >> 5), rr = r & 15, cc = c & 31, ob = rr * 64 + cc * 2; return st * 1024 + (ob ^ (((ob >> 9) & 1) << 5)); }
__host__ __device__ __forceinline__ void stage_rc(int b, int& R, int& C) { const int st = b / 1024, sb = b % 1024, swz = sb ^ (((sb >> 9) & 1) << 5); R = (st >> 1) * 16 + swz / 64; C = (st & 1) * 32 + (swz % 64) / 2; }
__host__ __device__ __forceinline__ int perm32(int rho) { const int n = rho >> 4, i = rho & 15; return 8 * (i >> 2) + 4 * n + (i & 3); }

struct Unit { int pm, pn, ko, ks; };
struct Gemm { const bf16_t* A; const bf16_t* Bt; int M, N, K, ld; };

struct StaticOrder {
    static constexpr bool DYN = false;
    int nM, nN, nwg, G, c;
    __host__ __device__ void init(int M, int N, int G_, int c_) { nM = M / BM; nN = N / BM; nwg = nM * nN; G = G_; c = c_; }
    __host__ __device__ bool next(int i, Unit& u) const {
        const long L = (long)i * G + c; if (L >= nwg) return false;
        int wgid = (int)L; { const int q = nwg / NXCD, r = nwg % NXCD, xcd = wgid % NXCD, off = wgid / NXCD; wgid = (xcd < r ? xcd * (q + 1) : r * (q + 1) + (xcd - r) * q) + off; }
        const int nig = WGM * nN, gid = wgid / nig, fm = gid * WGM, gsz = (nM - fm) < WGM ? (nM - fm) : WGM;
        u.pm = fm + ((wgid % nig) % gsz); u.pn = (wgid % nig) / gsz; u.ko = 0; u.ks = 0; return true;
    }
    __device__ __forceinline__ void a_ready(const Unit&) const {}
    __device__ __forceinline__ void done(const Unit&) const {}
};

typedef float f32x2c_t __attribute__((ext_vector_type(2))); typedef __bf16 bf16x2c_t __attribute__((ext_vector_type(2)));
__device__ __forceinline__ unsigned cvt_pk_bf16(float lo, float hi) { f32x2c_t v = {lo, hi}; bf16x2c_t b = __builtin_convertvector(v, bf16x2c_t); return __builtin_bit_cast(unsigned, b); }
typedef float f32x2 __attribute__((ext_vector_type(2)));
constexpr int PAN_PER_B = 65, RES_LD = 2048;
__device__ __forceinline__ int panel_set(int pm) { const int b = pm / PAN_PER_B, jp = pm - b * PAN_PER_B; return jp == 0 ? 2 : b; }
template <class T> __device__ __forceinline__ T* panel_ptr(T* lat, T* ctx, int pm) {
    const int b = pm / PAN_PER_B, jp = pm - b * PAN_PER_B;
    return jp == 0 ? ctx + (size_t)b * 256 * RES_LD : lat + ((size_t)b * 16384 + (size_t)(jp - 1) * 256) * RES_LD;
}
struct PanelOrder {
    static constexpr bool DYN = true;
    int nM, nN, nwg, G, c, skip, rev;
    unsigned* dyn; volatile PG8_LAS unsigned* slot;
    __device__ void init(int nM_, int nN_, int G_, int c_, int skip_) { nM = nM_; nN = nN_; nwg = nM * nN; G = G_; c = c_; skip = skip_; rev = 0; dyn = nullptr; slot = nullptr; }
    __device__ bool is_dyn(int i) const { return dyn != nullptr && rev == 0 && (nwg % G) != 0 && i == nwg / G; }
    __device__ void dyn_request(int lane) const { if (lane == 0) { const unsigned k = __hip_atomic_fetch_add(dyn, 1u, __ATOMIC_RELAXED, __HIP_MEMORY_SCOPE_AGENT); *slot = k; } }
    __device__ bool dyn_fetch(Unit& u) const { const unsigned k = *slot; const long L = (long)(nwg / G) * G + (long)k; if (L >= nwg) return false; return map(L, u); }
    __device__ void reverse_rounds() { rev = (nwg % G == 0) ? nwg / G : 0; }
    __device__ bool next(int i, Unit& u) const {
        if (rev) { if (i >= rev) return false; i = rev - 1 - i; }
        const long L = (long)i * G + c; if (L >= nwg) return false;
        return map(L, u);
    }
    __device__ bool map(long L, Unit& u) const {
        int wgid = (int)L; { const int q = nwg / NXCD, r = nwg % NXCD, xcd = wgid % NXCD, off = wgid / NXCD; wgid = (xcd < r ? xcd * (q + 1) : r * (q + 1) + (xcd - r) * q) + off; }
        const int nig = WGM * nN, gid = wgid / nig, fm = gid * WGM, gsz = (nM - fm) < WGM ? (nM - fm) : WGM;
        int pm = fm + ((wgid % nig) % gsz); u.pn = (wgid % nig) / gsz;
        if (skip) pm += 1 + (pm >= 64 ? 1 : 0);
        u.pm = pm; u.ko = 0; u.ks = 0; return true;
    }
    __device__ __forceinline__ void a_ready(const Unit&) const {}
    __device__ __forceinline__ void done(const Unit&) const {}
};
struct EpiBf16Plain {
    static constexpr bool PERM = true, AFTER_DRAIN = false;
    bf16_t* O; int ldc;
    __device__ __forceinline__ void operator()(const f32x4 (&acc)[2][2][4][2], const Unit& u, int wr, int wc, int fr, int fq) const {
        const int row0 = u.pm * BM + wr * 64 + fr, col0 = u.pn * BM + wc * 32 + 8 * fq;
#pragma unroll
        for (int ai = 0; ai < 2; ++ai)
#pragma unroll
            for (int m = 0; m < 4; ++m) { bf16_t* rowp = O + (size_t)(row0 + ai * HALF + m * 16) * ldc + col0;
#pragma unroll
                for (int bj = 0; bj < 2; ++bj) { const f32x4 v0 = acc[ai][bj][m][0], v1 = acc[ai][bj][m][1];
                    u32x4 w; w.x = cvt_pk_bf16(v0[0], v0[1]); w.y = cvt_pk_bf16(v0[2], v0[3]); w.z = cvt_pk_bf16(v1[0], v1[1]); w.w = cvt_pk_bf16(v1[2], v1[3]);
                    *(u32x4*)(rowp + bj * HALF) = w; } }
    }
};
__device__ __forceinline__ float silu_f(float g) { return g * __builtin_amdgcn_rcpf(1.0f + __builtin_amdgcn_exp2f(-1.4426950408889634f * g)); }
struct EpiSwiglu {
    static constexpr bool PERM = true, AFTER_DRAIN = false;
    bf16_t* H; int ldh;
    __device__ __forceinline__ void operator()(const f32x4 (&acc)[2][2][4][2], const Unit& u, int wr, int wc, int fr, int fq) const {
        const int row0 = u.pm * BM + wr * 64 + fr, col0 = u.pn * HALF + wc * 32 + 8 * fq;
#pragma unroll
        for (int ai = 0; ai < 2; ++ai)
#pragma unroll
            for (int m = 0; m < 4; ++m) { bf16_t* rowp = H + (size_t)(row0 + ai * HALF + m * 16) * ldh + col0;
                const f32x4 g0 = acc[ai][0][m][0], g1 = acc[ai][0][m][1], u0 = acc[ai][1][m][0], u1 = acc[ai][1][m][1];
                u32x4 w; w.x = cvt_pk_bf16(silu_f(g0[0]) * u0[0], silu_f(g0[1]) * u0[1]); w.y = cvt_pk_bf16(silu_f(g0[2]) * u0[2], silu_f(g0[3]) * u0[3]);
                w.z = cvt_pk_bf16(silu_f(g1[0]) * u1[0], silu_f(g1[1]) * u1[1]); w.w = cvt_pk_bf16(silu_f(g1[2]) * u1[2], silu_f(g1[3]) * u1[3]);
                __builtin_nontemporal_store(w, (u32x4*)rowp); }
    }
};
typedef _Float16 h16x2 __attribute__((ext_vector_type(2)));
__device__ __forceinline__ unsigned pk_h16(float lo, float hi) { const _Float16 a = (_Float16)lo, b = (_Float16)hi; return (unsigned)__builtin_bit_cast(unsigned short, a) | ((unsigned)__builtin_bit_cast(unsigned short, b) << 16); }
__device__ __forceinline__ void unpack8(const u32x4 w, float (&y)[8]) {
    const unsigned wx = w.x, wy = w.y, wz = w.z, ww = w.w;
    const h16x2 a = __builtin_bit_cast(h16x2, wx), b = __builtin_bit_cast(h16x2, wy), c = __builtin_bit_cast(h16x2, wz), d = __builtin_bit_cast(h16x2, ww);
    y[0] = (float)a[0]; y[1] = (float)a[1]; y[2] = (float)b[0]; y[3] = (float)b[1]; y[4] = (float)c[0]; y[5] = (float)c[1]; y[6] = (float)d[0]; y[7] = (float)d[1]; }
struct EpiResid {
    static constexpr bool PERM = true, AFTER_DRAIN = false;
    const float* base_f32  ; float* out_f32  ; bf16_t* res  ;
    const float* gate  ; int gidx; float scale;
    __device__ __forceinline__ void operator()(const f32x4 (&acc)[2][2][4][2], const Unit& u, int wr, int wc, int fr, int fq) const {
        const int col0 = u.pn * BM + wc * 32 + 8 * fq, set = panel_set(u.pm), r0 = wr * 64 + fr;
        const float* gp = gate + (size_t)(set * 9 + gidx) * 2048 + col0;
        f32x4 gv[2][2];
#pragma unroll
        for (int bj = 0; bj < 2; ++bj)
#pragma unroll
            for (int n = 0; n < 2; ++n) gv[bj][n] = *(const f32x4*)(gp + bj * HALF + n * 4) * scale;
        bf16_t* rp = res + ((size_t)u.pm * BM + r0) * RES_LD + col0;
        const float* bf = base_f32 ? panel_ptr(base_f32, base_f32, u.pm) + (size_t)r0 * RES_LD + col0 : nullptr;
        float* of = out_f32 ? panel_ptr(out_f32, out_f32, u.pm) + (size_t)r0 * RES_LD + col0 : nullptr;
        f32x4 cur[2][2], nxt[2][2];
        if (bf) {
#pragma unroll
            for (int bj = 0; bj < 2; ++bj)
#pragma unroll
                for (int n = 0; n < 2; ++n) cur[bj][n] = *(const f32x4*)(bf + bj * HALF + n * 4);
        } else {
#pragma unroll
            for (int bj = 0; bj < 2; ++bj) { float y[8]; unpack8(*(const u32x4*)(rp + bj * HALF), y); cur[bj][0] = (f32x4){y[0], y[1], y[2], y[3]}; cur[bj][1] = (f32x4){y[4], y[5], y[6], y[7]}; }
        }
#pragma unroll
        for (int g = 0; g < 8; ++g) { const int ai = g >> 2, m = g & 3; const size_t off = (size_t)(ai * HALF + m * 16) * RES_LD;
            if (g < 7) { const size_t offn = (size_t)(((g + 1) >> 2) * HALF + ((g + 1) & 3) * 16) * RES_LD;
                if (bf) {
#pragma unroll
                    for (int bj = 0; bj < 2; ++bj)
#pragma unroll
                        for (int n = 0; n < 2; ++n) nxt[bj][n] = *(const f32x4*)(bf + offn + bj * HALF + n * 4);
                } else {
#pragma unroll
                    for (int bj = 0; bj < 2; ++bj) { float y[8]; unpack8(*(const u32x4*)(rp + offn + bj * HALF), y); nxt[bj][0] = (f32x4){y[0], y[1], y[2], y[3]}; nxt[bj][1] = (f32x4){y[4], y[5], y[6], y[7]}; }
                } }
#pragma unroll
            for (int bj = 0; bj < 2; ++bj) { const f32x4 o0 = cur[bj][0] + gv[bj][0] * acc[ai][bj][m][0], o1 = cur[bj][1] + gv[bj][1] * acc[ai][bj][m][1];
                if (of) { *(f32x4*)(of + off + bj * HALF) = o0; *(f32x4*)(of + off + bj * HALF + 4) = o1; }
                else { u32x4 w; w.x = pk_h16(o0[0], o0[1]); w.y = pk_h16(o0[2], o0[3]); w.z = pk_h16(o1[0], o1[1]); w.w = pk_h16(o1[2], o1[3]); *(u32x4*)(rp + off + bj * HALF) = w; } }
            asm volatile("" ::: "memory");
#pragma unroll
            for (int bj = 0; bj < 2; ++bj)
#pragma unroll
                for (int n = 0; n < 2; ++n) cur[bj][n] = nxt[bj][n]; }
    }
};

struct CtxSplitOrder {
    static constexpr bool DYN = false;
    int nN, NS, Ks, nwg, G, c;
    unsigned* dyn; volatile PG8_LAS unsigned* slot;
    __device__ void init(int nN_, int NS_, int Ks_, int G_, int c_) { nN = nN_; NS = NS_; Ks = Ks_; nwg = 2 * nN * NS; G = G_; c = c_; dyn = nullptr; slot = nullptr; }
    __device__ bool next(int i, Unit& u) const {
        int L;
        if (dyn != nullptr && nwg <= G) {
            if (i != 0) return false;
            if (threadIdx.x == 0) *slot = __hip_atomic_fetch_add(dyn, 1u, __ATOMIC_RELAXED, __HIP_MEMORY_SCOPE_AGENT);
            __syncthreads(); L = (int)*slot;
        } else L = i * G + c;
        if (L >= nwg) return false;
        const int ks = L % NS, t = L / NS; u.pn = t % nN; u.pm = (t / nN) * PAN_PER_B; u.ks = ks; u.ko = ks * Ks; return true;
    }
    __device__ __forceinline__ void a_ready(const Unit&) const {}
    __device__ __forceinline__ void done(const Unit&) const {}
};
struct EpiCtxPartial {
    static constexpr bool PERM = false, AFTER_DRAIN = false;
    float* part  ; const float* gate  ; int gidx; float scale;
    __device__ __forceinline__ void operator()(const f32x4 (&acc)[2][2][4][2], const Unit& u, int wr, int wc, int fr, int fq) const {
        const int col0 = u.pn * BM + wc * 32 + 4 * fq, b = u.pm / PAN_PER_B;
        float* out = part + ((size_t)u.ks * 512 + (size_t)b * 256) * RES_LD;
        const float* gp = gate + (size_t)(2 * 9 + gidx) * 2048 + col0;
        f32x4 gv[2][2];
#pragma unroll
        for (int bj = 0; bj < 2; ++bj)
#pragma unroll
            for (int n = 0; n < 2; ++n) gv[bj][n] = *(const f32x4*)(gp + bj * HALF + n * 16) * scale;
#pragma unroll
        for (int ai = 0; ai < 2; ++ai)
#pragma unroll
            for (int m = 0; m < 4; ++m) { const size_t off = (size_t)(ai * HALF + wr * 64 + m * 16 + fr) * RES_LD + col0;
#pragma unroll
                for (int bj = 0; bj < 2; ++bj)
#pragma unroll
                    for (int n = 0; n < 2; ++n) *(f32x4*)(out + off + bj * HALF + n * 16) = gv[bj][n] * acc[ai][bj][m][n]; }
    }
};
template <class Epi, class Sched, bool ALIGN_EPI = false, bool SP2 = false>
__device__ __forceinline__ void gemm_phase(PG8_LAS unsigned char* lds, const Gemm g, const Sched& S, const Epi& E) {
    int tid_ = threadIdx.x; asm volatile("" : "+v"(tid_));
    const int tid = tid_, wid = __builtin_amdgcn_readfirstlane(tid >> 6), lane = tid & 63, wr = wid >> 2, wc = wid & 3, fr = lane & 15, fq = lane >> 4;
    const int K = g.K, ld = g.ld, nt = K / BK;
    unsigned voffA[2], voffB[2];
#pragma unroll
    for (int i = 0; i < 2; ++i) { int R, C; stage_rc(tid * 16 + i * 8192, R, C); const int Rb = Epi::PERM ? ((R & ~31) + perm32(R & 31)) : R;
        voffA[i] = (unsigned)(R * ld + C) * 2u; voffB[i] = (unsigned)(Rb * ld + C) * 2u; }
    const size_t kstep = (size_t)(BK * 2);
    const size_t hstep = (size_t)HALF * ld * 2;
    const size_t tstep = 2 * hstep;
    const unsigned ldsw = (unsigned)wid * 1024u;
    const int aoff = lds_byte(wr * 64 + fr, fq * 8), boff = lds_byte(wc * 32 + fr, fq * 8);
#define PG8_SA(b, h) (((b) * 2 + (h)) * HTB)
#define PG8_SB(b, h) ((4 + (b) * 2 + (h)) * HTB)
#define PG8_STAGE(bufoff, gbase, voff) do { _Pragma("unroll") for (int _i = 0; _i < 2; ++_i) \
        __builtin_amdgcn_global_load_lds((const unsigned*)((const char*)(gbase) + (voff)[_i]), (PG8_LAS unsigned*)(lds + (bufoff) + ldsw + _i * 8192), 16, 0, 0); } while (0)
#define PG8_LDA(dst, b, h) do { _Pragma("unroll") for (int m = 0; m < 4; ++m) _Pragma("unroll") for (int k = 0; k < 2; ++k) dst[m][k] = *(const PG8_LAS bf16x8*)(lds + PG8_SA(b, h) + aoff + m * 2048 + k * 1024); } while (0)
#define PG8_LDB(dst, b, h) do { _Pragma("unroll") for (int n = 0; n < 2; ++n) _Pragma("unroll") for (int k = 0; k < 2; ++k) dst[n][k] = *(const PG8_LAS bf16x8*)(lds + PG8_SB(b, h) + boff + n * 2048 + k * 1024); } while (0)
#define PG8_MMA(ai, bj, At, Bt) do { __builtin_amdgcn_s_setprio(1); _Pragma("unroll") for (int m = 0; m < 4; ++m) _Pragma("unroll") for (int n = 0; n < 2; ++n) _Pragma("unroll") for (int k = 0; k < 2; ++k) \
        acc[ai][bj][m][n] = __builtin_amdgcn_mfma_f32_16x16x32_bf16(Bt[n][k], At[m][k], acc[ai][bj][m][n], 0, 0, 0); __builtin_amdgcn_s_setprio(0); } while (0)
#define PG8_WAIT_V(n) asm volatile("s_waitcnt vmcnt(" #n ")" ::: "memory")
#define PG8_WAIT_L(n) asm volatile("s_waitcnt lgkmcnt(" #n ")" ::: "memory")
#define PG8_BAR __builtin_amdgcn_s_barrier()
#define PG8_SCHED __builtin_amdgcn_sched_barrier(0)
    Unit cur, nxt; int ui = 0;
    if (!S.next(0, cur)) return;
    f32x4 acc[2][2][4][2];
#pragma unroll
    for (int a = 0; a < 2; ++a)
#pragma unroll
        for (int b = 0; b < 2; ++b)
#pragma unroll
            for (int m = 0; m < 4; ++m)
#pragma unroll
                for (int n = 0; n < 2; ++n) acc[a][b][m][n] = (f32x4){0.f, 0.f, 0.f, 0.f};
    bf16x8 At[4][2], B0[2][2], B1[2][2];
    const char* cA = (const char*)g.A + (size_t)cur.pm * tstep + (size_t)cur.ko * 2; const char* cB = (const char*)g.Bt + (size_t)cur.pn * tstep + (size_t)cur.ko * 2;
    S.a_ready(cur);
    if constexpr (SP2) {
        PG8_STAGE(PG8_SB(0, 0), cB, voffB); PG8_STAGE(PG8_SB(0, 1), cB + hstep, voffB); PG8_STAGE(PG8_SA(0, 0), cA, voffA); PG8_STAGE(PG8_SA(0, 1), cA + hstep, voffA);
        if (wr == 1) PG8_BAR;
        PG8_WAIT_V(2); PG8_BAR;
        PG8_STAGE(PG8_SB(1, 0), cB + kstep, voffB); PG8_STAGE(PG8_SA(1, 0), cA + kstep, voffA); PG8_STAGE(PG8_SB(1, 1), cB + hstep + kstep, voffB);
        PG8_WAIT_V(6); PG8_BAR;
    } else {
        PG8_STAGE(PG8_SB(0, 0), cB, voffB); PG8_STAGE(PG8_SA(0, 0), cA, voffA); PG8_STAGE(PG8_SB(0, 1), cB + hstep, voffB); PG8_STAGE(PG8_SA(0, 1), cA + hstep, voffA);
        if (wr == 1) PG8_BAR;
        PG8_WAIT_V(4); PG8_BAR;
        PG8_STAGE(PG8_SB(1, 0), cB + kstep, voffB); PG8_STAGE(PG8_SA(1, 0), cA + kstep, voffA); PG8_STAGE(PG8_SB(1, 1), cB + hstep + kstep, voffB);
        PG8_WAIT_V(6); PG8_BAR;
    }
    for (;;) {
        bool has_next, pending = false;
        if constexpr (Sched::DYN) { if (S.is_dyn(ui + 1)) { pending = true; has_next = true; if (wid == 0) S.dyn_request(lane); } else has_next = S.next(ui + 1, nxt); }
        else has_next = S.next(ui + 1, nxt);
        const char* nA = cA; const char* nB = cB;
        if (has_next && !pending) { nA = (const char*)g.A + (size_t)nxt.pm * tstep + (size_t)nxt.ko * 2; nB = (const char*)g.Bt + (size_t)nxt.pn * tstep + (size_t)nxt.ko * 2; }
        for (int t = 0; t < nt; t += 2) {
            const bool last = (t == nt - 2);
            if constexpr (Sched::DYN) { if (last && pending) { pending = false; has_next = S.dyn_fetch(nxt);
                if (has_next) { nA = (const char*)g.A + (size_t)nxt.pm * tstep + (size_t)nxt.ko * 2; nB = (const char*)g.Bt + (size_t)nxt.pn * tstep + (size_t)nxt.ko * 2; } } }
            const char* a1 = cA + (size_t)(t + 1) * kstep;
            const char* a2 = last ? nA : cA + (size_t)(t + 2) * kstep; const char* b2 = last ? nB : cB + (size_t)(t + 2) * kstep;
            const char* a3 = a2 + kstep; const char* b3 = b2 + kstep;
            if (last && has_next) S.a_ready(nxt);
            if constexpr (SP2) {
            PG8_LDB(B0, 0, 0); PG8_LDB(B1, 0, 1); PG8_SCHED; PG8_LDA(At, 0, 0); PG8_STAGE(PG8_SA(1, 1), a1 + hstep, voffA);
            PG8_WAIT_V(8); PG8_WAIT_L(0); PG8_BAR; PG8_MMA(0, 0, At, B0); PG8_MMA(0, 1, At, B1); PG8_BAR; PG8_SCHED;
            PG8_LDA(At, 0, 1); PG8_STAGE(PG8_SB(0, 0), b2, voffB); PG8_STAGE(PG8_SB(0, 1), b2 + hstep, voffB); PG8_STAGE(PG8_SA(0, 0), a2, voffA);
            PG8_WAIT_V(8); PG8_WAIT_L(0); PG8_BAR; PG8_MMA(1, 0, At, B0); PG8_MMA(1, 1, At, B1); PG8_BAR; PG8_SCHED;
            PG8_LDB(B0, 1, 0); PG8_LDB(B1, 1, 1); PG8_SCHED; PG8_LDA(At, 1, 0); PG8_STAGE(PG8_SA(0, 1), a2 + hstep, voffA);
            PG8_WAIT_V(8); PG8_WAIT_L(0); PG8_BAR; PG8_MMA(0, 0, At, B0); PG8_MMA(0, 1, At, B1); PG8_BAR; PG8_SCHED;
            PG8_LDA(At, 1, 1); PG8_STAGE(PG8_SB(1, 0), b3, voffB); PG8_STAGE(PG8_SB(1, 1), b3 + hstep, voffB); PG8_STAGE(PG8_SA(1, 0), a3, voffA);
            PG8_WAIT_V(8); PG8_WAIT_L(0); PG8_BAR; PG8_MMA(1, 0, At, B0); PG8_MMA(1, 1, At, B1); PG8_BAR; PG8_SCHED;
            } else {
            PG8_LDB(B0, 0, 0); PG8_SCHED; PG8_LDA(At, 0, 0); PG8_STAGE(PG8_SA(1, 1), a1 + hstep, voffA);
            PG8_WAIT_L(8); PG8_BAR; PG8_WAIT_L(0); PG8_MMA(0, 0, At, B0); PG8_BAR; PG8_SCHED;
            PG8_LDB(B1, 0, 1); PG8_STAGE(PG8_SB(0, 0), b2, voffB);
            PG8_BAR; PG8_WAIT_L(0); PG8_MMA(0, 1, At, B1); PG8_BAR;
            PG8_LDA(At, 0, 1); PG8_STAGE(PG8_SA(0, 0), a2, voffA);
            PG8_BAR; PG8_WAIT_L(0); PG8_MMA(1, 0, At, B0); PG8_BAR; PG8_SCHED;
            PG8_STAGE(PG8_SB(0, 1), b2 + hstep, voffB);
            PG8_WAIT_V(6); PG8_BAR; PG8_MMA(1, 1, At, B1); PG8_BAR;
            PG8_LDB(B0, 1, 0); PG8_SCHED; PG8_LDA(At, 1, 0); PG8_STAGE(PG8_SA(0, 1), a2 + hstep, voffA);
            PG8_WAIT_L(8); PG8_BAR; PG8_WAIT_L(0); PG8_MMA(0, 0, At, B0); PG8_BAR; PG8_SCHED;
            PG8_LDB(B1, 1, 1); PG8_STAGE(PG8_SB(1, 0), b3, voffB);
            PG8_BAR; PG8_WAIT_L(0); PG8_MMA(0, 1, At, B1); PG8_BAR;
            PG8_LDA(At, 1, 1); PG8_STAGE(PG8_SA(1, 0), a3, voffA);
            PG8_BAR; PG8_WAIT_L(0); PG8_MMA(1, 0, At, B0); PG8_BAR; PG8_SCHED;
            PG8_STAGE(PG8_SB(1, 1), b3 + hstep, voffB);
            PG8_WAIT_V(6); PG8_BAR; PG8_MMA(1, 1, At, B1); PG8_BAR;
            }
        }
        if constexpr (ALIGN_EPI) { if (wr == 0) PG8_BAR; }
        if constexpr (!Epi::AFTER_DRAIN) { E(acc, cur, wr, wc, fr, fq); S.done(cur); }
        if (!has_next) break;
#pragma unroll
        for (int a = 0; a < 2; ++a)
#pragma unroll
            for (int b = 0; b < 2; ++b)
#pragma unroll
                for (int m = 0; m < 4; ++m)
#pragma unroll
                    for (int n = 0; n < 2; ++n) acc[a][b][m][n] = (f32x4){0.f, 0.f, 0.f, 0.f};
        cur = nxt; cA = nA; cB = nB; ++ui;
        if constexpr (ALIGN_EPI) { if (wr == 1) PG8_BAR; }
    }
    PG8_WAIT_V(0);
    if constexpr (!ALIGN_EPI) { if (wr == 0) PG8_BAR; }
    PG8_BAR;
    if constexpr (Epi::AFTER_DRAIN) { E.fused(acc, cur, wr, wc, fr, fq, lds, wid, lane); S.done(cur); }
#undef PG8_SA
#undef PG8_SB
#undef PG8_STAGE
#undef PG8_LDA
#undef PG8_LDB
#undef PG8_MMA
#undef PG8_WAIT_V
#undef PG8_WAIT_L
#undef PG8_BAR
#undef PG8_SCHED
}
}
#define GAS __attribute__((address_space(1)))
#define LAS __attribute__((address_space(3)))
typedef unsigned short bf16;
typedef unsigned v4u __attribute__((ext_vector_type(4)));
typedef float f32x4 __attribute__((ext_vector_type(4)));
typedef short bf16x8 __attribute__((ext_vector_type(8)));
typedef GAS unsigned gu32;
typedef GAS unsigned long long gu64;
#define RLX_AGENT __ATOMIC_RELAXED, __HIP_MEMORY_SCOPE_AGENT
#define LDS_WAIT() asm volatile("s_waitcnt lgkmcnt(0)" ::: "memory")
#define VM_WAIT() asm volatile("s_waitcnt vmcnt(0)" ::: "memory")
__device__ __forceinline__ unsigned long long rt() { return __builtin_amdgcn_s_memrealtime(); }
__device__ __forceinline__ unsigned f2bf(float f) { unsigned u = __builtin_bit_cast(unsigned, f); return (u + 0x7fffu + ((u >> 16) & 1u)) >> 16; }
__device__ __forceinline__ unsigned pk2(float lo, float hi) { return f2bf(lo) | (f2bf(hi) << 16); }

#define XB_TMO      128
#define XB_XCNT(j)  (256  + 64 * (j))
#define XB_XSUB(j)  (1280 + 64 * (j))
#define XB_XGEN(j)  (2304 + 64 * (j))
#define XB_TOP      3328
#define XB_TOPGEN   3392
#define XCD_BAR_WORDS 3456
#define XB_SPIN_CAP (1u << 18)

__device__ __forceinline__ unsigned xb_ld(unsigned* p)              { return __hip_atomic_load(p, __ATOMIC_RELAXED, __HIP_MEMORY_SCOPE_AGENT); }
__device__ __forceinline__ unsigned xb_add(unsigned* p, unsigned v) { return __hip_atomic_fetch_add(p, v, __ATOMIC_RELAXED, __HIP_MEMORY_SCOPE_AGENT); }
__device__ __forceinline__ unsigned xb_xcc_id() { return (unsigned)__builtin_amdgcn_s_getreg((3 << 11) | 20) & 0xFu; }
#define XB_SPIN(cond, bar) do { unsigned _sp = 0; while (cond) { __builtin_amdgcn_s_sleep(1); \
    if ((++_sp & 255u) == 0u) { if (xb_ld(&(bar)[XB_TMO])) break; if (_sp > XB_SPIN_CAP) { atomicAdd(&(bar)[XB_TMO], 1u); break; } } } } while (0)

struct XcdBarrier {
    unsigned* bar; unsigned x;
    volatile LAS unsigned* st;
};

__device__ __forceinline__ XcdBarrier xcd_barrier_post(unsigned* bar, volatile LAS unsigned* st) {
    XcdBarrier b; b.bar = bar; b.x = xb_xcc_id(); b.st = st;
    if (threadIdx.x == 0) (void)xb_add(&bar[XB_XCNT(b.x)], 1u);
    return b;
}
__device__ __forceinline__ void xcd_barrier_complete(unsigned* bar, unsigned x, unsigned& nloc, unsigned& nx) {
    const unsigned G = gridDim.x * gridDim.y * gridDim.z;
    unsigned sum, cnt, mine, sp = 0u;
    for (;;) {
        sum = 0u; cnt = 0u; mine = 0u;
#pragma unroll
        for (unsigned j = 0; j < 16; ++j) { const unsigned c = xb_ld(&bar[XB_XCNT(j)]); sum += c; cnt += (c > 0u) ? 1u : 0u; mine = (j == x) ? c : mine; }
        if (sum == G) break;
        __builtin_amdgcn_s_sleep(1);
        if ((++sp & 255u) == 0u) { if (xb_ld(&bar[XB_TMO])) break; if (sp > XB_SPIN_CAP) { atomicAdd(&bar[XB_TMO], 1u); break; } }
    }
    nloc = mine > 0u ? mine : 1u; nx = cnt > 0u ? cnt : 1u;
}

__device__ __forceinline__ void xcd_barrier(const XcdBarrier& b) {
    asm volatile("s_waitcnt vmcnt(0)" ::: "memory");
    __syncthreads();
    if (threadIdx.x == 0) {
        unsigned* bar = b.bar;
        __builtin_amdgcn_s_waitcnt(0);
        unsigned nloc = b.st[0], nx = b.st[1];
        if (nloc == 0u) { xcd_barrier_complete(bar, b.x, nloc, nx); b.st[0] = nloc; b.st[1] = nx; }
        const unsigned old = xb_add(&bar[XB_XSUB(b.x)], 1u);
        const unsigned gen = old / nloc;
        if (old + 1u == (gen + 1u) * nloc) {
            __builtin_amdgcn_fence(__ATOMIC_RELEASE, "agent");
            asm volatile("s_waitcnt vmcnt(0)" ::: "memory");
            const unsigned og = xb_add(&bar[XB_TOP], 1u);
            const unsigned tg = og / nx;
            if (og + 1u == (tg + 1u) * nx) xb_add(&bar[XB_TOPGEN], 1u);
            else XB_SPIN(xb_ld(&bar[XB_TOPGEN]) == tg, bar);
            __builtin_amdgcn_fence(__ATOMIC_ACQUIRE, "agent");
            xb_add(&bar[XB_XGEN(b.x)], 1u);
            asm volatile("s_waitcnt vmcnt(0)" ::: "memory");
        } else {
            XB_SPIN(xb_ld(&bar[XB_XGEN(b.x)]) == gen, bar);
            __builtin_amdgcn_fence(__ATOMIC_ACQUIRE, "agent");
            asm volatile("s_waitcnt vmcnt(0)" ::: "memory");
        }
    }
    __syncthreads();
}

constexpr int NWAVES = 8;
constexpr int DM = 2048, NB = 2, SEQ = 16384, CTXL = 256, DEPTH = 2, DFF = 5632, NMOD = 9;
constexpr int TOKB = SEQ + CTXL;
constexpr int M_ALL = NB * TOKB;
constexpr int NPAN = M_ALL / 256;
constexpr int NGU = 2 * DFF;
constexpr int NZ = 4352;
constexpr int NW_IN = 4128;
constexpr int CHB = TOKB / 128;
constexpr int NCH = NB * CHB;
constexpr int MODW = NMOD * DM;
constexpr float EPSN = 1e-6f;
constexpr int ZQ = 0, ZK = 1024, ZV = 1280, ZGQ = 1536, ZGK = 1792, ZGV = 2048, ZGR = 2560, ZMU = 3072, ZMV = 3584, ZLR = 4096;
constexpr int MXA = 0, MXG = 1024, MXM = 1536;

constexpr size_t MiB = 1u << 20;
constexpr size_t WS_CTL = 0, CTL_ZERO_BYTES = 64 * 1024;
constexpr size_t WS_MODP = 1 * MiB;
constexpr size_t WS_MOD = 5 * MiB;
constexpr size_t WS_ROPE = 6 * MiB;
constexpr size_t WS_CTXRES = 8 * MiB;
constexpr size_t WS_W = 16 * MiB;
constexpr size_t W_GU1 = 0, W_D1 = 44 * MiB, W_GU2 = 66 * MiB, W_D2 = 110 * MiB, W_IN = 132 * MiB, W_OUT = 149 * MiB, W_LAYER = 157 * MiB;
constexpr size_t WS_RES = 330 * MiB;
constexpr size_t WS_MIX = 460 * MiB;
constexpr size_t WS_H = 590 * MiB;
constexpr size_t WS_Z = WS_H;
constexpr size_t WS_UT = WS_H + 277 * MiB;
constexpr size_t WS_ST = 948 * MiB;
constexpr size_t WS_DV = 981 * MiB;
constexpr size_t WS_QG = 982 * MiB;
constexpr size_t WS_PART = 1015 * MiB;
constexpr size_t WS_END = 1031 * MiB;
constexpr int CTX_NS = 4;
static_assert(WS_UT + (size_t)2080 * 8192 * 4 <= WS_H + (size_t)M_ALL * DFF * 2 + MiB, "UT inside the H overlay (+slack below WS_ST)");
static_assert(WS_H + (size_t)M_ALL * DFF * 2 <= WS_ST && WS_UT + (size_t)2080 * 8192 * 4 <= WS_ST, "d_ws map");
constexpr int CW_TMO = 0, CW_BAR = 4096;

constexpr int RING_OFF = 0, RING_BYTES = 139264;
constexpr int LDSCTL_OFF = RING_BYTES, MISC_OFF = LDSCTL_OFF + 320;
constexpr int LDS_BYTES = 147456;

typedef short s16x4 __attribute__((ext_vector_type(4)));
typedef float f32x16 __attribute__((ext_vector_type(16)));
typedef float f32x8 __attribute__((ext_vector_type(8)));
typedef unsigned u32x2 __attribute__((ext_vector_type(2)));
typedef unsigned u32x4 __attribute__((ext_vector_type(4)));
typedef float f32x2_t __attribute__((ext_vector_type(2)));
typedef _Float16 h16x2_t __attribute__((ext_vector_type(2)));
__device__ __forceinline__ unsigned pkh(float lo, float hi) { const _Float16 a = (_Float16)lo, b = (_Float16)hi; return (unsigned)__builtin_bit_cast(unsigned short, a) | ((unsigned)__builtin_bit_cast(unsigned short, b) << 16); }
__device__ __forceinline__ float hlo(unsigned w) { return (float)__builtin_bit_cast(h16x2_t, w)[0]; }
__device__ __forceinline__ float hhi(unsigned w) { return (float)__builtin_bit_cast(h16x2_t, w)[1]; }
__device__ __forceinline__ float bf2f(unsigned short x) { return __uint_as_float((unsigned)x << 16); }
__device__ __forceinline__ float bflo(unsigned w) { return __uint_as_float(w << 16); }
__device__ __forceinline__ float bfhi(unsigned w) { return __uint_as_float(w & 0xffff0000u); }
typedef __bf16 bf16x2_t __attribute__((ext_vector_type(2)));
__device__ __forceinline__ unsigned cvtpk(float lo, float hi) { f32x2_t v = {lo, hi}; bf16x2_t b = __builtin_convertvector(v, bf16x2_t); return __builtin_bit_cast(unsigned, b); }
__device__ __forceinline__ float wave_sum(float v) {
#pragma unroll
    for (int o = 1; o < 64; o <<= 1) v += __shfl_xor(v, o);
    return v;
}
__device__ __forceinline__ int crow(int r, int hi) { return (r & 3) + 8 * (r >> 2) + 4 * hi; }
__device__ __forceinline__ float silu_acc(float x) { return x / (1.0f + __expf(-x)); }

struct Frame {
    LAS unsigned char* lds;
    volatile LAS unsigned* MISC;
    gu32* ctl;
    int tid, lane, wave, vcu, G;
};

__device__ __forceinline__ void p0_transpose_item(const float* W, int K, int N, bf16* WT, int k0, int n0, int orow0, LAS float* scr, int lane) {
#pragma unroll 8
    for (int i = 0; i < 32; ++i) { const int kk = 2 * i + (lane >> 5); scr[kk * 33 + (lane & 31)] = W[(size_t)(k0 + kk) * N + n0 + (lane & 31)]; }
    LDS_WAIT(); asm volatile("" ::: "memory");
    const int c = lane & 7;
#pragma unroll
    for (int j = 0; j < 4; ++j) { const int n = (lane >> 3) + 8 * j; const LAS float* s = scr + (8 * c) * 33 + n;
        v4u o; o.x = pk2(s[0 * 33], s[1 * 33]); o.y = pk2(s[2 * 33], s[3 * 33]); o.z = pk2(s[4 * 33], s[5 * 33]); o.w = pk2(s[6 * 33], s[7 * 33]);
        *(GAS v4u*)(WT + (size_t)(orow0 + n) * K + k0 + 8 * c) = o; }
    LDS_WAIT(); asm volatile("" ::: "memory");
}
__device__ __forceinline__ int gu_row(int n0) { return n0 < DFF ? (n0 / 128) * 256 + (n0 % 128) : ((n0 - DFF) / 128) * 256 + 128 + ((n0 - DFF) % 128); }
__device__ __forceinline__ int win_row(int n0) { return n0 < 3072 ? n0 : (n0 < 3104 ? ZLR + (n0 - 3072) : (n0 < 3616 ? ZMU + (n0 - 3104) : ZMV + (n0 - 3616))); }

struct Args { const float* in[21]; float* out; unsigned char* ws; int ph_lo, ph_hi; };

__device__ __forceinline__ void p0_prologue(Frame& F, const Args& a) {
    LAS float* scr = (LAS float*)(F.lds + RING_OFF + F.wave * 16384);
    const int gw = F.vcu * NWAVES + F.wave, NGW = F.G * NWAVES, lane = F.lane;
    unsigned char* ws = a.ws;
    constexpr int I_GU = (DM / 64) * (NGU / 32), I_D = (DFF / 64) * (DM / 32), I_IN = (DM / 64) * (NW_IN / 32), I_OUT = (DM / 64) * (DM / 32);
    constexpr int I_LAYER = 2 * I_GU + 2 * I_D + I_IN + I_OUT;
    for (int it = gw; it < DEPTH * I_LAYER; it += NGW) {
        const int l = it / I_LAYER; int r = it - l * I_LAYER;
        unsigned char* wl = ws + WS_W + (size_t)l * W_LAYER;
        if (r < 2 * I_GU) { const int f = r / I_GU; r -= f * I_GU; const int nblk = NGU / 32, kb = r / nblk, nb = r % nblk;
            p0_transpose_item(a.in[f ? 9 : 7] + (size_t)l * DM * NGU, DM, NGU, (bf16*)(wl + (f ? W_GU2 : W_GU1)), 64 * kb, 32 * nb, gu_row(32 * nb), scr, lane); continue; }
        r -= 2 * I_GU;
        if (r < 2 * I_D) { const int f = r / I_D; r -= f * I_D; const int nblk = DM / 32, kb = r / nblk, nb = r % nblk;
            p0_transpose_item(a.in[f ? 10 : 8] + (size_t)l * DFF * DM, DFF, DM, (bf16*)(wl + (f ? W_D2 : W_D1)), 64 * kb, 32 * nb, 32 * nb, scr, lane); continue; }
        r -= 2 * I_D;
        if (r < I_IN) { const int nblk = NW_IN / 32, kb = r / nblk, nb = r % nblk;
            p0_transpose_item(a.in[11] + (size_t)l * DM * NW_IN, DM, NW_IN, (bf16*)(wl + W_IN), 64 * kb, 32 * nb, win_row(32 * nb), scr, lane); continue; }
        r -= I_IN;
        { const int nblk = DM / 32, kb = r / nblk, nb = r % nblk;
            p0_transpose_item(a.in[12] + (size_t)l * DM * DM, DM, DM, (bf16*)(wl + W_OUT), 64 * kb, 32 * nb, 32 * nb, scr, lane); }
    }
    {
        const int per_layer = (NZ - NW_IN) * DM / 8;
        for (int i = gw * 64 + lane; i < DEPTH * per_layer; i += NGW * 64) { const int l = i / per_layer, r = i - l * per_layer;
            *(GAS v4u*)(ws + WS_W + (size_t)l * W_LAYER + W_IN + (size_t)NW_IN * DM * 2 + (size_t)r * 16) = (v4u){0u, 0u, 0u, 0u}; }
    }
    {
        const float* c = a.in[1]; const float* cctx = a.in[3]; const float* mw = a.in[4];
        float* modp = (float*)(ws + WS_MODP);
        LAS float* sv = scr;
        for (int it = gw; it < DEPTH * 8 * 72; it += NGW) {
            const int l = it / (8 * 72), r = it % (8 * 72), ks = r / 72, nb = r % 72, k0 = ks * 256, n = nb * 256 + lane * 4;
#pragma unroll
            for (int j = 0; j < 4; ++j) { const int k = k0 + lane + 64 * j;
                sv[0 * 256 + lane + 64 * j] = silu_acc(c[k]); sv[1 * 256 + lane + 64 * j] = silu_acc(c[DM + k]); sv[2 * 256 + lane + 64 * j] = silu_acc(cctx[k]); }
            LDS_WAIT(); asm volatile("" ::: "memory");
            f32x4 a0 = {0.f, 0.f, 0.f, 0.f}, a1 = a0, a2 = a0;
            const float* wp = mw + ((size_t)l * DM + k0) * MODW + n;
#pragma unroll 8
            for (int k = 0; k < 256; ++k) { const f32x4 w = *(const f32x4*)(wp + (size_t)k * MODW); a0 += w * sv[k]; a1 += w * sv[256 + k]; a2 += w * sv[512 + k]; }
            float* op = modp + ((size_t)(l * 8 + ks) * 3) * MODW + n;
            *(f32x4*)(op) = a0; *(f32x4*)(op + MODW) = a1; *(f32x4*)(op + 2 * MODW) = a2;
            LDS_WAIT(); asm volatile("" ::: "memory");
        }
    }
    {
        float* rc = (float*)(ws + WS_ROPE); float* rs = rc + 256 * 32;
        for (int i = gw * 64 + lane; i < 256 * 32; i += NGW * 64) { const int p = i >> 5, f = i & 31;
            const double inv = pow(10000.0, -(double)f / 32.0); const double ang = (double)p * inv;
            rc[i] = (float)cos(ang); rs[i] = (float)sin(ang); }
    }
}
__device__ __forceinline__ void p1_modreduce(Frame& F, const Args& a) {
    const float* modp = (const float*)(a.ws + WS_MODP); float* mod = (float*)(a.ws + WS_MOD); const float* mb = a.in[5];
    for (int i = F.vcu * 512 + F.tid; i < DEPTH * 3 * MODW; i += F.G * 512) { const int l = i / (3 * MODW), r = i % (3 * MODW), set = r / MODW, n = r % MODW;
        float s = mb[l * MODW + n];
#pragma unroll
        for (int ks = 0; ks < 8; ++ks) s += modp[((size_t)(l * 8 + ks) * 3 + set) * MODW + n];
        mod[i] = s; }
}

struct NRow { u32x4 h[4]; f32x4 f[8]; const float* fsrc; bool isf; };
template <bool LAZYF>
__device__ __forceinline__ void norm_load(NRow& r, const float* src_lat, const float* src_ctx, const bf16* RES, int row, int lane) {
    const int b = row / TOKB, j = row - b * TOKB; const bool isctx = j < CTXL;
    const float* src = isctx ? (src_ctx ? src_ctx + ((size_t)b * CTXL + j) * DM : (const float*)nullptr) : (src_lat ? src_lat + ((size_t)b * SEQ + (j - CTXL)) * DM : (const float*)nullptr);
    r.isf = src != nullptr; r.fsrc = src;
    if (src) { if constexpr (!LAZYF) {
#pragma unroll
        for (int q = 0; q < 4; ++q) { r.f[2 * q] = *(const GAS f32x4*)(src + (q * 64 + lane) * 8); r.f[2 * q + 1] = *(const GAS f32x4*)(src + (q * 64 + lane) * 8 + 4); } } }
    else {
#pragma unroll
        for (int q = 0; q < 4; ++q) r.h[q] = __builtin_nontemporal_load((const GAS u32x4*)(RES + (size_t)row * DM + (q * 64 + lane) * 8)); }
}
template <bool LAZYF = false>
__device__ __forceinline__ void norm_phase(Frame& F, const float* src_lat, const float* src_ctx, bf16* RES, const float* g, const float* mod  , int sub, bf16* XN, int skip_ctx, const float* part) {
    const int gw = F.vcu * NWAVES + F.wave, NGW = F.G * NWAVES, lane = F.lane;
    int cur = -1; f32x4 A[8], B[8]; NRow rc, rn;
    int row = gw;
    if (skip_ctx) while (row < M_ALL && (row % TOKB) < CTXL) row += NGW;
    if (row < M_ALL) norm_load<LAZYF>(rc, src_lat, src_ctx, RES, row, lane);
    while (row < M_ALL) {
        int nrow = row + NGW;
        if (skip_ctx) while (nrow < M_ALL && (nrow % TOKB) < CTXL) nrow += NGW;
        if (nrow < M_ALL) norm_load<LAZYF>(rn, src_lat, src_ctx, RES, nrow, lane);
        const int b = row / TOKB, j = row - b * TOKB; const bool isctx = j < CTXL;
        const int set = isctx ? 2 : b;
        if (set != cur) { cur = set; const float* sh = mod + (size_t)(set * 9 + 3 * sub) * DM; const float* sc = sh + DM;
#pragma unroll
            for (int q = 0; q < 8; ++q) { const int c = ((q >> 1) * 64 + lane) * 8 + (q & 1) * 4; const f32x4 gg = *(const f32x4*)(g + c), ss = *(const f32x4*)(sc + c); A[q] = gg * (ss + 1.0f); B[q] = *(const f32x4*)(sh + c); } }
        f32x4 v[8];
        if (rc.isf) {
            if constexpr (LAZYF) {
#pragma unroll
                for (int q = 0; q < 4; ++q) { v[2 * q] = *(const GAS f32x4*)(rc.fsrc + (q * 64 + lane) * 8); v[2 * q + 1] = *(const GAS f32x4*)(rc.fsrc + (q * 64 + lane) * 8 + 4); }
            } else {
#pragma unroll
            for (int q = 0; q < 8; ++q) v[q] = rc.f[q]; }
        } else {
#pragma unroll
            for (int q = 0; q < 4; ++q) { const u32x4 w = rc.h[q]; v[2 * q] = (f32x4){hlo(w.x), hhi(w.x), hlo(w.y), hhi(w.y)}; v[2 * q + 1] = (f32x4){hlo(w.z), hhi(w.z), hlo(w.w), hhi(w.w)}; }
        }
        if (isctx && part) { const size_t ro = ((size_t)b * CTXL + j) * DM;
#pragma unroll
            for (int ks = 0; ks < CTX_NS; ++ks)
#pragma unroll
                for (int q = 0; q < 8; ++q) v[q] += *(const GAS f32x4*)(part + (size_t)ks * 512 * DM + ro + ((q >> 1) * 64 + lane) * 8 + (q & 1) * 4);
#pragma unroll
            for (int q = 0; q < 4; ++q) { u32x4 w; w.x = pkh(v[2 * q].x, v[2 * q].y); w.y = pkh(v[2 * q].z, v[2 * q].w); w.z = pkh(v[2 * q + 1].x, v[2 * q + 1].y); w.w = pkh(v[2 * q + 1].z, v[2 * q + 1].w);
                *(GAS u32x4*)(RES + (size_t)row * DM + (q * 64 + lane) * 8) = w;
                v[2 * q] = (f32x4){hlo(w.x), hhi(w.x), hlo(w.y), hhi(w.y)}; v[2 * q + 1] = (f32x4){hlo(w.z), hhi(w.z), hlo(w.w), hhi(w.w)}; } }
        float s = 0.f;
#pragma unroll
        for (int q = 0; q < 8; ++q) s += (v[q].x * v[q].x + v[q].y * v[q].y) + (v[q].z * v[q].z + v[q].w * v[q].w);
        const float rstd = 1.0f / sqrtf(wave_sum(s) * (1.0f / DM) + EPSN);
        bf16* orow = XN + (size_t)row * DM;
#pragma unroll
        for (int q = 0; q < 4; ++q) { const f32x4 o0 = v[2 * q] * rstd * A[2 * q] + B[2 * q], o1 = v[2 * q + 1] * rstd * A[2 * q + 1] + B[2 * q + 1];
            u32x4 w; w.x = cvtpk(o0.x, o0.y); w.y = cvtpk(o0.z, o0.w); w.z = cvtpk(o1.x, o1.y); w.w = cvtpk(o1.z, o1.w); *(GAS u32x4*)(orow + (q * 64 + lane) * 8) = w; }
        rc = rn; row = nrow;
    }
}
__device__ __forceinline__ void final_norm_phase(Frame& F, const bf16* RES, float* out, const float* g) {
    const int gw = F.vcu * NWAVES + F.wave, NGW = F.G * NWAVES, lane = F.lane;
    f32x4 A[8];
#pragma unroll
    for (int q = 0; q < 8; ++q) A[q] = *(const f32x4*)(g + ((q >> 1) * 64 + lane) * 8 + (q & 1) * 4);
    u32x4 hc[4], hn[4];
#define FN_LOAD(H, R) do { const int b_ = (R) / SEQ, t_ = (R) - b_ * SEQ; const bf16* s_ = RES + ((size_t)b_ * TOKB + CTXL + t_) * DM; \
        _Pragma("unroll") for (int q = 0; q < 4; ++q) H[q] = __builtin_nontemporal_load((const GAS u32x4*)(s_ + (q * 64 + lane) * 8)); } while (0)
    int row = gw;
    if (row < NB * SEQ) FN_LOAD(hc, row);
    while (row < NB * SEQ) {
        const int nrow = row + NGW;
        if (nrow < NB * SEQ) FN_LOAD(hn, nrow);
        f32x4 v[8]; float s = 0.f;
#pragma unroll
        for (int q = 0; q < 4; ++q) { const u32x4 w = hc[q]; v[2 * q] = (f32x4){hlo(w.x), hhi(w.x), hlo(w.y), hhi(w.y)}; v[2 * q + 1] = (f32x4){hlo(w.z), hhi(w.z), hlo(w.w), hhi(w.w)}; }
#pragma unroll
        for (int q = 0; q < 8; ++q) s += (v[q].x * v[q].x + v[q].y * v[q].y) + (v[q].z * v[q].z + v[q].w * v[q].w);
        const float rstd = 1.0f / sqrtf(wave_sum(s) * (1.0f / DM) + EPSN);
        float* p = out + (size_t)row * DM;
#pragma unroll
        for (int q = 0; q < 4; ++q) { *(GAS f32x4*)(p + (q * 64 + lane) * 8) = v[2 * q] * rstd * A[2 * q]; *(GAS f32x4*)(p + (q * 64 + lane) * 8 + 4) = v[2 * q + 1] * rstd * A[2 * q + 1]; }
#pragma unroll
        for (int q = 0; q < 4; ++q) hc[q] = hn[q];
        row = nrow;
    }
#undef FN_LOAD
}

typedef short v4i16_t __attribute__((ext_vector_type(4)));
__device__ __forceinline__ s16x4 vtr(LAS const unsigned char* p) { return __builtin_bit_cast(s16x4, __builtin_amdgcn_ds_read_tr16_b64_v4i16((LAS v4i16_t*)p)); }
template <int KSTEPS>
__device__ __forceinline__ void mm32_tr(f32x16& acc, LAS const unsigned char* At, int sa, int m0, LAS const unsigned char* Bn, int sb, int n0, int lane) {
    const int h = lane >> 5, blk = (lane >> 4) & 1, q = (lane & 15) >> 2, p = lane & 3, r = lane & 31;
    LAS const unsigned char* ap = At + (8 * h + q) * sa + (m0 + 16 * blk + 4 * p) * 2;
    LAS const unsigned char* bp = Bn + (n0 + r) * sb + 16 * h;
#pragma unroll
    for (int ks = 0; ks < KSTEPS; ++ks) {
        const s16x4 lo = vtr(ap + (16 * ks) * sa), hi4 = vtr(ap + (16 * ks + 4) * sa);
        const bf16x8 af = (bf16x8){lo[0], lo[1], lo[2], lo[3], hi4[0], hi4[1], hi4[2], hi4[3]};
        const bf16x8 bfv = *(LAS const bf16x8*)(bp + 32 * ks);
        acc = __builtin_amdgcn_mfma_f32_32x32x16_bf16(af, bfv, acc, 0, 0, 0);
    }
}
template <int KSTEPS>
__device__ __forceinline__ void mm32_rr(f32x16& acc, LAS const unsigned char* Am, int sa, int m0, LAS const unsigned char* Bn, int sb, int n0, int lane) {
    const int h = lane >> 5, r = lane & 31;
    LAS const unsigned char* ap = Am + (m0 + r) * sa + 16 * h;
    LAS const unsigned char* bp = Bn + (n0 + r) * sb + 16 * h;
#pragma unroll
    for (int ks = 0; ks < KSTEPS; ++ks) {
        const bf16x8 af = *(LAS const bf16x8*)(ap + 32 * ks);
        const bf16x8 bfv = *(LAS const bf16x8*)(bp + 32 * ks);
        acc = __builtin_amdgcn_mfma_f32_32x32x16_bf16(af, bfv, acc, 0, 0, 0);
    }
}

__device__ __forceinline__ void qknorm_row(bf16* Z, int row, const float* qkg  , const float* rc, const float* rs, int lane) {
    const int b = row / TOKB, j = row - b * TOKB; const bool isctx = j < CTXL; const int t = j - CTXL, prow = t >> 6, pcol = t & 63;
    bf16* zr = Z + (size_t)row * NZ;
    v4u wv[3];
#pragma unroll
    for (int pass = 0; pass < 3; ++pass) { const int ch = lane + 64 * pass; wv[pass] = (v4u){0u, 0u, 0u, 0u}; if (ch < 160) wv[pass] = *(const GAS v4u*)(zr + ch * 8); }
    const int j16 = lane & 15; const int pos = isctx ? 0 : ((j16 & 8) ? pcol : prow); const int f0 = 8 * (j16 & 3);
    const f32x4 c0 = *(const f32x4*)(rc + pos * 32 + f0), c1 = *(const f32x4*)(rc + pos * 32 + f0 + 4), s0 = *(const f32x4*)(rs + pos * 32 + f0), s1 = *(const f32x4*)(rs + pos * 32 + f0 + 4);
    const float cs[8] = {c0.x, c0.y, c0.z, c0.w, c1.x, c1.y, c1.z, c1.w}, sn[8] = {s0.x, s0.y, s0.z, s0.w, s1.x, s1.y, s1.z, s1.w};
    const bool second = (j16 & 4) != 0;
#pragma unroll
    for (int pass = 0; pass < 3; ++pass) {
        const int ch = lane + 64 * pass; const bool act = ch < 160;
        const int head = ch >> 4;
        const v4u w = wv[pass];
        float y[8] = {bflo(w.x), bfhi(w.x), bflo(w.y), bfhi(w.y), bflo(w.z), bfhi(w.z), bflo(w.w), bfhi(w.w)};
        float ss = 0.f;
#pragma unroll
        for (int e = 0; e < 8; ++e) ss += y[e] * y[e];
        ss += __shfl_xor(ss, 1); ss += __shfl_xor(ss, 2); ss += __shfl_xor(ss, 4); ss += __shfl_xor(ss, 8);
        const float rstd = 1.0f / sqrtf(ss * (1.0f / 128.0f) + EPSN);
        const float* gp = qkg + (head < 8 ? 0 : 128) + j16 * 8;
        const f32x4 g0 = *(const f32x4*)gp, g1 = *(const f32x4*)(gp + 4);
        const float gg[8] = {g0.x, g0.y, g0.z, g0.w, g1.x, g1.y, g1.z, g1.w};
#pragma unroll
        for (int e = 0; e < 8; ++e) y[e] = y[e] * rstd * gg[e];
        float pr[8];
#pragma unroll
        for (int e = 0; e < 8; ++e) pr[e] = __shfl_xor(y[e], 4);
        if (!isctx) {
#pragma unroll
            for (int e = 0; e < 8; ++e) y[e] = second ? (pr[e] * sn[e] + y[e] * cs[e]) : (y[e] * cs[e] - pr[e] * sn[e]);
        }
        if (head < 8) {
#pragma unroll
            for (int e = 0; e < 8; ++e) y[e] *= 0.12752455f; }
        if (act) { v4u o; o.x = cvtpk(y[0], y[1]); o.y = cvtpk(y[2], y[3]); o.z = cvtpk(y[4], y[5]); o.w = cvtpk(y[6], y[7]); *(GAS v4u*)(zr + ch * 8) = o; }
    }
}

constexpr int ST272 = 272, ST144 = 144;
__device__ __forceinline__ void gmlp_unit(Frame& F, const bf16* Z, bf16* MIX, int chunk, int grp, const float* ws_l  , const float* bs_l  , const float* gm  ) {
    int tid_ = threadIdx.x; asm volatile("" : "+v"(tid_));
    const int tid = tid_, lane = tid & 63, wave = __builtin_amdgcn_readfirstlane(tid >> 6);
    const int b = chunk / CHB, c = chunk - b * CHB, r0 = b * TOKB + c * 128;
    LAS unsigned char* VN = F.lds + RING_OFF;
    LAS unsigned char* WS = VN + 128 * ST272;
    LAS float* RS = (LAS float*)(WS + 128 * ST272);
    { const int row = tid >> 2, part = tid & 3; const bf16* p = Z + (size_t)(r0 + row) * NZ + ZMV + part * 128; float ss = 0.f;
#pragma unroll
        for (int q = 0; q < 16; ++q) { const v4u w = *(const GAS v4u*)(p + q * 8);
            const float y0 = bflo(w.x), y1 = bfhi(w.x), y2 = bflo(w.y), y3 = bfhi(w.y), y4 = bflo(w.z), y5 = bfhi(w.z), y6 = bflo(w.w), y7 = bfhi(w.w);
            ss += (y0 * y0 + y1 * y1) + (y2 * y2 + y3 * y3) + (y4 * y4 + y5 * y5) + (y6 * y6 + y7 * y7); }
        ss += __shfl_xor(ss, 1); ss += __shfl_xor(ss, 2);
        if (part == 0) RS[row] = 1.0f / sqrtf(ss * (1.0f / 512.0f) + EPSN); }
#pragma unroll
    for (int q = 0; q < 8; ++q) { const int idx = tid + 512 * q, i = idx >> 5, j4 = (idx & 31) * 4; const f32x4 w = *(const f32x4*)(ws_l + (size_t)grp * 16384 + i * 128 + j4);
        u32x2 o; o.x = cvtpk(w.x, w.y); o.y = cvtpk(w.z, w.w); *(LAS u32x2*)(WS + i * ST272 + j4 * 2) = o; }
    __syncthreads();
#pragma unroll
    for (int q = 0; q < 4; ++q) { const int idx = tid + 512 * q, jrow = idx >> 4, c8 = (idx & 15) * 8; const v4u w = *(const GAS v4u*)(Z + (size_t)(r0 + jrow) * NZ + ZMV + grp * 128 + c8);
        const float rstd = RS[jrow]; const float* gp = gm + grp * 128 + c8;
        v4u o; o.x = cvtpk(bflo(w.x) * rstd * gp[0], bfhi(w.x) * rstd * gp[1]); o.y = cvtpk(bflo(w.y) * rstd * gp[2], bfhi(w.y) * rstd * gp[3]);
        o.z = cvtpk(bflo(w.z) * rstd * gp[4], bfhi(w.z) * rstd * gp[5]); o.w = cvtpk(bflo(w.w) * rstd * gp[6], bfhi(w.w) * rstd * gp[7]);
        *(LAS v4u*)(VN + jrow * ST272 + c8 * 2) = o; }
    __syncthreads();
    const int it = wave & 3, ct0 = (wave >> 2) * 2, hi = lane >> 5, i = it * 32 + (lane & 31);
    const float bias = bs_l[grp * 128 + i];
#pragma unroll
    for (int cc = 0; cc < 2; ++cc) { const int ct = ct0 + cc; f32x16 acc = {};
        mm32_tr<8>(acc, VN, ST272, ct * 32, WS, ST272, it * 32, lane);
        const bf16* mup = Z + (size_t)(r0 + i) * NZ + ZMU + grp * 128 + ct * 32 + 4 * hi; bf16* op = MIX + (size_t)(r0 + i) * DM + MXM + grp * 128 + ct * 32 + 4 * hi;
#pragma unroll
        for (int rg = 0; rg < 4; ++rg) { const u32x2 mu = *(const GAS u32x2*)(mup + 8 * rg);
            u32x2 o; o.x = cvtpk(bflo(mu.x) * (acc[4 * rg + 0] + bias), bfhi(mu.x) * (acc[4 * rg + 1] + bias)); o.y = cvtpk(bflo(mu.y) * (acc[4 * rg + 2] + bias), bfhi(mu.y) * (acc[4 * rg + 3] + bias));
            *(GAS u32x2*)(op + 8 * rg) = o; } }
    __syncthreads();
}

__device__ __forceinline__ float log_sigmoid_f(float x) { const float t = __builtin_amdgcn_exp2f(fabsf(x) * -1.4426950408889634f); return fminf(x, 0.f) - 0.6931471805599453f * __builtin_amdgcn_logf(1.0f + t); }
__device__ __forceinline__ void gla_a_unit(Frame& F, bf16* Z, bf16* QG, float* UT, float* DV, int chunk, int hd, const float* gw_l  , const float* gb_l  ) {
    int tid_ = threadIdx.x; asm volatile("" : "+v"(tid_));
    const int tid = tid_, lane = tid & 63, wave = __builtin_amdgcn_readfirstlane(tid >> 6);
    const int b = chunk / CHB, c = chunk - b * CHB, r0 = b * TOKB + c * 128;
    LAS unsigned char* QT = F.lds + RING_OFF;
    LAS unsigned char* KT = QT + 128 * ST144;
    LAS unsigned char* KTT = KT + 128 * ST144;
    LAS unsigned char* VV = KTT + 64 * ST272;
    LAS unsigned char* ATT = VV + 128 * ST272;
    LAS unsigned char* QRAW = ATT; LAS unsigned char* KRAW = ATT + 16384;
    LAS float* SEG = (LAS float*)(ATT + 128 * ST272);
    LAS unsigned char* LR = (LAS unsigned char*)(SEG + 512);
#pragma unroll
    for (int q = 0; q < 4; ++q) { const int idx = tid + 512 * q, jrow = idx >> 4, c8 = (idx & 15) * 8;
        *(LAS v4u*)(VV + jrow * ST272 + c8 * 2) = *(const GAS v4u*)(Z + (size_t)(r0 + jrow) * NZ + ZGV + hd * 128 + c8); }
#pragma unroll
    for (int q = 0; q < 2; ++q) { const int idx = tid + 512 * q, jrow = idx >> 3, c8 = (idx & 7) * 8;
        *(LAS v4u*)(QRAW + jrow * 128 + c8 * 2) = *(const GAS v4u*)(Z + (size_t)(r0 + jrow) * NZ + ZGQ + hd * 64 + c8);
        *(LAS v4u*)(KRAW + jrow * 128 + c8 * 2) = *(const GAS v4u*)(Z + (size_t)(r0 + jrow) * NZ + ZGK + hd * 64 + c8); }
    { const int jrow = tid >> 2, c8 = (tid & 3) * 8; *(LAS v4u*)(LR + jrow * 64 + c8 * 2) = *(const GAS v4u*)(Z + (size_t)(r0 + jrow) * NZ + ZLR + c8); }
    __syncthreads();
    const int d = lane, jb = wave;
    f32x16 att0 = {}, att1 = {};
    const int jt = wave & 3, it0 = (wave >> 2) * 2, hi = lane >> 5, r32 = lane & 31;
#pragma unroll
    for (int dir = 0; dir < 2; ++dir) {
        float cs[16];
        { float wv[16];
#pragma unroll
          for (int r = 0; r < 16; ++r) wv[r] = gw_l[(dir * 16 + r) * 256 + hd * 64 + d];
          const float gbias = gb_l[dir * 256 + hd * 64 + d];
#pragma unroll
          for (int i = 0; i < 16; ++i) { LAS const unsigned char* lr = LR + (jb * 16 + i) * 64 + dir * 32;
            const v4u w0 = *(LAS const v4u*)(lr), w1 = *(LAS const v4u*)(lr + 16);
            float lg = gbias;
            lg += bflo(w0.x) * wv[0] + bfhi(w0.x) * wv[1] + bflo(w0.y) * wv[2] + bfhi(w0.y) * wv[3] + bflo(w0.z) * wv[4] + bfhi(w0.z) * wv[5] + bflo(w0.w) * wv[6] + bfhi(w0.w) * wv[7];
            lg += bflo(w1.x) * wv[8] + bfhi(w1.x) * wv[9] + bflo(w1.y) * wv[10] + bfhi(w1.y) * wv[11] + bflo(w1.z) * wv[12] + bfhi(w1.z) * wv[13] + bflo(w1.w) * wv[14] + bfhi(w1.w) * wv[15];
            cs[i] = log_sigmoid_f(lg) * (1.0f / 16.0f); } }
        if (dir == 0) {
#pragma unroll
            for (int i = 1; i < 16; ++i) cs[i] += cs[i - 1];
            SEG[jb * 64 + d] = cs[15];
        } else {
#pragma unroll
            for (int i = 14; i >= 0; --i) cs[i] += cs[i + 1];
            SEG[jb * 64 + d] = cs[0];
        }
        __syncthreads();
        float offs = 0.f;
#pragma unroll
        for (int s = 0; s < 8; ++s) { const float sv = SEG[s * 64 + d]; if (dir == 0 ? (s < jb) : (s > jb)) offs += sv; }
#pragma unroll
        for (int i = 0; i < 16; ++i) { const int j = jb * 16 + i; const float cc = cs[i] + offs;
            const float qraw = bf2f(*(LAS const unsigned short*)(QRAW + j * 128 + d * 2)) * 0.125f, kraw = bf2f(*(LAS const unsigned short*)(KRAW + j * 128 + d * 2));
            const float qt = qraw * __expf(cc), kt = kraw * __expf(-cc);
            const unsigned short qb = (unsigned short)(cvtpk(qt, 0.f) & 0xffffu), kb = (unsigned short)(cvtpk(kt, 0.f) & 0xffffu);
            *(LAS unsigned short*)(QT + j * ST144 + d * 2) = qb; *(LAS unsigned short*)(KT + j * ST144 + d * 2) = kb; *(LAS unsigned short*)(KTT + d * ST272 + j * 2) = kb; }
        __syncthreads();
#pragma unroll
        for (int q = 0; q < 2; ++q) { const int idx = tid + 512 * q, jrow = idx >> 3, c8 = (idx & 7) * 8;
            *(GAS v4u*)(QG + (size_t)(r0 + jrow) * 512 + dir * 256 + hd * 64 + c8) = *(LAS const v4u*)(QT + jrow * ST144 + c8 * 2); }
#pragma unroll
        for (int cc = 0; cc < 2; ++cc) { f32x16 acc = {};
            mm32_rr<4>(acc, KT, ST144, jt * 32, QT, ST144, (it0 + cc) * 32, lane);
            const int ii = (it0 + cc) * 32 + r32;
#pragma unroll
            for (int r = 0; r < 16; ++r) { const int jj = jt * 32 + crow(r, hi); const int df = dir == 0 ? (ii - jj) : (jj - ii);
                const float v = __uint_as_float(__float_as_uint(acc[r]) & ~(unsigned)(df >> 31)); if (cc == 0) att0[r] += v; else att1[r] += v; } }
        { const int et = wave & 3, dt = wave >> 2; f32x16 acc = {};
            mm32_tr<8>(acc, VV, ST272, et * 32, KTT, ST272, dt * 32, lane);
            const int dd = dt * 32 + r32; float tot = 0.f;
#pragma unroll
            for (int s = 0; s < 8; ++s) tot += SEG[s * 64 + dd];
            const float ex = __expf(tot);
            const size_t cidx = ((size_t)(b * CHB + c) * 4 + hd) * 2 + dir;
            float* up = UT + cidx * 8192 + dd;
#pragma unroll
            for (int r = 0; r < 16; ++r) up[(et * 32 + crow(r, hi)) * 64] = acc[r] * ex;
            if (et == 0 && hi == 0) DV[cidx * 64 + dd] = ex; }
        __syncthreads();
    }
#pragma unroll
    for (int cc = 0; cc < 2; ++cc) { const int ii = (it0 + cc) * 32 + r32;
#pragma unroll
        for (int rg = 0; rg < 4; ++rg) { u32x2 o;
            if (cc == 0) { o.x = cvtpk(att0[4 * rg], att0[4 * rg + 1]); o.y = cvtpk(att0[4 * rg + 2], att0[4 * rg + 3]); } else { o.x = cvtpk(att1[4 * rg], att1[4 * rg + 1]); o.y = cvtpk(att1[4 * rg + 2], att1[4 * rg + 3]); }
            *(LAS u32x2*)(ATT + ii * ST272 + (jt * 32 + 8 * rg + 4 * hi) * 2) = o; } }
    __syncthreads();
    { const int itile = wave & 3, et0 = (wave >> 2) * 2; const int ii = itile * 32 + r32;
#pragma unroll
        for (int cc = 0; cc < 2; ++cc) { const int et = et0 + cc; f32x16 acc = {};
            mm32_tr<8>(acc, VV, ST272, et * 32, ATT, ST272, itile * 32, lane);
            bf16* op = Z + (size_t)(r0 + ii) * NZ + ZGV + hd * 128 + et * 32 + 4 * hi;
#pragma unroll
            for (int rg = 0; rg < 4; ++rg) { u32x2 o; o.x = cvtpk(acc[4 * rg], acc[4 * rg + 1]); o.y = cvtpk(acc[4 * rg + 2], acc[4 * rg + 3]); *(GAS u32x2*)(op + 8 * rg) = o; } } }
    __syncthreads();
}

__device__ __forceinline__ void gla_scan_phase(Frame& F, const float* UT, const float* DV, bf16* ST) {
    for (int gt = F.vcu * 512 + F.tid; gt < 16 * 8192; gt += F.G * 512) {
        const int chain = gt >> 13, elem = gt & 8191, d = elem & 63, dir = chain & 1, hd = (chain >> 1) & 3, b = chain >> 3;
        float state = 0.f;
#pragma unroll 1
        for (int s0 = 0; s0 < CHB; s0 += 26) {
            float u[26], dv[26]; size_t ci[26];
#pragma unroll
            for (int i = 0; i < 26; ++i) { const int s = s0 + i; const int c = dir == 0 ? s : (s == 0 ? 1 : (s == 1 ? 0 : 131 - s));
                ci[i] = ((size_t)(b * CHB + c) * 4 + hd) * 2 + dir; u[i] = UT[ci[i] * 8192 + elem]; dv[i] = DV[ci[i] * 64 + d]; }
#pragma unroll
            for (int i = 0; i < 26; ++i) { ST[ci[i] * 8192 + elem] = (bf16)(cvtpk(state, 0.f) & 0xffffu); state = dv[i] * state + u[i]; }
        }
    }
}

__device__ __forceinline__ void gla_c_item(const bf16* Z, const bf16* QG, const bf16* ST, bf16* MIX, int chunk, int hd, int itile, const float* gg  , int lane) {
    const int b = chunk / CHB, c = chunk - b * CHB, r0 = b * TOKB + c * 128, r32 = lane & 31, hi = lane >> 5;
    const size_t row = (size_t)(r0 + itile * 32 + r32);
    bf16x8 bq[2][4];
#pragma unroll
    for (int dir = 0; dir < 2; ++dir)
#pragma unroll
        for (int ks = 0; ks < 4; ++ks) bq[dir][ks] = *(const GAS bf16x8*)(QG + row * 512 + dir * 256 + hd * 64 + 16 * ks + 8 * hi);
    u32x2 oi[4][4], rw[4][4];
#pragma unroll
    for (int et = 0; et < 4; ++et)
#pragma unroll
        for (int rg = 0; rg < 4; ++rg) { const int e0 = et * 32 + 8 * rg + 4 * hi;
            oi[et][rg] = *(const GAS u32x2*)(Z + row * NZ + ZGV + hd * 128 + e0); rw[et][rg] = *(const GAS u32x2*)(Z + row * NZ + ZGR + hd * 128 + e0); }
    f32x16 acc[4] = {};
#pragma unroll
    for (int dir = 0; dir < 2; ++dir) { const size_t cidx = ((size_t)(b * CHB + c) * 4 + hd) * 2 + dir; const bf16* sp = ST + cidx * 8192 + (size_t)r32 * 64 + 8 * hi;
#pragma unroll
        for (int et = 0; et < 4; ++et)
#pragma unroll
            for (int ks = 0; ks < 4; ++ks) { const bf16x8 af = *(const GAS bf16x8*)(sp + et * 32 * 64 + 16 * ks);
                acc[et] = __builtin_amdgcn_mfma_f32_32x32x16_bf16(af, bq[dir][ks], acc[et], 0, 0, 0);
            } }
    float ss = 0.f;
#pragma unroll
    for (int et = 0; et < 4; ++et)
#pragma unroll
        for (int rg = 0; rg < 4; ++rg) { const u32x2 w = oi[et][rg];
            acc[et][4 * rg + 0] += bflo(w.x); acc[et][4 * rg + 1] += bfhi(w.x); acc[et][4 * rg + 2] += bflo(w.y); acc[et][4 * rg + 3] += bfhi(w.y);
            ss += (acc[et][4 * rg] * acc[et][4 * rg] + acc[et][4 * rg + 1] * acc[et][4 * rg + 1]) + (acc[et][4 * rg + 2] * acc[et][4 * rg + 2] + acc[et][4 * rg + 3] * acc[et][4 * rg + 3]); }
    ss += __shfl_xor(ss, 32);
    const float rstd = 1.0f / sqrtf(ss * (1.0f / 128.0f) + EPSN);
#pragma unroll
    for (int et = 0; et < 4; ++et)
#pragma unroll
        for (int rg = 0; rg < 4; ++rg) { const int e0 = et * 32 + 8 * rg + 4 * hi; const u32x2 rv = rw[et][rg]; const f32x4 g4 = *(const f32x4*)(gg + hd * 128 + e0);
            const float r0v = bflo(rv.x), r1v = bfhi(rv.x), r2v = bflo(rv.y), r3v = bfhi(rv.y);
            float y0 = acc[et][4 * rg] * rstd * g4.x * silu_acc(r0v), y1 = acc[et][4 * rg + 1] * rstd * g4.y * silu_acc(r1v), y2 = acc[et][4 * rg + 2] * rstd * g4.z * silu_acc(r2v), y3 = acc[et][4 * rg + 3] * rstd * g4.w * silu_acc(r3v);
            u32x2 o; o.x = cvtpk(y0, y1); o.y = cvtpk(y2, y3);
            *(GAS u32x2*)(MIX + row * DM + MXG + hd * 128 + e0) = o; }
}

namespace att {
constexpr int D = 128, NW = 8, QBLK = 32, KVBLK = 64;
constexpr float SCALE = 0.088388347648318440f;
constexpr float THR = 8.f;
constexpr int LDQ = NZ, LDK = NZ, LDO = DM;
constexpr int NBUF = 3, SHM_V = KVBLK * D * 2, SHM_K = KVBLK * D * 2, SHM_ATTN = NBUF * SHM_V + NBUF * SHM_K + NW * 64 * 4;
#define KSWZ(row, colB) ((row) * 256 + ((colB) ^ (((row) & 7) << 4)))
#define SBAR() __builtin_amdgcn_sched_barrier(0)
template <bool FAST>
__device__ __forceinline__ void partialSM(f32x16& p0, f32x16& p1, float& m_reg, float& mn, float& alpha) {
  if (FAST) { mn = m_reg; alpha = 1.f;
#pragma unroll
    for (int r = 0; r < 16; ++r) p0[r] = __builtin_amdgcn_exp2f(p0[r]);
    return; }
  float pmax = p0[0];
#pragma unroll
  for (int r = 1; r < 16; ++r) pmax = fmaxf(pmax, p0[r]);
#pragma unroll
  for (int r = 0; r < 16; ++r) pmax = fmaxf(pmax, p1[r]);
  { auto rr = __builtin_amdgcn_permlane32_swap(__float_as_uint(pmax), __float_as_uint(pmax), false, false);
    pmax = fmaxf(__uint_as_float(rr[0]), __uint_as_float(rr[1])); }
  float C = 1.0f; asm volatile("" : "+v"(C));
  if (__builtin_expect(__all(pmax - m_reg <= THR * 1.4426950408889634f), 1)) { mn = m_reg; alpha = 1.f; }
  else { mn = fmaxf(m_reg, pmax); alpha = __builtin_amdgcn_exp2f((m_reg - mn) * C); m_reg = mn; }
  float mnC = -mn * C;
#pragma unroll
  for (int r = 0; r < 16; ++r) p0[r] = fmaf(p0[r], C, mnC);
#pragma unroll
  for (int r = 0; r < 16; ++r) p1[r] = fmaf(p1[r], C, mnC);
#pragma unroll
  for (int r = 0; r < 16; ++r) p0[r] = __builtin_amdgcn_exp2f(p0[r]);
}
__device__ __forceinline__ void finishSM(f32x16& p0, f32x16& p1, float alpha, float& l_reg, bf16x8& pa0, bf16x8& pa1, bf16x8& pa2, bf16x8& pa3) {
#pragma unroll
  for (int r = 0; r < 16; ++r) p1[r] = __builtin_amdgcn_exp2f(p1[r]);
  float ps = 0;
#pragma unroll
  for (int r = 0; r < 16; ++r) ps += p0[r];
#pragma unroll
  for (int r = 0; r < 16; ++r) ps += p1[r];
  { auto rr = __builtin_amdgcn_permlane32_swap(__float_as_uint(ps), __float_as_uint(ps), false, false);
    ps = __uint_as_float(rr[0]) + __uint_as_float(rr[1]); }
  l_reg = l_reg * alpha + ps;
#define PK4(P, BASE, OUT) do { unsigned a0 = cvtpk(P[BASE + 0], P[BASE + 1]), a1 = cvtpk(P[BASE + 2], P[BASE + 3]);   \
    unsigned b0 = cvtpk(P[BASE + 4], P[BASE + 5]), b1 = cvtpk(P[BASE + 6], P[BASE + 7]);                              \
    auto r0 = __builtin_amdgcn_permlane32_swap(a0, b0, false, false); auto r1 = __builtin_amdgcn_permlane32_swap(a1, b1, false, false); \
    v4u w = {r0[0], r1[0], r0[1], r1[1]}; OUT = __builtin_bit_cast(bf16x8, w); } while (0)
  PK4(p0, 0, pa0); PK4(p0, 8, pa1); PK4(p1, 0, pa2); PK4(p1, 8, pa3);
#undef PK4
}
__device__ __forceinline__ void qkt(f32x16& p0, f32x16& p1, LAS const unsigned char* Ks, const bf16x8* qr, int r32, int hi) {
  p0 = f32x16{}; p1 = f32x16{};
#pragma unroll
  for (int d0 = 0; d0 < 8; ++d0) { int cb = (d0 * 16 + hi * 8) * 2;
    bf16x8 b0 = *(LAS const bf16x8*)(Ks + KSWZ(r32, cb));
    bf16x8 b1 = *(LAS const bf16x8*)(Ks + KSWZ(32 + r32, cb));
    p0 = __builtin_amdgcn_mfma_f32_32x32x16_bf16(b0, qr[d0], p0, 0, 0, 0);
    p1 = __builtin_amdgcn_mfma_f32_32x32x16_bf16(b1, qr[d0], p1, 0, 0, 0); }
}
__device__ __forceinline__ int v_st(int k, int c) { const int kk = (k & ~0xC) | ((k & 4) << 1) | ((k & 8) >> 1); return ((kk >> 3) * 4 + (c >> 5)) * 512 + ((kk & 7) * 32 + (c & 31)) * 2; }
__device__ __forceinline__ int v_rd_base(int lane) { return ((lane & 3) << 3) | (((lane >> 2) & 3) << 6) | (((lane >> 4) & 1) << 5) | (((lane >> 5) & 1) << 8); }
constexpr int v_rd_off(int d0, int ks, int half) { return d0 * 512 + ks * 4096 + half * 2048; }
template <int OFF> __device__ __forceinline__ s16x4 tr_read(int vb) {
  s16x4 r; asm volatile("ds_read_b64_tr_b16 %0, %1 offset:%2" : "=&v"(r) : "v"(vb), "i"(OFF) : "memory"); return r;
}
template <int D0> __device__ __forceinline__ void pv_one(f32x16& od, int vb, bf16x8 pa0, bf16x8 pa1, bf16x8 pa2, bf16x8 pa3) {
  const s16x4 l0 = tr_read<v_rd_off(D0, 0, 0)>(vb), h0 = tr_read<v_rd_off(D0, 0, 1)>(vb), l1 = tr_read<v_rd_off(D0, 1, 0)>(vb), h1 = tr_read<v_rd_off(D0, 1, 1)>(vb);
  const s16x4 l2 = tr_read<v_rd_off(D0, 2, 0)>(vb), h2 = tr_read<v_rd_off(D0, 2, 1)>(vb), l3 = tr_read<v_rd_off(D0, 3, 0)>(vb), h3 = tr_read<v_rd_off(D0, 3, 1)>(vb);
  asm volatile("s_waitcnt lgkmcnt(0)" ::: "memory"); SBAR();
#define PK(L, H) (bf16x8){L[0], L[1], L[2], L[3], H[0], H[1], H[2], H[3]}
  od = __builtin_amdgcn_mfma_f32_32x32x16_bf16(pa0, PK(l0, h0), od, 0, 0, 0);
  od = __builtin_amdgcn_mfma_f32_32x32x16_bf16(pa1, PK(l1, h1), od, 0, 0, 0);
  od = __builtin_amdgcn_mfma_f32_32x32x16_bf16(pa2, PK(l2, h2), od, 0, 0, 0);
  od = __builtin_amdgcn_mfma_f32_32x32x16_bf16(pa3, PK(l3, h3), od, 0, 0, 0);
#undef PK
}
__device__ __forceinline__ void pv_d0(f32x16* o, int vb, bf16x8 pa0, bf16x8 pa1, bf16x8 pa2, bf16x8 pa3) {
  pv_one<0>(o[0], vb, pa0, pa1, pa2, pa3); pv_one<1>(o[1], vb, pa0, pa1, pa2, pa3); pv_one<2>(o[2], vb, pa0, pa1, pa2, pa3); pv_one<3>(o[3], vb, pa0, pa1, pa2, pa3);
}
template <bool FAST>
__device__ __forceinline__ void attn_dense_body(const bf16* __restrict__ Qb, const bf16* __restrict__ Kh, const bf16* __restrict__ Vh, bf16* __restrict__ Ob, int seq, LAS unsigned char* lds) {
  int tid_ = threadIdx.x; asm volatile("" : "+v"(tid_));
  const int tid = tid_, wid = __builtin_amdgcn_readfirstlane(tid >> 6), lane = tid & 63, r32 = lane & 31, hi = lane >> 5;
  LAS unsigned char* V_lds = lds; LAS unsigned char* K_lds = lds + NBUF * SHM_V;
  LAS float* wsp = (LAS float*)(lds + NBUF * SHM_V + NBUF * SHM_K) + wid * 64; LAS float* li_l = wsp; LAS float* al_l = wsp + 32;
  float m_reg = FAST ? 0.f : -1e30f, l_reg = 0; f32x16 o[4] = {}; bf16x8 qr[8];
  const bf16* Qw = Qb + (long)(wid * QBLK + r32) * LDQ + hi * 8;
#pragma unroll
  for (int d0 = 0; d0 < 8; ++d0) qr[d0] = *(const GAS bf16x8*)(Qw + d0 * 16);
  const int sr = tid >> 4, sc = (tid & 15) * 8, vst0 = v_st(sr, sc), vst1 = v_st(32 + sr, sc);
  const int vb0 = (int)(unsigned)(uintptr_t)V_lds + v_rd_base(lane);
  struct { bf16x8 vs0, vs1, ks0, ks1; } sr_[2];
#define SLOAD(i, k0) do { sr_[i].vs0 = *(const GAS bf16x8*)(&Vh[(long)((k0) + sr) * LDK + sc]); sr_[i].vs1 = *(const GAS bf16x8*)(&Vh[(long)((k0) + 32 + sr) * LDK + sc]); \
    sr_[i].ks0 = *(const GAS bf16x8*)(&Kh[(long)((k0) + sr) * LDK + sc]); sr_[i].ks1 = *(const GAS bf16x8*)(&Kh[(long)((k0) + 32 + sr) * LDK + sc]); } while (0)
#define SWRITE(b, i) do { *(LAS bf16x8*)(V_lds + (b) * SHM_V + vst0) = sr_[i].vs0;          \
    *(LAS bf16x8*)(V_lds + (b) * SHM_V + vst1) = sr_[i].vs1; int kc = sc * 2;               \
    *(LAS bf16x8*)(K_lds + (b) * SHM_K + KSWZ(sr, kc)) = sr_[i].ks0;                       \
    *(LAS bf16x8*)(K_lds + (b) * SHM_K + KSWZ(32 + sr, kc)) = sr_[i].ks1; } while (0)
#define SWAIT() asm volatile("s_waitcnt vmcnt(4)" ::: "memory")
#define RESC(a) do { if (__any((a) < 1.f)) { if (hi == 0) al_l[r32] = (a); asm volatile("s_waitcnt lgkmcnt(0)" ::: "memory"); \
    _Pragma("unroll") for (int d = 0; d < 4; ++d) _Pragma("unroll") for (int r = 0; r < 16; ++r) o[d][r] *= al_l[crow(r, hi)]; } } while (0)
  f32x16 pA0, pA1, pB0, pB1; float mnA, mnB, alA, alB; bf16x8 pa0, pa1, pa2, pa3; const int NT = seq / KVBLK;
  constexpr int SE = 0, SO = 1;
  int bc = 1, bp = 0, bn = 2;
#define ROT() do { const int t_ = bp; bp = bc; bc = bn; bn = t_; } while (0)
  SLOAD(SE, 0); asm volatile("s_waitcnt vmcnt(0)" ::: "memory"); SWRITE(0, SE); __syncthreads();
  qkt(pA0, pA1, K_lds, qr, r32, hi); partialSM<FAST>(pA0, pA1, m_reg, mnA, alA);
  SLOAD(SO, KVBLK); if (2 < NT) SLOAD(SE, 2 * KVBLK);
  SWAIT(); SWRITE(1, SO); __syncthreads();
  for (int j = 1; j + 1 < NT; j += 2) {
    SBAR(); qkt(pB0, pB1, K_lds + bc * SHM_K, qr, r32, hi);
    finishSM(pA0, pA1, alA, l_reg, pa0, pa1, pa2, pa3); SBAR();
    SLOAD(SO, (j + 2) * KVBLK); SBAR();
    pv_d0(o, vb0 + bp * (int)SHM_V, pa0, pa1, pa2, pa3); partialSM<FAST>(pB0, pB1, m_reg, mnB, alB);
    SWAIT(); SWRITE(bn, SE);
    if (!FAST) RESC(alB);
    __syncthreads(); ROT();
    SBAR(); qkt(pA0, pA1, K_lds + bc * SHM_K, qr, r32, hi);
    finishSM(pB0, pB1, alB, l_reg, pa0, pa1, pa2, pa3); SBAR();
    if (j + 3 < NT) SLOAD(SE, (j + 3) * KVBLK); SBAR();
    pv_d0(o, vb0 + bp * (int)SHM_V, pa0, pa1, pa2, pa3); partialSM<FAST>(pA0, pA1, m_reg, mnA, alA);
    SWAIT(); SWRITE(bn, SO);
    if (!FAST) RESC(alA);
    __syncthreads(); ROT();
  }
  SBAR(); qkt(pB0, pB1, K_lds + bc * SHM_K, qr, r32, hi);
  finishSM(pA0, pA1, alA, l_reg, pa0, pa1, pa2, pa3); SBAR();
  pv_d0(o, vb0 + bp * (int)SHM_V, pa0, pa1, pa2, pa3); partialSM<FAST>(pB0, pB1, m_reg, mnB, alB);
  if (!FAST) RESC(alB);
  finishSM(pB0, pB1, alB, l_reg, pa0, pa1, pa2, pa3); SBAR();
  pv_d0(o, vb0 + bc * (int)SHM_V, pa0, pa1, pa2, pa3);
  if (hi == 0) li_l[r32] = l_reg; asm volatile("s_waitcnt lgkmcnt(0)" ::: "memory");
  float rli[16];
#pragma unroll
  for (int r = 0; r < 16; ++r) rli[r] = __builtin_amdgcn_rcpf(li_l[crow(r, hi)]);
  bf16* Ow = Ob + (long)(wid * QBLK) * LDO;
#pragma unroll
  for (int r = 0; r < 16; ++r) { int orow = crow(r, hi);
#pragma unroll
    for (int d0 = 0; d0 < 4; ++d0) Ow[(long)orow * LDO + d0 * 32 + r32] = (bf16)(cvtpk(o[d0][r] * rli[r], 0.f) & 0xffffu); }
  __syncthreads();
#undef SLOAD
#undef SWRITE
#undef SWAIT
#undef RESC
#undef ROT
}
constexpr int V16_LD = 288, SHM_V16 = KVBLK * V16_LD, SHM_K16 = KVBLK * D * 2;
#define KSWZ16(row, colB) ((row) * 256 + ((colB) ^ (((row) & 15) << 4)))
struct H16 { f32x4 s[2][2]; };
template <int PART, int KL> __device__ __forceinline__ void kload16(bf16x8 (&kf)[4], LAS const unsigned char* Ks, int li, int g) {
#pragma unroll
  for (int ks = 0; ks < 4; ++ks) kf[ks] = *(LAS const bf16x8*)(Ks + KSWZ16(16 * (2 * PART + KL) + li, 64 * ks + 16 * g));
}
template <int PART> __device__ __forceinline__ void qkmma16(H16& S, const bf16x8 (&ka)[4], LAS const unsigned char* Ks, const bf16x8 (&qf)[2][4], int li, int g) {
  bf16x8 kb[4]; kload16<PART, 1>(kb, Ks, li, g);
#pragma unroll
  for (int kl = 0; kl < 2; ++kl) { S.s[kl][0] = (f32x4){0.f, 0.f, 0.f, 0.f}; S.s[kl][1] = (f32x4){0.f, 0.f, 0.f, 0.f}; }
#pragma unroll
  for (int ks = 0; ks < 4; ++ks) {
    S.s[0][0] = __builtin_amdgcn_mfma_f32_16x16x32_bf16(ka[ks], qf[0][ks], S.s[0][0], 0, 0, 0);
    S.s[0][1] = __builtin_amdgcn_mfma_f32_16x16x32_bf16(ka[ks], qf[1][ks], S.s[0][1], 0, 0, 0); }
#pragma unroll
  for (int ks = 0; ks < 4; ++ks) {
    S.s[1][0] = __builtin_amdgcn_mfma_f32_16x16x32_bf16(kb[ks], qf[0][ks], S.s[1][0], 0, 0, 0);
    S.s[1][1] = __builtin_amdgcn_mfma_f32_16x16x32_bf16(kb[ks], qf[1][ks], S.s[1][1], 0, 0, 0); }
}
#define QK_SCHED() do { __builtin_amdgcn_sched_group_barrier(0x100, 4, 0); _Pragma("unroll") for (int i_ = 0; i_ < 16; ++i_) { __builtin_amdgcn_sched_group_barrier(0x008, 1, 0); __builtin_amdgcn_sched_group_barrier(0x002, 3, 0); } } while (0)
__device__ __forceinline__ void eh16(H16& S, float (&lsum)[2], bf16x8 (&pf)[2]) {
#pragma unroll
  for (int kl = 0; kl < 2; ++kl)
#pragma unroll
    for (int qb = 0; qb < 2; ++qb)
#pragma unroll
      for (int r = 0; r < 4; ++r) S.s[kl][qb][r] = __builtin_amdgcn_exp2f(S.s[kl][qb][r]);
#pragma unroll
  for (int qb = 0; qb < 2; ++qb) { const f32x4 a = S.s[0][qb], b = S.s[1][qb];
    lsum[qb] += ((a[0] + a[1]) + (a[2] + a[3])) + ((b[0] + b[1]) + (b[2] + b[3]));
    v4u w = {cvtpk(a[0], a[1]), cvtpk(a[2], a[3]), cvtpk(b[0], b[1]), cvtpk(b[2], b[3])}; pf[qb] = __builtin_bit_cast(bf16x8, w); }
}
constexpr int v16_off(int db, int part, int t) { return (32 * part + 16 * t) * V16_LD + db * 32; }
struct VF4 { s16x4 a0, a1, b0, b1, c0, c1, d0, d1; };
template <int PART, int G> __device__ __forceinline__ void vrd16(VF4& f, int vb) {
  f.a0 = tr_read<v16_off(4 * G, PART, 0)>(vb); f.a1 = tr_read<v16_off(4 * G, PART, 1)>(vb); f.b0 = tr_read<v16_off(4 * G + 1, PART, 0)>(vb); f.b1 = tr_read<v16_off(4 * G + 1, PART, 1)>(vb);
  f.c0 = tr_read<v16_off(4 * G + 2, PART, 0)>(vb); f.c1 = tr_read<v16_off(4 * G + 2, PART, 1)>(vb); f.d0 = tr_read<v16_off(4 * G + 3, PART, 0)>(vb); f.d1 = tr_read<v16_off(4 * G + 3, PART, 1)>(vb);
}
template <int G> __device__ __forceinline__ void vmma16(f32x4 (&o)[2][8], const VF4& f, const bf16x8 (&pf)[2]) {
#define PK(L, H) (bf16x8){L[0], L[1], L[2], L[3], H[0], H[1], H[2], H[3]}
  o[0][4 * G] = __builtin_amdgcn_mfma_f32_16x16x32_bf16(pf[0], PK(f.a0, f.a1), o[0][4 * G], 0, 0, 0);
  o[1][4 * G] = __builtin_amdgcn_mfma_f32_16x16x32_bf16(pf[1], PK(f.a0, f.a1), o[1][4 * G], 0, 0, 0);
  o[0][4 * G + 1] = __builtin_amdgcn_mfma_f32_16x16x32_bf16(pf[0], PK(f.b0, f.b1), o[0][4 * G + 1], 0, 0, 0);
  o[1][4 * G + 1] = __builtin_amdgcn_mfma_f32_16x16x32_bf16(pf[1], PK(f.b0, f.b1), o[1][4 * G + 1], 0, 0, 0);
  o[0][4 * G + 2] = __builtin_amdgcn_mfma_f32_16x16x32_bf16(pf[0], PK(f.c0, f.c1), o[0][4 * G + 2], 0, 0, 0);
  o[1][4 * G + 2] = __builtin_amdgcn_mfma_f32_16x16x32_bf16(pf[1], PK(f.c0, f.c1), o[1][4 * G + 2], 0, 0, 0);
  o[0][4 * G + 3] = __builtin_amdgcn_mfma_f32_16x16x32_bf16(pf[0], PK(f.d0, f.d1), o[0][4 * G + 3], 0, 0, 0);
  o[1][4 * G + 3] = __builtin_amdgcn_mfma_f32_16x16x32_bf16(pf[1], PK(f.d0, f.d1), o[1][4 * G + 3], 0, 0, 0);
#undef PK
}
typedef short v4i16_t __attribute__((ext_vector_type(4)));
__device__ __forceinline__ s16x4 vtr(LAS const unsigned char* p) { return __builtin_bit_cast(s16x4, __builtin_amdgcn_ds_read_tr16_b64_v4i16((LAS v4i16_t*)p)); }
template <int PART, int G> __device__ __forceinline__ void vld16(VF4& f, LAS const unsigned char* vp) {
  f.a0 = vtr(vp + v16_off(4 * G, PART, 0)); f.a1 = vtr(vp + v16_off(4 * G, PART, 1)); f.b0 = vtr(vp + v16_off(4 * G + 1, PART, 0)); f.b1 = vtr(vp + v16_off(4 * G + 1, PART, 1));
  f.c0 = vtr(vp + v16_off(4 * G + 2, PART, 0)); f.c1 = vtr(vp + v16_off(4 * G + 2, PART, 1)); f.d0 = vtr(vp + v16_off(4 * G + 3, PART, 0)); f.d1 = vtr(vp + v16_off(4 * G + 3, PART, 1));
}
template <int PART, int KPART> __device__ __forceinline__ void pvh16(f32x4 (&o)[2][8], LAS const unsigned char* vp, const bf16x8 (&pf)[2], bf16x8 (&kf)[4], LAS const unsigned char* Ks, int li, int g) {
  VF4 f0, f1;
  vld16<PART, 0>(f0, vp); vld16<PART, 1>(f1, vp);
  vmma16<0>(o, f0, pf); vmma16<1>(o, f1, pf);
  kload16<KPART, 0>(kf, Ks, li, g);
  __builtin_amdgcn_sched_group_barrier(0x100, 16, 0); __builtin_amdgcn_sched_group_barrier(0x008, 16, 0); __builtin_amdgcn_sched_group_barrier(0x100, 4, 0);
}
__device__ __forceinline__ void attn16_body(const bf16* __restrict__ Qb, const bf16* __restrict__ Kh, const bf16* __restrict__ Vh, bf16* __restrict__ Ob, int seq, LAS unsigned char* lds) {
  int tid_ = threadIdx.x; asm volatile("" : "+v"(tid_));
  const int tid = tid_, wid = __builtin_amdgcn_readfirstlane(tid >> 6), lane = tid & 63, li = lane & 15, g = lane >> 4;
  LAS unsigned char* V_lds = lds; LAS unsigned char* K_lds = lds + NBUF * SHM_V16;
  LAS float* li_l = (LAS float*)(lds + NBUF * SHM_V16 + NBUF * SHM_K16) + wid * 64;
  float lsum[2] = {0.f, 0.f}; f32x4 o[2][8]; bf16x8 qf[2][4];
#pragma unroll
  for (int qb = 0; qb < 2; ++qb)
#pragma unroll
    for (int db = 0; db < 8; ++db) o[qb][db] = (f32x4){0.f, 0.f, 0.f, 0.f};
#pragma unroll
  for (int qb = 0; qb < 2; ++qb)
#pragma unroll
    for (int ks = 0; ks < 4; ++ks) qf[qb][ks] = *(const GAS bf16x8*)(Qb + (long)(wid * QBLK + 16 * qb + li) * LDQ + 32 * ks + 8 * g);
  const int sr = tid >> 4, sc = (tid & 15) * 8;
  LAS const unsigned char* vp0 = V_lds + (4 * g + (li >> 2)) * V16_LD + (li & 3) * 8;
  bf16x8 vs0, vs1, ks0, ks1;
#define SLOAD(k0) do { vs0 = *(const GAS bf16x8*)(&Vh[(long)((k0) + sr) * LDK + sc]); vs1 = *(const GAS bf16x8*)(&Vh[(long)((k0) + 32 + sr) * LDK + sc]); \
    ks0 = *(const GAS bf16x8*)(&Kh[(long)((k0) + sr) * LDK + sc]); ks1 = *(const GAS bf16x8*)(&Kh[(long)((k0) + 32 + sr) * LDK + sc]); } while (0)
#define SWRITE(b) do { *(LAS bf16x8*)(V_lds + (b) * SHM_V16 + sr * V16_LD + sc * 2) = vs0; *(LAS bf16x8*)(V_lds + (b) * SHM_V16 + (32 + sr) * V16_LD + sc * 2) = vs1; const int kc = sc * 2; \
    *(LAS bf16x8*)(K_lds + (b) * SHM_K16 + KSWZ16(sr, kc)) = ks0; *(LAS bf16x8*)(K_lds + (b) * SHM_K16 + KSWZ16(32 + sr, kc)) = ks1; } while (0)
  H16 S0, S1; bf16x8 pf[2]; const int NT = seq / KVBLK;
  SLOAD(0); SWRITE(0); SLOAD(KVBLK); SWRITE(1); __syncthreads();
  bf16x8 kf[4];
  SBAR(); kload16<0, 0>(kf, K_lds, li, g); qkmma16<0>(S0, kf, K_lds, qf, li, g); kload16<1, 0>(kf, K_lds, li, g); SBAR();
  int bc = 0, bnx = 1, bw = 2;
  for (int j = 0; j < NT; ++j) {
    if (j + 2 < NT) SLOAD((j + 2) * KVBLK);
    SBAR(); qkmma16<1>(S1, kf, K_lds + bc * SHM_K16, qf, li, g); eh16(S0, lsum, pf); QK_SCHED(); SBAR();
    pvh16<0, 0>(o, vp0 + bc * SHM_V16, pf, kf, K_lds + bnx * SHM_K16, li, g); SBAR();
    if (j + 1 < NT) { qkmma16<0>(S0, kf, K_lds + bnx * SHM_K16, qf, li, g); eh16(S1, lsum, pf); QK_SCHED(); } else { eh16(S1, lsum, pf); } SBAR();
    pvh16<1, 1>(o, vp0 + bc * SHM_V16, pf, kf, K_lds + bnx * SHM_K16, li, g); SBAR();
    if (j + 2 < NT) SWRITE(bw);
    __syncthreads();
    { const int t_ = bc; bc = bnx; bnx = bw; bw = t_; }
  }
#pragma unroll
  for (int qb = 0; qb < 2; ++qb) { float v = lsum[qb]; v += __shfl_xor(v, 16); v += __shfl_xor(v, 32); if (g == 0) li_l[16 * qb + li] = v; }
  asm volatile("s_waitcnt lgkmcnt(0)" ::: "memory");
  bf16* Ow = Ob + (long)(wid * QBLK) * LDO;
#pragma unroll
  for (int qb = 0; qb < 2; ++qb)
#pragma unroll
    for (int r = 0; r < 4; ++r) { const int qrow = 16 * qb + 4 * g + r; const float rl = __builtin_amdgcn_rcpf(li_l[qrow]);
#pragma unroll
      for (int db = 0; db < 8; ++db) Ow[(long)qrow * LDO + 16 * db + li] = (bf16)(cvtpk(o[qb][db][r] * rl, 0.f) & 0xffffu); }
  __syncthreads();
#undef SLOAD
#undef SWRITE
}
#undef QK_SCHED
#undef KSWZ16
#undef KSWZ
#undef SBAR
}

constexpr int N_PHASES = 27;
template <int V> struct ICON { static constexpr int value = V; };
#ifndef MK_ONE_LAUNCH
#define MK_ONE_LAUNCH 1
#endif
__global__ void __launch_bounds__(NWAVES * 64, 2) fwd_kernel(Args args) {
    extern __shared__ __attribute__((aligned(16))) unsigned char lds[];
    Frame F;
    F.lds = (LAS unsigned char*)lds;
    F.MISC = (volatile LAS unsigned*)(F.lds + MISC_OFF);
    F.tid = threadIdx.x; F.lane = F.tid & 63; F.wave = __builtin_amdgcn_readfirstlane(F.tid >> 6);
    F.G = gridDim.x; { const int bx = blockIdx.x; F.vcu = (F.G % 8 == 0) ? (bx % 8) * (F.G / 8) + bx / 8 : bx; }
    const int vcu0 = F.vcu; int bidx = (int)blockIdx.x;
    F.ctl = (gu32*)(args.ws + WS_CTL);
    for (int u = F.tid; u < (LDS_BYTES - LDSCTL_OFF) / 4; u += NWAVES * 64) ((LAS unsigned*)(F.lds + LDSCTL_OFF))[u] = 0u;
    __syncthreads();
    const int lo = args.ph_lo, hi = args.ph_hi;
    XcdBarrier bar; bar.bar = (unsigned*)(F.ctl + CW_BAR); bar.x = 0; bar.st = nullptr;
    if (hi - lo > 1) bar = xcd_barrier_post((unsigned*)(F.ctl + CW_BAR), F.MISC + 8);
#if MK_ONE_LAUNCH
#define IN(k) true
#else
#define IN(k) (lo <= (k) && (k) < hi)
#endif
#define SEAM(k) do { if (IN(k) && IN((k) + 1)) { XcdBarrier bb_ = bar; asm volatile("" : "+s"(bb_.x)); unsigned* bp_ = bb_.bar; asm volatile("" : "+s"(bp_)); bb_.bar = bp_; xcd_barrier(bb_); } } while (0)
#define FRESH() do { int t_ = threadIdx.x; asm volatile("" : "+v"(t_)); F.tid = t_; F.lane = t_ & 63; F.wave = __builtin_amdgcn_readfirstlane(t_ >> 6); } while (0)

    const int NGW = F.G * NWAVES;
#define KARG_AS __attribute__((address_space(4)))
#define WSP() const KARG_AS Args* ka_ = (const KARG_AS Args*)__builtin_amdgcn_kernarg_segment_ptr(); asm volatile("" : "+s"(ka_)); unsigned char* ws = ka_->ws; asm volatile("" : "+s"(ws)); \
    { int v_ = vcu0; asm volatile("" : "+s"(v_)); F.vcu = v_; int b_ = (int)blockIdx.x; asm volatile("" : "+s"(b_)); bidx = b_; }
#define WSP0() unsigned char* ws = args.ws; asm volatile("" : "+s"(ws))
    if (IN(0)) { FRESH(); p0_prologue(F, args); }
    SEAM(0);
    if (IN(1)) { FRESH(); p1_modreduce(F, args); }
    SEAM(1);

    auto layer_half = [&](auto LC_, auto HC_) __attribute__((always_inline)) {
        constexpr int l = decltype(LC_)::value, half = decltype(HC_)::value;
        constexpr int pb = 2 + 12 * l; constexpr int last = (l == DEPTH - 1) ? 1 : 0;
        {
            if (half == 1) {
                if (IN(pb + 3)) { FRESH(); WSP(); norm_phase<l == 0>(F, (const float*)nullptr, l == 0 ? ka_->in[2] : (const float*)nullptr, (bf16*)(ws + WS_RES), ka_->in[6] + (size_t)(l * 3 + 1) * DM, (const float*)(ws + WS_MOD) + (size_t)l * 3 * MODW, 1, (bf16*)ka_->out, 0, (const float*)(ws + WS_PART)); }
                SEAM(pb + 3);
                if (IN(pb + 4)) { WSP();
                    pg8::Gemm g{(const bf16*)ka_->out, (const bf16*)(ws + WS_W + (size_t)l * W_LAYER + W_IN), M_ALL, NZ, DM, DM}; pg8::PanelOrder S; S.init(NPAN, NZ / 256, F.G, bidx, 0);
                    pg8::EpiBf16Plain E{(bf16*)(ws + WS_Z), NZ};
                    pg8::gemm_phase<pg8::EpiBf16Plain, pg8::PanelOrder, true, true>(F.lds + RING_OFF, g, S, E);
                }
                SEAM(pb + 4);
                if (IN(pb + 5)) { FRESH(); WSP(); const int gw = F.vcu * NWAVES + F.wave;
                    bf16* Z = (bf16*)(ws + WS_Z); bf16* MIX = (bf16*)(ws + WS_MIX);
                    const float* gw_l = ka_->in[14] + (size_t)l * 2 * 16 * 256; const float* gb_l = ka_->in[15] + (size_t)l * 2 * 256;
                    const float* wsl = ka_->in[17] + (size_t)l * 4 * 128 * 128; const float* bsl = ka_->in[18] + (size_t)l * 4 * 128; const float* gml = ka_->in[19] + (size_t)l * 512;
                    const float* qkg = ka_->in[13] + (size_t)l * 256; const float* rope_c = (const float*)(ws + WS_ROPE);
                    {
                    for (int U = F.vcu; U < NCH * 4; U += F.G) gla_a_unit(F, Z, (bf16*)(ws + WS_QG), (float*)(ws + WS_UT), (float*)(ws + WS_DV), U >> 2, U & 3, gw_l, gb_l);
                    for (int row = gw; row < M_ALL; row += NGW) qknorm_row(Z, row, qkg, rope_c, rope_c + 256 * 32, F.lane);
                    }
                }
                SEAM(pb + 5);
                if (IN(pb + 6)) { FRESH(); WSP(); gla_scan_phase(F, (const float*)(ws + WS_UT), (const float*)(ws + WS_DV), (bf16*)(ws + WS_ST)); }
                SEAM(pb + 6);
                if (IN(pb + 7)) { FRESH(); WSP();
                    bf16* Z = (bf16*)(ws + WS_Z); bf16* MIX = (bf16*)(ws + WS_MIX);
                    float nbl2;
                    { const float* qkg = ka_->in[13] + (size_t)l * 256; float gq = fmaxf(fabsf(qkg[F.lane]), fabsf(qkg[64 + F.lane])), gk = fmaxf(fabsf(qkg[128 + F.lane]), fabsf(qkg[192 + F.lane]));
#pragma unroll
                      for (int o = 1; o < 64; o <<= 1) { gq = fmaxf(gq, __shfl_xor(gq, o)); gk = fmaxf(gk, __shfl_xor(gk, o)); }
                      nbl2 = -11.313708499f * gq * gk * 1.4426950408889634f; nbl2 = __builtin_bit_cast(float, __builtin_amdgcn_readfirstlane(__builtin_bit_cast(int, nbl2))); }
                    { const int nU = last ? 1024 : 1040;
#define ATT_UNITS(FASTP) for (int U = F.vcu; U < nU; U += F.G) { \
                            int b, hq, kvh, seq; size_t row0; \
                            if (U < 1024) { const int i = U >> 8, v = U & 255, grp = v >> 6; b = grp >> 1; kvh = grp & 1; hq = kvh * 4 + i; row0 = (size_t)b * TOKB + CTXL + (size_t)(v & 63) * 256; seq = TOKB; } \
                            else { const int V = U - 1024; b = V >> 3; hq = V & 7; kvh = hq >> 2; row0 = (size_t)b * TOKB; seq = CTXL; } \
                            const size_t kv0 = (size_t)b * TOKB; \
                            if (FASTP) att::attn16_body(Z + row0 * NZ + ZQ + hq * 128, Z + kv0 * NZ + ZK + kvh * 128, Z + kv0 * NZ + ZV + kvh * 128, MIX + row0 * DM + MXA + hq * 128, seq, F.lds + RING_OFF); \
                            else att::attn_dense_body<false>(Z + row0 * NZ + ZQ + hq * 128, Z + kv0 * NZ + ZK + kvh * 128, Z + kv0 * NZ + ZV + kvh * 128, MIX + row0 * DM + MXA + hq * 128, seq, F.lds + RING_OFF); }
                        if (nbl2 >= -100.0f) { ATT_UNITS(true) } else { ATT_UNITS(false) }
#undef ATT_UNITS
                    }
                    FRESH(); const int gw = F.vcu * NWAVES + F.wave;
                    const float* gg = ka_->in[16] + (size_t)l * 512;
                    { unsigned* gcnt = (unsigned*)(ws + WS_CTL + 61440 + 64 * (12 + l)); volatile LAS unsigned* gslot = (volatile LAS unsigned*)(F.lds + MISC_OFF + 1032);
                      (void)gw;
                      unsigned nx_ = 0u; if (threadIdx.x == 0) nx_ = __hip_atomic_fetch_add(gcnt, 1u, __ATOMIC_RELAXED, __HIP_MEMORY_SCOPE_AGENT);
                      for (int it_ = 0;; ++it_) {
                          if (threadIdx.x == 0) gslot[it_ & 1] = nx_;
                          __syncthreads();
                          const unsigned bi = gslot[it_ & 1];
                          if (bi >= (unsigned)(NCH * 2)) break;
                          if (threadIdx.x == 0) nx_ = __hip_atomic_fetch_add(gcnt, 1u, __ATOMIC_RELAXED, __HIP_MEMORY_SCOPE_AGENT);
                          const int w = (int)bi * 8 + F.wave; const int chunk = w >> 4, c = chunk % CHB; if (last && c < 2) continue;
                          gla_c_item(Z, (const bf16*)(ws + WS_QG), (const bf16*)(ws + WS_ST), MIX, chunk, (w >> 2) & 3, w & 3, gg, F.lane); } }
                    { const float* wsl = ka_->in[17] + (size_t)l * 4 * 128 * 128; const float* bsl = ka_->in[18] + (size_t)l * 4 * 128; const float* gml = ka_->in[19] + (size_t)l * 512;
                      unsigned* qb = (unsigned*)(ws + WS_CTL + 61440 + 64 * (14 + l)); volatile LAS unsigned* qs = (volatile LAS unsigned*)(F.lds + MISC_OFF + 1040);
                      __syncthreads();
                      unsigned nx_ = 0u; if (threadIdx.x == 0) nx_ = __hip_atomic_fetch_add(qb, 1u, __ATOMIC_RELAXED, __HIP_MEMORY_SCOPE_AGENT);
                      for (int it_ = 0;; ++it_) {
                          if (threadIdx.x == 0) qs[it_ & 1] = nx_;
                          __syncthreads();
                          const int V = (int)qs[it_ & 1]; if (V >= NCH * 4) break;
                          if (threadIdx.x == 0) nx_ = __hip_atomic_fetch_add(qb, 1u, __ATOMIC_RELAXED, __HIP_MEMORY_SCOPE_AGENT);
                          const int chunk = V >> 2; if (!(last && (chunk % CHB) < 2)) gmlp_unit(F, Z, MIX, chunk, V & 3, wsl, bsl, gml); } }
                }
                SEAM(pb + 7);
                if (IN(pb + 8)) { WSP();
                    pg8::Gemm g{(const bf16*)(ws + WS_MIX), (const bf16*)(ws + WS_W + (size_t)l * W_LAYER + W_OUT), M_ALL, DM, DM, DM}; pg8::PanelOrder S; S.init(NPAN - 2, DM / 256, F.G, bidx, 1);
                    { pg8::EpiResid E{(const float*)nullptr, (float*)nullptr, (bf16*)(ws + WS_RES), (const float*)(ws + WS_MOD) + (size_t)l * 3 * MODW, 5, 1.0f};
                    pg8::gemm_phase<pg8::EpiResid, pg8::PanelOrder, true, true>(F.lds + RING_OFF, g, S, E); }
                    if (!last) {
                        pg8::Gemm gc{(const bf16*)(ws + WS_MIX), (const bf16*)(ws + WS_W + (size_t)l * W_LAYER + W_OUT), M_ALL, DM, DM / CTX_NS, DM}; pg8::CtxSplitOrder Sc; Sc.init(DM / 256, CTX_NS, DM / CTX_NS, F.G, bidx); Sc.dyn = (unsigned*)(ws + WS_CTL + 61440 + 64 * (10 + l)); Sc.slot = (volatile LAS unsigned*)(F.lds + MISC_OFF + 1028);
                        pg8::EpiCtxPartial Ec{(float*)(ws + WS_PART), (const float*)(ws + WS_MOD) + (size_t)l * 3 * MODW, 5, 1.0f};
                        pg8::gemm_phase<pg8::EpiCtxPartial, pg8::CtxSplitOrder, true, true>(F.lds + RING_OFF, gc, Sc, Ec); }
                }
                SEAM(pb + 8);
            }
            const int pf = pb + 9 * half, sub = 2 * half, first = (l == 0 && half == 0) ? 1 : 0, skipc = (last && half == 1) ? 1 : 0;
            if (IN(pf + 0)) { FRESH(); WSP();
                norm_phase(F, first ? ka_->in[0] : (const float*)nullptr, first ? ka_->in[2] : (const float*)nullptr, (bf16*)(ws + WS_RES), ka_->in[6] + (size_t)(l * 3 + sub) * DM, (const float*)(ws + WS_MOD) + (size_t)l * 3 * MODW, sub, (bf16*)ka_->out, skipc,
                           (half == 1 ? !last : l > 0) ? (const float*)(ws + WS_PART) : (const float*)nullptr); }
            SEAM(pf + 0);
            if (IN(pf + 1)) { WSP();
                pg8::Gemm g{(const bf16*)ka_->out, (const bf16*)(ws + WS_W + (size_t)l * W_LAYER + (half ? W_GU2 : W_GU1)), M_ALL, NGU, DM, DM}; pg8::PanelOrder S; S.init(skipc ? NPAN - 2 : NPAN, NGU / 256, F.G, bidx, skipc); S.dyn = (unsigned*)(ws + WS_CTL + 61440 + 64 * (l * 2 + half)); S.slot = (volatile LAS unsigned*)(F.lds + MISC_OFF + 1024);
                pg8::EpiSwiglu E{(bf16*)(ws + WS_H), DFF};
                pg8::gemm_phase<pg8::EpiSwiglu, pg8::PanelOrder, true, true>(F.lds + RING_OFF, g, S, E);
            }
            SEAM(pf + 1);
            if (IN(pf + 2)) { WSP();
                pg8::Gemm g{(const bf16*)(ws + WS_H), (const bf16*)(ws + WS_W + (size_t)l * W_LAYER + (half ? W_D2 : W_D1)), M_ALL, DM, DFF, DFF}; pg8::PanelOrder S; S.init(NPAN - 2, DM / 256, F.G, bidx, 1); S.reverse_rounds();
                { pg8::EpiResid E{first ? ka_->in[0] : (const float*)nullptr, (float*)nullptr, (bf16*)(ws + WS_RES), (const float*)(ws + WS_MOD) + (size_t)l * 3 * MODW, 3 * sub + 2, 0.5f};
                pg8::gemm_phase<pg8::EpiResid, pg8::PanelOrder, true, true>(F.lds + RING_OFF, g, S, E); }
                if (!skipc) {
                    pg8::Gemm gc{(const bf16*)(ws + WS_H), (const bf16*)(ws + WS_W + (size_t)l * W_LAYER + (half ? W_D2 : W_D1)), M_ALL, DM, DFF / CTX_NS, DFF}; pg8::CtxSplitOrder Sc; Sc.init(DM / 256, CTX_NS, DFF / CTX_NS, F.G, bidx); Sc.dyn = (unsigned*)(ws + WS_CTL + 61440 + 64 * (6 + l * 2 + half)); Sc.slot = (volatile LAS unsigned*)(F.lds + MISC_OFF + 1028);
                    pg8::EpiCtxPartial Ec{(float*)(ws + WS_PART), (const float*)(ws + WS_MOD) + (size_t)l * 3 * MODW, 3 * sub + 2, 0.5f};
                    pg8::gemm_phase<pg8::EpiCtxPartial, pg8::CtxSplitOrder, true, true>(F.lds + RING_OFF, gc, Sc, Ec); }
            }
            SEAM(pf + 2);
        }
    };
    static_assert(DEPTH == 2, "the four instantiations below");
    layer_half(ICON<0>{}, ICON<0>{}); layer_half(ICON<0>{}, ICON<1>{}); layer_half(ICON<1>{}, ICON<0>{}); layer_half(ICON<1>{}, ICON<1>{});
    if (IN(26)) { FRESH(); WSP(); final_norm_phase(F, (const bf16*)(ws + WS_RES), ka_->out, ka_->in[20]); }
#undef IN
#undef SEAM
}

extern "C" void kernel_launch(void* const* d_in, const int* in_sizes, int n_in, void* d_out, int out_size, void* d_ws, size_t ws_size, hipStream_t stream) {
    static int grid = 0;
    if (grid == 0) {
        if (n_in != 21 || in_sizes[0] != NB * SEQ * DM || out_size != NB * SEQ * DM || ws_size < WS_END) {
            fprintf(stderr, "kernel_launch: shape mismatch: n_in %d in0 %d out %d ws %zu (need %zu)\n", n_in, n_in > 0 ? in_sizes[0] : -1, out_size, ws_size, (size_t)WS_END); grid = -1; return; }
        int dev = 0, cus = 0, per_cu = 0;
        if (hipGetDevice(&dev) != hipSuccess || hipDeviceGetAttribute(&cus, hipDeviceAttributeMultiprocessorCount, dev) != hipSuccess) { fprintf(stderr, "kernel_launch: device query failed\n"); grid = -1; return; }
        if (hipFuncSetAttribute((const void*)fwd_kernel, hipFuncAttributeMaxDynamicSharedMemorySize, LDS_BYTES) != hipSuccess) { fprintf(stderr, "kernel_launch: hipFuncSetAttribute failed\n"); grid = -1; return; }
        if (hipOccupancyMaxActiveBlocksPerMultiprocessor(&per_cu, (const void*)fwd_kernel, NWAVES * 64, LDS_BYTES) != hipSuccess || per_cu < 1)
            fprintf(stderr, "kernel_launch: note: occupancy query reports %d workgroups per CU\n", per_cu);
        (void)hipGetLastError();
        grid = cus;
    }
    if (grid < 0) return;
    if (hipMemsetAsync((char*)d_ws + WS_CTL, 0, CTL_ZERO_BYTES, stream) != hipSuccess) { fprintf(stderr, "kernel_launch: memset failed\n"); return; }
    Args a{};
    for (int i = 0; i < 21; ++i) a.in[i] = (const float*)d_in[i];
    a.out = (float*)d_out; a.ws = (unsigned char*)d_ws;
#if MK_ONE_LAUNCH
    a.ph_lo = 0; a.ph_hi = N_PHASES;
    hipLaunchKernelGGL(fwd_kernel, dim3(grid), dim3(NWAVES * 64), LDS_BYTES, stream, a);
#else
    for (int p = 0; p < N_PHASES; ++p) { a.ph_lo = p; a.ph_hi = p + 1; hipLaunchKernelGGL(fwd_kernel, dim3(grid), dim3(NWAVES * 64), LDS_BYTES, stream, a); }
#endif
    const hipError_t le = hipPeekAtLastError();
    if (le != hipSuccess) fprintf(stderr, "kernel_launch: launch failed: %s\n", hipGetErrorName(le));
}
```

```cpp
#include <hip/hip_runtime.h>
#include <cstdio>
#include <cstdint>
#include <cmath>
namespace pg8 {
#define PG8_LAS __attribute__((address_space(3)))
typedef unsigned short bf16_t;
typedef short bf16x8 __attribute__((ext_vector_type(8)));
typedef float f32x4 __attribute__((ext_vector_type(4)));
typedef unsigned u32x4 __attribute__((ext_vector_type(4)));
constexpr int BM = 256, BK = 64, HALF = 128, HTB = HALF * BK * 2  , STAGE_BYTES = 8 * HTB, NXCD = 8, WGM = 4;

__host__ __device__ __forceinline__ int lds_byte(int r, int c) { const int st = (r >> 4) * 2 + (c >> 5), rr = r & 15, cc = c & 31, ob = rr * 64 + cc * 2; return st * 1024 + (ob ^ (((ob >> 9) & 1) << 5)); }
__host__ __device__ __forceinline__ void stage_rc(int b, int& R, int& C) { const int st = b / 1024, sb = b % 1024, swz = sb ^ (((sb >> 9) & 1) << 5); R = (st >> 1) * 16 + swz / 64; C = (st & 1) * 32 + (swz % 64) / 2; }
__host__ __device__ __forceinline__ int perm32(int rho) { const int n = rho >> 4, i = rho & 15; return 8 * (i >> 2) + 4 * n + (i & 3); }

struct Unit { int pm, pn, ko, ks; };
struct Gemm { const bf16_t* A; const bf16_t* Bt; int M, N, K, ld; };

struct StaticOrder {
    static constexpr bool DYN = false;
    int nM, nN, nwg, G, c;
    __host__ __device__ void init(int M, int N, int G_, int c_) { nM = M / BM; nN = N / BM; nwg = nM * nN; G = G_; c = c_; }
    __host__ __device__ bool next(int i, Unit& u) const {
        const long L = (long)i * G + c; if (L >= nwg) return false;
        int wgid = (int)L; { const int q = nwg / NXCD, r = nwg % NXCD, xcd = wgid % NXCD, off = wgid / NXCD; wgid = (xcd < r ? xcd * (q + 1) : r * (q + 1) + (xcd - r) * q) + off; }
        const int nig = WGM * nN, gid = wgid / nig, fm = gid * WGM, gsz = (nM - fm) < WGM ? (nM - fm) : WGM;
        u.pm = fm + ((wgid % nig) % gsz); u.pn = (wgid % nig) / gsz; u.ko = 0; u.ks = 0; return true;
    }
    __device__ __forceinline__ void a_ready(const Unit&) const {}
    __device__ __forceinline__ void done(const Unit&) const {}
};

typedef float f32x2c_t __attribute__((ext_vector_type(2))); typedef __bf16 bf16x2c_t __attribute__((ext_vector_type(2)));
__device__ __forceinline__ unsigned cvt_pk_bf16(float lo, float hi) { f32x2c_t v = {lo, hi}; bf16x2c_t b = __builtin_convertvector(v, bf16x2c_t); return __builtin_bit_cast(unsigned, b); }
typedef float f32x2 __attribute__((ext_vector_type(2)));
constexpr int PAN_PER_B = 65, RES_LD = 2048;
__device__ __forceinline__ int panel_set(int pm) { const int b = pm / PAN_PER_B, jp = pm - b * PAN_PER_B; return jp == 0 ? 2 : b; }
template <class T> __device__ __forceinline__ T* panel_ptr(T* lat, T* ctx, int pm) {
    const int b = pm / PAN_PER_B, jp = pm - b * PAN_PER_B;
    return jp == 0 ? ctx + (size_t)b * 256 * RES_LD : lat + ((size_t)b * 16384 + (size_t)(jp - 1) * 256) * RES_LD;
}
struct PanelOrder {
    static constexpr bool DYN = true;
    int nM, nN, nwg, G, c, skip, rev;
    unsigned* dyn; volatile PG8_LAS unsigned* slot;
    __device__ void init(int nM_, int nN_, int G_, int c_, int skip_) { nM = nM_; nN = nN_; nwg = nM * nN; G = G_; c = c_; skip = skip_; rev = 0; dyn = nullptr; slot = nullptr; }
    __device__ bool is_dyn(int i) const { return dyn != nullptr && rev == 0 && (nwg % G) != 0 && i == nwg / G; }
    __device__ void dyn_request(int lane) const { if (lane == 0) { const unsigned k = __hip_atomic_fetch_add(dyn, 1u, __ATOMIC_RELAXED, __HIP_MEMORY_SCOPE_AGENT); *slot = k; } }
    __device__ bool dyn_fetch(Unit& u) const { const unsigned k = *slot; const long L = (long)(nwg / G) * G + (long)k; if (L >= nwg) return false; return map(L, u); }
    __device__ void reverse_rounds() { rev = (nwg % G == 0) ? nwg / G : 0; }
    __device__ bool next(int i, Unit& u) const {
        if (rev) { if (i >= rev) return false; i = rev - 1 - i; }
        const long L = (long)i * G + c; if (L >= nwg) return false;
        return map(L, u);
    }
    __device__ bool map(long L, Unit& u) const {
        int wgid = (int)L; { const int q = nwg / NXCD, r = nwg % NXCD, xcd = wgid % NXCD, off = wgid / NXCD; wgid = (xcd < r ? xcd * (q + 1) : r * (q + 1) + (xcd - r) * q) + off; }
        const int nig = WGM * nN, gid = wgid / nig, fm = gid * WGM, gsz = (nM - fm) < WGM ? (nM - fm) : WGM;
        int pm = fm + ((wgid % nig) % gsz); u.pn = (wgid % nig) / gsz;
        if (skip) pm += 1 + (pm >= 64 ? 1 : 0);
        u.pm = pm; u.ko = 0; u.ks = 0; return true;
    }
    __device__ __forceinline__ void a_ready(const Unit&) const {}
    __device__ __forceinline__ void done(const Unit&) const {}
};
struct EpiBf16Plain {
    static constexpr bool PERM = true, AFTER_DRAIN = false;
    bf16_t* O; int ldc;
    __device__ __forceinline__ void operator()(const f32x4 (&acc)[2][2][4][2], const Unit& u, int wr, int wc, int fr, int fq) const {
        const int row0 = u.pm * BM + wr * 64 + fr, col0 = u.pn * BM + wc * 32 + 8 * fq;
#pragma unroll
        for (int ai = 0; ai < 2; ++ai)
#pragma unroll
            for (int m = 0; m < 4; ++m) { bf16_t* rowp = O + (size_t)(row0 + ai * HALF + m * 16) * ldc + col0;
#pragma unroll
                for (int bj = 0; bj < 2; ++bj) { const f32x4 v0 = acc[ai][bj][m][0], v1 = acc[ai][bj][m][1];
                    u32x4 w; w.x = cvt_pk_bf16(v0[0], v0[1]); w.y = cvt_pk_bf16(v0[2], v0[3]); w.z = cvt_pk_bf16(v1[0], v1[1]); w.w = cvt_pk_bf16(v1[2], v1[3]);
                    *(u32x4*)(rowp + bj * HALF) = w; } }
    }
};
__device__ __forceinline__ float silu_f(float g) { return g * __builtin_amdgcn_rcpf(1.0f + __builtin_amdgcn_exp2f(-1.4426950408889634f * g)); }
struct EpiSwiglu {
    static constexpr bool PERM = true, AFTER_DRAIN = false;
    bf16_t* H; int ldh;
    __device__ __forceinline__ void operator()(const f32x4 (&acc)[2][2][4][2], const Unit& u, int wr, int wc, int fr, int fq) const {
        const int row0 = u.pm * BM + wr * 64 + fr, col0 = u.pn * HALF + wc * 32 + 8 * fq;
#pragma unroll
        for (int ai = 0; ai < 2; ++ai)
#pragma unroll
            for (int m = 0; m < 4; ++m) { bf16_t* rowp = H + (size_t)(row0 + ai * HALF + m * 16) * ldh + col0;
                const f32x4 g0 = acc[ai][0][m][0], g1 = acc[ai][0][m][1], u0 = acc[ai][1][m][0], u1 = acc[ai][1][m][1];
                u32x4 w; w.x = cvt_pk_bf16(silu_f(g0[0]) * u0[0], silu_f(g0[1]) * u0[1]); w.y = cvt_pk_bf16(silu_f(g0[2]) * u0[2], silu_f(g0[3]) * u0[3]);
                w.z = cvt_pk_bf16(silu_f(g1[0]) * u1[0], silu_f(g1[1]) * u1[1]); w.w = cvt_pk_bf16(silu_f(g1[2]) * u1[2], silu_f(g1[3]) * u1[3]);
                __builtin_nontemporal_store(w, (u32x4*)rowp); }
    }
};
typedef _Float16 h16x2 __attribute__((ext_vector_type(2)));
__device__ __forceinline__ unsigned pk_h16(float lo, float hi) { const _Float16 a = (_Float16)lo, b = (_Float16)hi; return (unsigned)__builtin_bit_cast(unsigned short, a) | ((unsigned)__builtin_bit_cast(unsigned short, b) << 16); }
__device__ __forceinline__ void unpack8(const u32x4 w, float (&y)[8]) {
    const unsigned wx = w.x, wy = w.y, wz = w.z, ww = w.w;
    const h16x2 a = __builtin_bit_cast(h16x2, wx), b = __builtin_bit_cast(h16x2, wy), c = __builtin_bit_cast(h16x2, wz), d = __builtin_bit_cast(h16x2, ww);
    y[0] = (float)a[0]; y[1] = (float)a[1]; y[2] = (float)b[0]; y[3] = (float)b[1]; y[4] = (float)c[0]; y[5] = (float)c[1]; y[6] = (float)d[0]; y[7] = (float)d[1]; }
struct EpiResid {
    static constexpr bool PERM = true, AFTER_DRAIN = false;
    const float* base_f32  ; float* out_f32  ; bf16_t* res  ;
    const float* gate  ; int gidx; float scale;
    __device__ __forceinline__ void operator()(const f32x4 (&acc)[2][2][4][2], const Unit& u, int wr, int wc, int fr, int fq) const {
        const int col0 = u.pn * BM + wc * 32 + 8 * fq, set = panel_set(u.pm), r0 = wr * 64 + fr;
        const float* gp = gate + (size_t)(set * 9 + gidx) * 2048 + col0;
        f32x4 gv[2][2];
#pragma unroll
        for (int bj = 0; bj < 2; ++bj)
#pragma unroll
            for (int n = 0; n < 2; ++n) gv[bj][n] = *(const f32x4*)(gp + bj * HALF + n * 4) * scale;
        bf16_t* rp = res + ((size_t)u.pm * BM + r0) * RES_LD + col0;
        const float* bf = base_f32 ? panel_ptr(base_f32, base_f32, u.pm) + (size_t)r0 * RES_LD + col0 : nullptr;
        float* of = out_f32 ? panel_ptr(out_f32, out_f32, u.pm) + (size_t)r0 * RES_LD + col0 : nullptr;
        f32x4 cur[2][2], nxt[2][2];
        if (bf) {
#pragma unroll
            for (int bj = 0; bj < 2; ++bj)
#pragma unroll
                for (int n = 0; n < 2; ++n) cur[bj][n] = *(const f32x4*)(bf + bj * HALF + n * 4);
        } else {
#pragma unroll
            for (int bj = 0; bj < 2; ++bj) { float y[8]; unpack8(*(const u32x4*)(rp + bj * HALF), y); cur[bj][0] = (f32x4){y[0], y[1], y[2], y[3]}; cur[bj][1] = (f32x4){y[4], y[5], y[6], y[7]}; }
        }
#pragma unroll
        for (int g = 0; g < 8; ++g) { const int ai = g >> 2, m = g & 3; const size_t off = (size_t)(ai * HALF + m * 16) * RES_LD;
            if (g < 7) { const size_t offn = (size_t)(((g + 1) >> 2) * HALF + ((g + 1) & 3) * 16) * RES_LD;
                if (bf) {
#pragma unroll
                    for (int bj = 0; bj < 2; ++bj)
#pragma unroll
                        for (int n = 0; n < 2; ++n) nxt[bj][n] = *(const f32x4*)(bf + offn + bj * HALF + n * 4);
                } else {
#pragma unroll
                    for (int bj = 0; bj < 2; ++bj) { float y[8]; unpack8(*(const u32x4*)(rp + offn + bj * HALF), y); nxt[bj][0] = (f32x4){y[0], y[1], y[2], y[3]}; nxt[bj][1] = (f32x4){y[4], y[5], y[6], y[7]}; }
                } }
#pragma unroll
            for (int bj = 0; bj < 2; ++bj) { const f32x4 o0 = cur[bj][0] + gv[bj][0] * acc[ai][bj][m][0], o1 = cur[bj][1] + gv[bj][1] * acc[ai][bj][m][1];
                if (of) { *(f32x4*)(of + off + bj * HALF) = o0; *(f32x4*)(of + off + bj * HALF + 4) = o1; }
                else { u32x4 w; w.x = pk_h16(o0[0], o0[1]); w.y = pk_h16(o0[2], o0[3]); w.z = pk_h16(o1[0], o1[1]); w.w = pk_h16(o1[2], o1[3]); *(u32x4*)(rp + off + bj * HALF) = w; } }
            asm volatile("" ::: "memory");
#pragma unroll
            for (int bj = 0; bj < 2; ++bj)
#pragma unroll
                for (int n = 0; n < 2; ++n) cur[bj][n] = nxt[bj][n]; }
    }
};

struct CtxSplitOrder {
    static constexpr bool DYN = false;
    int nN, NS, Ks, nwg, G, c;
    unsigned* dyn; volatile PG8_LAS unsigned* slot;
    __device__ void init(int nN_, int NS_, int Ks_, int G_, int c_) { nN = nN_; NS = NS_; Ks = Ks_; nwg = 2 * nN * NS; G = G_; c = c_; dyn = nullptr; slot = nullptr; }
    __device__ bool next(int i, Unit& u) const {
        int L;
        if (dyn != nullptr && nwg <= G) {
            if (i != 0) return false;
            if (threadIdx.x == 0) *slot = __hip_atomic_fetch_add(dyn, 1u, __ATOMIC_RELAXED, __HIP_MEMORY_SCOPE_AGENT);
            __syncthreads(); L = (int)*slot;
        } else L = i * G + c;
        if (L >= nwg) return false;
        const int ks = L % NS, t = L / NS; u.pn = t % nN; u.pm = (t / nN) * PAN_PER_B; u.ks = ks; u.ko = ks * Ks; return true;
    }
    __device__ __forceinline__ void a_ready(const Unit&) const {}
    __device__ __forceinline__ void done(const Unit&) const {}
};
struct EpiCtxPartial {
    static constexpr bool PERM = false, AFTER_DRAIN = false;
    float* part  ; const float* gate  ; int gidx; float scale;
    __device__ __forceinline__ void operator()(const f32x4 (&acc)[2][2][4][2], const Unit& u, int wr, int wc, int fr, int fq) const {
        const int col0 = u.pn * BM + wc * 32 + 4 * fq, b = u.pm / PAN_PER_B;
        float* out = part + ((size_t)u.ks * 512 + (size_t)b * 256) * RES_LD;
        const float* gp = gate + (size_t)(2 * 9 + gidx) * 2048 + col0;
        f32x4 gv[2][2];
#pragma unroll
        for (int bj = 0; bj < 2; ++bj)
#pragma unroll
            for (int n = 0; n < 2; ++n) gv[bj][n] = *(const f32x4*)(gp + bj * HALF + n * 16) * scale;
#pragma unroll
        for (int ai = 0; ai < 2; ++ai)
#pragma unroll
            for (int m = 0; m < 4; ++m) { const size_t off = (size_t)(ai * HALF + wr * 64 + m * 16 + fr) * RES_LD + col0;
#pragma unroll
                for (int bj = 0; bj < 2; ++bj)
#pragma unroll
                    for (int n = 0; n < 2; ++n) *(f32x4*)(out + off + bj * HALF + n * 16) = gv[bj][n] * acc[ai][bj][m][n]; }
    }
};
template <class Epi, class Sched, bool ALIGN_EPI = false, bool SP2 = false>
__device__ __forceinline__ void gemm_phase(PG8_LAS unsigned char* lds, const Gemm g, const Sched& S, const Epi& E) {
    int tid_ = threadIdx.x; asm volatile("" : "+v"(tid_));
    const int tid = tid_, wid = __builtin_amdgcn_readfirstlane(tid >> 6), lane = tid & 63, wr = wid >> 2, wc = wid & 3, fr = lane & 15, fq = lane >> 4;
    const int K = g.K, ld = g.ld, nt = K / BK;
    unsigned voffA[2], voffB[2];
#pragma unroll
    for (int i = 0; i < 2; ++i) { int R, C; stage_rc(tid * 16 + i * 8192, R, C); const int Rb = Epi::PERM ? ((R & ~31) + perm32(R & 31)) : R;
        voffA[i] = (unsigned)(R * ld + C) * 2u; voffB[i] = (unsigned)(Rb * ld + C) * 2u; }
    const size_t kstep = (size_t)(BK * 2);
    const size_t hstep = (size_t)HALF * ld * 2;
    const size_t tstep = 2 * hstep;
    const unsigned ldsw = (unsigned)wid * 1024u;
    const int aoff = lds_byte(wr * 64 + fr, fq * 8), boff = lds_byte(wc * 32 + fr, fq * 8);
#define PG8_SA(b, h) (((b) * 2 + (h)) * HTB)
#define PG8_SB(b, h) ((4 + (b) * 2 + (h)) * HTB)
#define PG8_STAGE(bufoff, gbase, voff) do { _Pragma("unroll") for (int _i = 0; _i < 2; ++_i) \
        __builtin_amdgcn_global_load_lds((const unsigned*)((const char*)(gbase) + (voff)[_i]), (PG8_LAS unsigned*)(lds + (bufoff) + ldsw + _i * 8192), 16, 0, 0); } while (0)
#define PG8_LDA(dst, b, h) do { _Pragma("unroll") for (int m = 0; m < 4; ++m) _Pragma("unroll") for (int k = 0; k < 2; ++k) dst[m][k] = *(const PG8_LAS bf16x8*)(lds + PG8_SA(b, h) + aoff + m * 2048 + k * 1024); } while (0)
#define PG8_LDB(dst, b, h) do { _Pragma("unroll") for (int n = 0; n < 2; ++n) _Pragma("unroll") for (int k = 0; k < 2; ++k) dst[n][k] = *(const PG8_LAS bf16x8*)(lds + PG8_SB(b, h) + boff + n * 2048 + k * 1024); } while (0)
#define PG8_MMA(ai, bj, At, Bt) do { __builtin_amdgcn_s_setprio(1); _Pragma("unroll") for (int m = 0; m < 4; ++m) _Pragma("unroll") for (int n = 0; n < 2; ++n) _Pragma("unroll") for (int k = 0; k < 2; ++k) \
        acc[ai][bj][m][n] = __builtin_amdgcn_mfma_f32_16x16x32_bf16(Bt[n][k], At[m][k], acc[ai][bj][m][n], 0, 0, 0); __builtin_amdgcn_s_setprio(0); } while (0)
#define PG8_WAIT_V(n) asm volatile("s_waitcnt vmcnt(" #n ")" ::: "memory")
#define PG8_WAIT_L(n) asm volatile("s_waitcnt lgkmcnt(" #n ")" ::: "memory")
#define PG8_BAR __builtin_amdgcn_s_barrier()
#define PG8_SCHED __builtin_amdgcn_sched_barrier(0)
    Unit cur, nxt; int ui = 0;
    if (!S.next(0, cur)) return;
    f32x4 acc[2][2][4][2];
#pragma unroll
    for (int a = 0; a < 2; ++a)
#pragma unroll
        for (int b = 0; b < 2; ++b)
#pragma unroll
            for (int m = 0; m < 4; ++m)
#pragma unroll
                for (int n = 0; n < 2; ++n) acc[a][b][m][n] = (f32x4){0.f, 0.f, 0.f, 0.f};
    bf16x8 At[4][2], B0[2][2], B1[2][2];
    const char* cA = (const char*)g.A + (size_t)cur.pm * tstep + (size_t)cur.ko * 2; const char* cB = (const char*)g.Bt + (size_t)cur.pn * tstep + (size_t)cur.ko * 2;
    S.a_ready(cur);
    if constexpr (SP2) {
        PG8_STAGE(PG8_SB(0, 0), cB, voffB); PG8_STAGE(PG8_SB(0, 1), cB + hstep, voffB); PG8_STAGE(PG8_SA(0, 0), cA, voffA); PG8_STAGE(PG8_SA(0, 1), cA + hstep, voffA);
        if (wr == 1) PG8_BAR;
        PG8_WAIT_V(2); PG8_BAR;
        PG8_STAGE(PG8_SB(1, 0), cB + kstep, voffB); PG8_STAGE(PG8_SA(1, 0), cA + kstep, voffA); PG8_STAGE(PG8_SB(1, 1), cB + hstep + kstep, voffB);
        PG8_WAIT_V(6); PG8_BAR;
    } else {
        PG8_STAGE(PG8_SB(0, 0), cB, voffB); PG8_STAGE(PG8_SA(0, 0), cA, voffA); PG8_STAGE(PG8_SB(0, 1), cB + hstep, voffB); PG8_STAGE(PG8_SA(0, 1), cA + hstep, voffA);
        if (wr == 1) PG8_BAR;
        PG8_WAIT_V(4); PG8_BAR;
        PG8_STAGE(PG8_SB(1, 0), cB + kstep, voffB); PG8_STAGE(PG8_SA(1, 0), cA + kstep, voffA); PG8_STAGE(PG8_SB(1, 1), cB + hstep + kstep, voffB);
        PG8_WAIT_V(6); PG8_BAR;
    }
    for (;;) {
        bool has_next, pending = false;
        if constexpr (Sched::DYN) { if (S.is_dyn(ui + 1)) { pending = true; has_next = true; if (wid == 0) S.dyn_request(lane); } else has_next = S.next(ui + 1, nxt); }
        else has_next = S.next(ui + 1, nxt);
        const char* nA = cA; const char* nB = cB;
        if (has_next && !pending) { nA = (const char*)g.A + (size_t)nxt.pm * tstep + (size_t)nxt.ko * 2; nB = (const char*)g.Bt + (size_t)nxt.pn * tstep + (size_t)nxt.ko * 2; }
        for (int t = 0; t < nt; t += 2) {
            const bool last = (t == nt - 2);
            if constexpr (Sched::DYN) { if (last && pending) { pending = false; has_next = S.dyn_fetch(nxt);
                if (has_next) { nA = (const char*)g.A + (size_t)nxt.pm * tstep + (size_t)nxt.ko * 2; nB = (const char*)g.Bt + (size_t)nxt.pn * tstep + (size_t)nxt.ko * 2; } } }
            const char* a1 = cA + (size_t)(t + 1) * kstep;
            const char* a2 = last ? nA : cA + (size_t)(t + 2) * kstep; const char* b2 = last ? nB : cB + (size_t)(t + 2) * kstep;
            const char* a3 = a2 + kstep; const char* b3 = b2 + kstep;
            if (last && has_next) S.a_ready(nxt);
            if constexpr (SP2) {
            PG8_LDB(B0, 0, 0); PG8_LDB(B1, 0, 1); PG8_SCHED; PG8_LDA(At, 0, 0); PG8_STAGE(PG8_SA(1, 1), a1 + hstep, voffA);
            PG8_WAIT_V(8); PG8_WAIT_L(0); PG8_BAR; PG8_MMA(0, 0, At, B0); PG8_MMA(0, 1, At, B1); PG8_BAR; PG8_SCHED;
            PG8_LDA(At, 0, 1); PG8_STAGE(PG8_SB(0, 0), b2, voffB); PG8_STAGE(PG8_SB(0, 1), b2 + hstep, voffB); PG8_STAGE(PG8_SA(0, 0), a2, voffA);
            PG8_WAIT_V(8); PG8_WAIT_L(0); PG8_BAR; PG8_MMA(1, 0, At, B0); PG8_MMA(1, 1, At, B1); PG8_BAR; PG8_SCHED;
            PG8_LDB(B0, 1, 0); PG8_LDB(B1, 1, 1); PG8_SCHED; PG8_LDA(At, 1, 0); PG8_STAGE(PG8_SA(0, 1), a2 + hstep, voffA);
            PG8_WAIT_V(8); PG8_WAIT_L(0); PG8_BAR; PG8_MMA(0, 0, At, B0); PG8_MMA(0, 1, At, B1); PG8_BAR; PG8_SCHED;
            PG8_LDA(At, 1, 1); PG8_STAGE(PG8_SB(1, 0), b3, voffB); PG8_STAGE(PG8_SB(1, 1), b3 + hstep, voffB); PG8_STAGE(PG8_SA(1, 0), a3, voffA);
            PG8_WAIT_V(8); PG8_WAIT_L(0); PG8_BAR; PG8_MMA(1, 0, At, B0); PG8_MMA(1, 1, At, B1); PG8_BAR; PG8_SCHED;
            } else {
            PG8_LDB(B0, 0, 0); PG8_SCHED; PG8_LDA(At, 0, 0); PG8_STAGE(PG8_SA(1, 1), a1 + hstep, voffA);
            PG8_WAIT_L(8); PG8_BAR; PG8_WAIT_L(0); PG8_MMA(0, 0, At, B0); PG8_BAR; PG8_SCHED;
            PG8_LDB(B1, 0, 1); PG8_STAGE(PG8_SB(0, 0), b2, voffB);
            PG8_BAR; PG8_WAIT_L(0); PG8_MMA(0, 1, At, B1); PG8_BAR;
            PG8_LDA(At, 0, 1); PG8_STAGE(PG8_SA(0, 0), a2, voffA);
            PG8_BAR; PG8_WAIT_L(0); PG8_MMA(1, 0, At, B0); PG8_BAR; PG8_SCHED;
            PG8_STAGE(PG8_SB(0, 1), b2 + hstep, voffB);
            PG8_WAIT_V(6); PG8_BAR; PG8_MMA(1, 1, At, B1); PG8_BAR;
            PG8_LDB(B0, 1, 0); PG8_SCHED; PG8_LDA(At, 1, 0); PG8_STAGE(PG8_SA(0, 1), a2 + hstep, voffA);
            PG8_WAIT_L(8); PG8_BAR; PG8_WAIT_L(0); PG8_MMA(0, 0, At, B0); PG8_BAR; PG8_SCHED;
            PG8_LDB(B1, 1, 1); PG8_STAGE(PG8_SB(1, 0), b3, voffB);
            PG8_BAR; PG8_WAIT_L(0); PG8_MMA(0, 1, At, B1); PG8_BAR;
            PG8_LDA(At, 1, 1); PG8_STAGE(PG8_SA(1, 0), a3, voffA);
            PG8_BAR; PG8_WAIT_L(0); PG8_MMA(1, 0, At, B0); PG8_BAR; PG8_SCHED;
            PG8_STAGE(PG8_SB(1, 1), b3 + hstep, voffB);
            PG8_WAIT_V(6); PG8_BAR; PG8_MMA(1, 1, At, B1); PG8_BAR;
            }
        }
        if constexpr (ALIGN_EPI) { if (wr == 0) PG8_BAR; }
        if constexpr (!Epi::AFTER_DRAIN) { E(acc, cur, wr, wc, fr, fq); S.done(cur); }
        if (!has_next) break;
#pragma unroll
        for (int a = 0; a < 2; ++a)
#pragma unroll
            for (int b = 0; b < 2; ++b)
#pragma unroll
                for (int m = 0; m < 4; ++m)
#pragma unroll
                    for (int n = 0; n < 2; ++n) acc[a][b][m][n] = (f32x4){0.f, 0.f, 0.f, 0.f};
        cur = nxt; cA = nA; cB = nB; ++ui;
        if constexpr (ALIGN_EPI) { if (wr == 1) PG8_BAR; }
    }
    PG8_WAIT_V(0);
    if constexpr (!ALIGN_EPI) { if (wr == 0) PG8_BAR; }
    PG8_BAR;
    if constexpr (Epi::AFTER_DRAIN) { E.fused(acc, cur, wr, wc, fr, fq, lds, wid, lane); S.done(cur); }
#undef PG8_SA
#undef PG8_SB
#undef PG8_STAGE
#undef PG8_LDA
#undef PG8_LDB
#undef PG8_MMA
#undef PG8_WAIT_V
#undef PG8_WAIT_L
#undef PG8_BAR
#undef PG8_SCHED
}
}
#define GAS __attribute__((address_space(1)))
#define LAS __attribute__((address_space(3)))
typedef unsigned short bf16;
typedef unsigned v4u __attribute__((ext_vector_type(4)));
typedef float f32x4 __attribute__((ext_vector_type(4)));
typedef short bf16x8 __attribute__((ext_vector_type(8)));
typedef GAS unsigned gu32;
typedef GAS unsigned long long gu64;
#define RLX_AGENT __ATOMIC_RELAXED, __HIP_MEMORY_SCOPE_AGENT
#define LDS_WAIT() asm volatile("s_waitcnt lgkmcnt(0)" ::: "memory")
#define VM_WAIT() asm volatile("s_waitcnt vmcnt(0)" ::: "memory")
__device__ __forceinline__ unsigned long long rt() { return __builtin_amdgcn_s_memrealtime(); }
__device__ __forceinline__ unsigned f2bf(float f) { unsigned u = __builtin_bit_cast(unsigned, f); return (u + 0x7fffu + ((u >> 16) & 1u)) >> 16; }
__device__ __forceinline__ unsigned pk2(float lo, float hi) { return f2bf(lo) | (f2bf(hi) << 16); }

#define XB_TMO      128
#define XB_XCNT(j)  (256  + 64 * (j))
#define XB_XSUB(j)  (1280 + 64 * (j))
#define XB_XGEN(j)  (2304 + 64 * (j))
#define XB_TOP      3328
#define XB_TOPGEN   3392
#define XCD_BAR_WORDS 3456
#define XB_SPIN_CAP (1u << 18)

__device__ __forceinline__ unsigned xb_ld(unsigned* p)              { return __hip_atomic_load(p, __ATOMIC_RELAXED, __HIP_MEMORY_SCOPE_AGENT); }
__device__ __forceinline__ unsigned xb_add(unsigned* p, unsigned v) { return __hip_atomic_fetch_add(p, v, __ATOMIC_RELAXED, __HIP_MEMORY_SCOPE_AGENT); }
__device__ __forceinline__ unsigned xb_xcc_id() { return (unsigned)__builtin_amdgcn_s_getreg((3 << 11) | 20) & 0xFu; }
#define XB_SPIN(cond, bar) do { unsigned _sp = 0; while (cond) { __builtin_amdgcn_s_sleep(1); \
    if ((++_sp & 255u) == 0u) { if (xb_ld(&(bar)[XB_TMO])) break; if (_sp > XB_SPIN_CAP) { atomicAdd(&(bar)[XB_TMO], 1u); break; } } } } while (0)

struct XcdBarrier {
    unsigned* bar; unsigned x;
    volatile LAS unsigned* st;
};

__device__ __forceinline__ XcdBarrier xcd_barrier_post(unsigned* bar, volatile LAS unsigned* st) {
    XcdBarrier b; b.bar = bar; b.x = xb_xcc_id(); b.st = st;
    if (threadIdx.x == 0) (void)xb_add(&bar[XB_XCNT(b.x)], 1u);
    return b;
}
__device__ __forceinline__ void xcd_barrier_complete(unsigned* bar, unsigned x, unsigned& nloc, unsigned& nx) {
    const unsigned G = gridDim.x * gridDim.y * gridDim.z;
    unsigned sum, cnt, mine, sp = 0u;
    for (;;) {
        sum = 0u; cnt = 0u; mine = 0u;
#pragma unroll
        for (unsigned j = 0; j < 16; ++j) { const unsigned c = xb_ld(&bar[XB_XCNT(j)]); sum += c; cnt += (c > 0u) ? 1u : 0u; mine = (j == x) ? c : mine; }
        if (sum == G) break;
        __builtin_amdgcn_s_sleep(1);
        if ((++sp & 255u) == 0u) { if (xb_ld(&bar[XB_TMO])) break; if (sp > XB_SPIN_CAP) { atomicAdd(&bar[XB_TMO], 1u); break; } }
    }
    nloc = mine > 0u ? mine : 1u; nx = cnt > 0u ? cnt : 1u;
}

__device__ __forceinline__ void xcd_barrier(const XcdBarrier& b) {
    asm volatile("s_waitcnt vmcnt(0)" ::: "memory");
    __syncthreads();
    if (threadIdx.x == 0) {
        unsigned* bar = b.bar;
        __builtin_amdgcn_s_waitcnt(0);
        unsigned nloc = b.st[0], nx = b.st[1];
        if (nloc == 0u) { xcd_barrier_complete(bar, b.x, nloc, nx); b.st[0] = nloc; b.st[1] = nx; }
        const unsigned old = xb_add(&bar[XB_XSUB(b.x)], 1u);
        const unsigned gen = old / nloc;
        if (old + 1u == (gen + 1u) * nloc) {
            __builtin_amdgcn_fence(__ATOMIC_RELEASE, "agent");
            asm volatile("s_waitcnt vmcnt(0)" ::: "memory");
            const unsigned og = xb_add(&bar[XB_TOP], 1u);
            const unsigned tg = og / nx;
            if (og + 1u == (tg + 1u) * nx) xb_add(&bar[XB_TOPGEN], 1u);
            else XB_SPIN(xb_ld(&bar[XB_TOPGEN]) == tg, bar);
            __builtin_amdgcn_fence(__ATOMIC_ACQUIRE, "agent");
            xb_add(&bar[XB_XGEN(b.x)], 1u);
            asm volatile("s_waitcnt vmcnt(0)" ::: "memory");
        } else {
            XB_SPIN(xb_ld(&bar[XB_XGEN(b.x)]) == gen, bar);
            __builtin_amdgcn_fence(__ATOMIC_ACQUIRE, "agent");
            asm volatile("s_waitcnt vmcnt(0)" ::: "memory");
        }
    }
    __syncthreads();
}

constexpr int NWAVES = 8;
constexpr int DM = 2048, NB = 2, SEQ = 16384, CTXL = 256, DEPTH = 2, DFF = 5632, NMOD = 9;
constexpr int TOKB = SEQ + CTXL;
constexpr int M_ALL = NB * TOKB;
constexpr int NPAN = M_ALL / 256;
constexpr int NGU = 2 * DFF;
constexpr int NZ = 4352;
constexpr int NW_IN = 4128;
constexpr int CHB = TOKB / 128;
constexpr int NCH = NB * CHB;
constexpr int MODW = NMOD * DM;
constexpr float EPSN = 1e-6f;
constexpr int ZQ = 0, ZK = 1024, ZV = 1280, ZGQ = 1536, ZGK = 1792, ZGV = 2048, ZGR = 2560, ZMU = 3072, ZMV = 3584, ZLR = 4096;
constexpr int MXA = 0, MXG = 1024, MXM = 1536;

constexpr size_t MiB = 1u << 20;
constexpr size_t WS_CTL = 0, CTL_ZERO_BYTES = 64 * 1024;
constexpr size_t WS_MODP = 1 * MiB;
constexpr size_t WS_MOD = 5 * MiB;
constexpr size_t WS_ROPE = 6 * MiB;
constexpr size_t WS_CTXRES = 8 * MiB;
constexpr size_t WS_W = 16 * MiB;
constexpr size_t W_GU1 = 0, W_D1 = 44 * MiB, W_GU2 = 66 * MiB, W_D2 = 110 * MiB, W_IN = 132 * MiB, W_OUT = 149 * MiB, W_LAYER = 157 * MiB;
constexpr size_t WS_RES = 330 * MiB;
constexpr size_t WS_MIX = 460 * MiB;
constexpr size_t WS_H = 590 * MiB;
constexpr size_t WS_Z = WS_H;
constexpr size_t WS_UT = WS_H + 277 * MiB;
constexpr size_t WS_ST = 948 * MiB;
constexpr size_t WS_DV = 981 * MiB;
constexpr size_t WS_QG = 982 * MiB;
constexpr size_t WS_PART = 1015 * MiB;
constexpr size_t WS_END = 1031 * MiB;
constexpr int CTX_NS = 4;
static_assert(WS_UT + (size_t)2080 * 8192 * 4 <= WS_H + (size_t)M_ALL * DFF * 2 + MiB, "UT inside the H overlay (+slack below WS_ST)");
static_assert(WS_H + (size_t)M_ALL * DFF * 2 <= WS_ST && WS_UT + (size_t)2080 * 8192 * 4 <= WS_ST, "d_ws map");
constexpr int CW_TMO = 0, CW_BAR = 4096;

constexpr int RING_OFF = 0, RING_BYTES = 139264;
constexpr int LDSCTL_OFF = RING_BYTES, MISC_OFF = LDSCTL_OFF + 320;
constexpr int LDS_BYTES = 147456;

typedef short s16x4 __attribute__((ext_vector_type(4)));
typedef float f32x16 __attribute__((ext_vector_type(16)));
typedef float f32x8 __attribute__((ext_vector_type(8)));
typedef unsigned u32x2 __attribute__((ext_vector_type(2)));
typedef unsigned u32x4 __attribute__((ext_vector_type(4)));
typedef float f32x2_t __attribute__((ext_vector_type(2)));
typedef _Float16 h16x2_t __attribute__((ext_vector_type(2)));
__device__ __forceinline__ unsigned pkh(float lo, float hi) { const _Float16 a = (_Float16)lo, b = (_Float16)hi; return (unsigned)__builtin_bit_cast(unsigned short, a) | ((unsigned)__builtin_bit_cast(unsigned short, b) << 16); }
__device__ __forceinline__ float hlo(unsigned w) { return (float)__builtin_bit_cast(h16x2_t, w)[0]; }
__device__ __forceinline__ float hhi(unsigned w) { return (float)__builtin_bit_cast(h16x2_t, w)[1]; }
__device__ __forceinline__ float bf2f(unsigned short x) { return __uint_as_float((unsigned)x << 16); }
__device__ __forceinline__ float bflo(unsigned w) { return __uint_as_float(w << 16); }
__device__ __forceinline__ float bfhi(unsigned w) { return __uint_as_float(w & 0xffff0000u); }
typedef __bf16 bf16x2_t __attribute__((ext_vector_type(2)));
__device__ __forceinline__ unsigned cvtpk(float lo, float hi) { f32x2_t v = {lo, hi}; bf16x2_t b = __builtin_convertvector(v, bf16x2_t); return __builtin_bit_cast(unsigned, b); }
__device__ __forceinline__ float wave_sum(float v) {
#pragma unroll
    for (int o = 1; o < 64; o <<= 1) v += __shfl_xor(v, o);
    return v;
}
__device__ __forceinline__ int crow(int r, int hi) { return (r & 3) + 8 * (r >> 2) + 4 * hi; }
__device__ __forceinline__ float silu_acc(float x) { return x / (1.0f + __expf(-x)); }
__device__ __forceinline__ float silu_rcp(float x) { return x * __builtin_amdgcn_rcpf(1.0f + __builtin_amdgcn_exp2f(-1.4426950408889634f * x)); }

struct Frame {
    LAS unsigned char* lds;
    volatile LAS unsigned* MISC;
    gu32* ctl;
    int tid, lane, wave, vcu, G;
};

__device__ __forceinline__ void p0_transpose_item(const float* W, int K, int N, bf16* WT, int k0, int n0, int orow0, LAS float* scr, int lane) {
#pragma unroll 8
    for (int i = 0; i < 32; ++i) { const int kk = 2 * i + (lane >> 5); scr[kk * 33 + (lane & 31)] = W[(size_t)(k0 + kk) * N + n0 + (lane & 31)]; }
    LDS_WAIT(); asm volatile("" ::: "memory");
    const int c = lane & 7;
#pragma unroll
    for (int j = 0; j < 4; ++j) { const int n = (lane >> 3) + 8 * j; const LAS float* s = scr + (8 * c) * 33 + n;
        v4u o; o.x = pk2(s[0 * 33], s[1 * 33]); o.y = pk2(s[2 * 33], s[3 * 33]); o.z = pk2(s[4 * 33], s[5 * 33]); o.w = pk2(s[6 * 33], s[7 * 33]);
        *(GAS v4u*)(WT + (size_t)(orow0 + n) * K + k0 + 8 * c) = o; }
    LDS_WAIT(); asm volatile("" ::: "memory");
}
__device__ __forceinline__ int gu_row(int n0) { return n0 < DFF ? (n0 / 128) * 256 + (n0 % 128) : ((n0 - DFF) / 128) * 256 + 128 + ((n0 - DFF) % 128); }
__device__ __forceinline__ int win_row(int n0) { return n0 < 3072 ? n0 : (n0 < 3104 ? ZLR + (n0 - 3072) : (n0 < 3616 ? ZMU + (n0 - 3104) : ZMV + (n0 - 3616))); }

struct Args { const float* in[21]; float* out; unsigned char* ws; int ph_lo, ph_hi; };

__device__ __forceinline__ void p0_prologue(Frame& F, const Args& a) {
    LAS float* scr = (LAS float*)(F.lds + RING_OFF + F.wave * 16384);
    const int gw = F.vcu * NWAVES + F.wave, NGW = F.G * NWAVES, lane = F.lane;
    unsigned char* ws = a.ws;
    constexpr int I_GU = (DM / 64) * (NGU / 32), I_D = (DFF / 64) * (DM / 32), I_IN = (DM / 64) * (NW_IN / 32), I_OUT = (DM / 64) * (DM / 32);
    constexpr int I_LAYER = 2 * I_GU + 2 * I_D + I_IN + I_OUT;
    for (int it = gw; it < DEPTH * I_LAYER; it += NGW) {
        const int l = it / I_LAYER; int r = it - l * I_LAYER;
        unsigned char* wl = ws + WS_W + (size_t)l * W_LAYER;
        if (r < 2 * I_GU) { const int f = r / I_GU; r -= f * I_GU; const int nblk = NGU / 32, kb = r / nblk, nb = r % nblk;
            p0_transpose_item(a.in[f ? 9 : 7] + (size_t)l * DM * NGU, DM, NGU, (bf16*)(wl + (f ? W_GU2 : W_GU1)), 64 * kb, 32 * nb, gu_row(32 * nb), scr, lane); continue; }
        r -= 2 * I_GU;
        if (r < 2 * I_D) { const int f = r / I_D; r -= f * I_D; const int nblk = DM / 32, kb = r / nblk, nb = r % nblk;
            p0_transpose_item(a.in[f ? 10 : 8] + (size_t)l * DFF * DM, DFF, DM, (bf16*)(wl + (f ? W_D2 : W_D1)), 64 * kb, 32 * nb, 32 * nb, scr, lane); continue; }
        r -= 2 * I_D;
        if (r < I_IN) { const int nblk = NW_IN / 32, kb = r / nblk, nb = r % nblk;
            p0_transpose_item(a.in[11] + (size_t)l * DM * NW_IN, DM, NW_IN, (bf16*)(wl + W_IN), 64 * kb, 32 * nb, win_row(32 * nb), scr, lane); continue; }
        r -= I_IN;
        { const int nblk = DM / 32, kb = r / nblk, nb = r % nblk;
            p0_transpose_item(a.in[12] + (size_t)l * DM * DM, DM, DM, (bf16*)(wl + W_OUT), 64 * kb, 32 * nb, 32 * nb, scr, lane); }
    }
    {
        const int per_layer = (NZ - NW_IN) * DM / 8;
        for (int i = gw * 64 + lane; i < DEPTH * per_layer; i += NGW * 64) { const int l = i / per_layer, r = i - l * per_layer;
            *(GAS v4u*)(ws + WS_W + (size_t)l * W_LAYER + W_IN + (size_t)NW_IN * DM * 2 + (size_t)r * 16) = (v4u){0u, 0u, 0u, 0u}; }
    }
    {
        const float* c = a.in[1]; const float* cctx = a.in[3]; const float* mw = a.in[4];
        float* modp = (float*)(ws + WS_MODP);
        LAS float* sv = scr;
        for (int it = gw; it < DEPTH * 8 * 72; it += NGW) {
            const int l = it / (8 * 72), r = it % (8 * 72), ks = r / 72, nb = r % 72, k0 = ks * 256, n = nb * 256 + lane * 4;
#pragma unroll
            for (int j = 0; j < 4; ++j) { const int k = k0 + lane + 64 * j;
                sv[0 * 256 + lane + 64 * j] = silu_acc(c[k]); sv[1 * 256 + lane + 64 * j] = silu_acc(c[DM + k]); sv[2 * 256 + lane + 64 * j] = silu_acc(cctx[k]); }
            LDS_WAIT(); asm volatile("" ::: "memory");
            f32x4 a0 = {0.f, 0.f, 0.f, 0.f}, a1 = a0, a2 = a0;
            const float* wp = mw + ((size_t)l * DM + k0) * MODW + n;
#pragma unroll 8
            for (int k = 0; k < 256; ++k) { const f32x4 w = *(const f32x4*)(wp + (size_t)k * MODW); a0 += w * sv[k]; a1 += w * sv[256 + k]; a2 += w * sv[512 + k]; }
            float* op = modp + ((size_t)(l * 8 + ks) * 3) * MODW + n;
            *(f32x4*)(op) = a0; *(f32x4*)(op + MODW) = a1; *(f32x4*)(op + 2 * MODW) = a2;
            LDS_WAIT(); asm volatile("" ::: "memory");
        }
    }
    {
        float* rc = (float*)(ws + WS_ROPE); float* rs = rc + 256 * 32;
        for (int i = gw * 64 + lane; i < 256 * 32; i += NGW * 64) { const int p = i >> 5, f = i & 31;
            const double inv = pow(10000.0, -(double)f / 32.0); const double ang = (double)p * inv;
            rc[i] = (float)cos(ang); rs[i] = (float)sin(ang); }
    }
}
__device__ __forceinline__ void p1_modreduce(Frame& F, const Args& a) {
    const float* modp = (const float*)(a.ws + WS_MODP); float* mod = (float*)(a.ws + WS_MOD); const float* mb = a.in[5];
    for (int i = F.vcu * 512 + F.tid; i < DEPTH * 3 * MODW; i += F.G * 512) { const int l = i / (3 * MODW), r = i % (3 * MODW), set = r / MODW, n = r % MODW;
        float s = mb[l * MODW + n];
#pragma unroll
        for (int ks = 0; ks < 8; ++ks) s += modp[((size_t)(l * 8 + ks) * 3 + set) * MODW + n];
        mod[i] = s; }
}

struct NRow { u32x4 h[4]; f32x4 f[8]; const float* fsrc; bool isf; };
template <bool LAZYF>
__device__ __forceinline__ void norm_load(NRow& r, const float* src_lat, const float* src_ctx, const bf16* RES, int row, int lane) {
    const int b = row / TOKB, j = row - b * TOKB; const bool isctx = j < CTXL;
    const float* src = isctx ? (src_ctx ? src_ctx + ((size_t)b * CTXL + j) * DM : (const float*)nullptr) : (src_lat ? src_lat + ((size_t)b * SEQ + (j - CTXL)) * DM : (const float*)nullptr);
    r.isf = src != nullptr; r.fsrc = src;
    if (src) { if constexpr (!LAZYF) {
#pragma unroll
        for (int q = 0; q < 4; ++q) { r.f[2 * q] = *(const GAS f32x4*)(src + (q * 64 + lane) * 8); r.f[2 * q + 1] = *(const GAS f32x4*)(src + (q * 64 + lane) * 8 + 4); } } }
    else {
#pragma unroll
        for (int q = 0; q < 4; ++q) r.h[q] = __builtin_nontemporal_load((const GAS u32x4*)(RES + (size_t)row * DM + (q * 64 + lane) * 8)); }
}
template <bool LAZYF = false>
__device__ __forceinline__ void norm_phase(Frame& F, const float* src_lat, const float* src_ctx, bf16* RES, const float* g, const float* mod  , int sub, bf16* XN, int skip_ctx, const float* part) {
    const int gw = F.vcu * NWAVES + F.wave, NGW = F.G * NWAVES, lane = F.lane;
    int cur = -1; f32x4 A[8], B[8]; NRow rc, rn;
    int row = gw;
    if (skip_ctx) while (row < M_ALL && (row % TOKB) < CTXL) row += NGW;
    if (row < M_ALL) norm_load<LAZYF>(rc, src_lat, src_ctx, RES, row, lane);
    while (row < M_ALL) {
        int nrow = row + NGW;
        if (skip_ctx) while (nrow < M_ALL && (nrow % TOKB) < CTXL) nrow += NGW;
        if (nrow < M_ALL) norm_load<LAZYF>(rn, src_lat, src_ctx, RES, nrow, lane);
        const int b = row / TOKB, j = row - b * TOKB; const bool isctx = j < CTXL;
        const int set = isctx ? 2 : b;
        if (set != cur) { cur = set; const float* sh = mod + (size_t)(set * 9 + 3 * sub) * DM; const float* sc = sh + DM;
#pragma unroll
            for (int q = 0; q < 8; ++q) { const int c = ((q >> 1) * 64 + lane) * 8 + (q & 1) * 4; const f32x4 gg = *(const f32x4*)(g + c), ss = *(const f32x4*)(sc + c); A[q] = gg * (ss + 1.0f); B[q] = *(const f32x4*)(sh + c); } }
        f32x4 v[8];
        if (rc.isf) {
            if constexpr (LAZYF) {
#pragma unroll
                for (int q = 0; q < 4; ++q) { v[2 * q] = *(const GAS f32x4*)(rc.fsrc + (q * 64 + lane) * 8); v[2 * q + 1] = *(const GAS f32x4*)(rc.fsrc + (q * 64 + lane) * 8 + 4); }
            } else {
#pragma unroll
            for (int q = 0; q < 8; ++q) v[q] = rc.f[q]; }
        } else {
#pragma unroll
            for (int q = 0; q < 4; ++q) { const u32x4 w = rc.h[q]; v[2 * q] = (f32x4){hlo(w.x), hhi(w.x), hlo(w.y), hhi(w.y)}; v[2 * q + 1] = (f32x4){hlo(w.z), hhi(w.z), hlo(w.w), hhi(w.w)}; }
        }
        if (isctx && part) { const size_t ro = ((size_t)b * CTXL + j) * DM;
#pragma unroll
            for (int ks = 0; ks < CTX_NS; ++ks)
#pragma unroll
                for (int q = 0; q < 8; ++q) v[q] += *(const GAS f32x4*)(part + (size_t)ks * 512 * DM + ro + ((q >> 1) * 64 + lane) * 8 + (q & 1) * 4);
#pragma unroll
            for (int q = 0; q < 4; ++q) { u32x4 w; w.x = pkh(v[2 * q].x, v[2 * q].y); w.y = pkh(v[2 * q].z, v[2 * q].w); w.z = pkh(v[2 * q + 1].x, v[2 * q + 1].y); w.w = pkh(v[2 * q + 1].z, v[2 * q + 1].w);
                *(GAS u32x4*)(RES + (size_t)row * DM + (q * 64 + lane) * 8) = w;
                v[2 * q] = (f32x4){hlo(w.x), hhi(w.x), hlo(w.y), hhi(w.y)}; v[2 * q + 1] = (f32x4){hlo(w.z), hhi(w.z), hlo(w.w), hhi(w.w)}; } }
        float s = 0.f;
#pragma unroll
        for (int q = 0; q < 8; ++q) s += (v[q].x * v[q].x + v[q].y * v[q].y) + (v[q].z * v[q].z + v[q].w * v[q].w);
        const float rstd = 1.0f / sqrtf(wave_sum(s) * (1.0f / DM) + EPSN);
        bf16* orow = XN + (size_t)row * DM;
#pragma unroll
        for (int q = 0; q < 4; ++q) { const f32x4 o0 = v[2 * q] * rstd * A[2 * q] + B[2 * q], o1 = v[2 * q + 1] * rstd * A[2 * q + 1] + B[2 * q + 1];
            u32x4 w; w.x = cvtpk(o0.x, o0.y); w.y = cvtpk(o0.z, o0.w); w.z = cvtpk(o1.x, o1.y); w.w = cvtpk(o1.z, o1.w); *(GAS u32x4*)(orow + (q * 64 + lane) * 8) = w; }
        rc = rn; row = nrow;
    }
}
__device__ __forceinline__ void final_norm_phase(Frame& F, const bf16* RES, float* out, const float* g) {
    const int gw = F.vcu * NWAVES + F.wave, NGW = F.G * NWAVES, lane = F.lane;
    f32x4 A[8];
#pragma unroll
    for (int q = 0; q < 8; ++q) A[q] = *(const f32x4*)(g + ((q >> 1) * 64 + lane) * 8 + (q & 1) * 4);
    u32x4 hc[4], hn[4];
#define FN_LOAD(H, R) do { const int b_ = (R) / SEQ, t_ = (R) - b_ * SEQ; const bf16* s_ = RES + ((size_t)b_ * TOKB + CTXL + t_) * DM; \
        _Pragma("unroll") for (int q = 0; q < 4; ++q) H[q] = __builtin_nontemporal_load((const GAS u32x4*)(s_ + (q * 64 + lane) * 8)); } while (0)
    int row = gw;
    if (row < NB * SEQ) FN_LOAD(hc, row);
    while (row < NB * SEQ) {
        const int nrow = row + NGW;
        if (nrow < NB * SEQ) FN_LOAD(hn, nrow);
        f32x4 v[8]; float s = 0.f;
#pragma unroll
        for (int q = 0; q < 4; ++q) { const u32x4 w = hc[q]; v[2 * q] = (f32x4){hlo(w.x), hhi(w.x), hlo(w.y), hhi(w.y)}; v[2 * q + 1] = (f32x4){hlo(w.z), hhi(w.z), hlo(w.w), hhi(w.w)}; }
#pragma unroll
        for (int q = 0; q < 8; ++q) s += (v[q].x * v[q].x + v[q].y * v[q].y) + (v[q].z * v[q].z + v[q].w * v[q].w);
        const float rstd = 1.0f / sqrtf(wave_sum(s) * (1.0f / DM) + EPSN);
        float* p = out + (size_t)row * DM;
#pragma unroll
        for (int q = 0; q < 4; ++q) { *(GAS f32x4*)(p + (q * 64 + lane) * 8) = v[2 * q] * rstd * A[2 * q]; *(GAS f32x4*)(p + (q * 64 + lane) * 8 + 4) = v[2 * q + 1] * rstd * A[2 * q + 1]; }
#pragma unroll
        for (int q = 0; q < 4; ++q) hc[q] = hn[q];
        row = nrow;
    }
#undef FN_LOAD
}

typedef short v4i16_t __attribute__((ext_vector_type(4)));
__device__ __forceinline__ s16x4 vtr(LAS const unsigned char* p) { return __builtin_bit_cast(s16x4, __builtin_amdgcn_ds_read_tr16_b64_v4i16((LAS v4i16_t*)p)); }
template <int KSTEPS>
__device__ __forceinline__ void mm32_tr(f32x16& acc, LAS const unsigned char* At, int sa, int m0, LAS const unsigned char* Bn, int sb, int n0, int lane) {
    const int h = lane >> 5, blk = (lane >> 4) & 1, q = (lane & 15) >> 2, p = lane & 3, r = lane & 31;
    LAS const unsigned char* ap = At + (8 * h + q) * sa + (m0 + 16 * blk + 4 * p) * 2;
    LAS const unsigned char* bp = Bn + (n0 + r) * sb + 16 * h;
#pragma unroll
    for (int ks = 0; ks < KSTEPS; ++ks) {
        const s16x4 lo = vtr(ap + (16 * ks) * sa), hi4 = vtr(ap + (16 * ks + 4) * sa);
        const bf16x8 af = (bf16x8){lo[0], lo[1], lo[2], lo[3], hi4[0], hi4[1], hi4[2], hi4[3]};
        const bf16x8 bfv = *(LAS const bf16x8*)(bp + 32 * ks);
        acc = __builtin_amdgcn_mfma_f32_32x32x16_bf16(af, bfv, acc, 0, 0, 0);
    }
}
template <int KSTEPS>
__device__ __forceinline__ void mm32_rr(f32x16& acc, LAS const unsigned char* Am, int sa, int m0, LAS const unsigned char* Bn, int sb, int n0, int lane) {
    const int h = lane >> 5, r = lane & 31;
    LAS const unsigned char* ap = Am + (m0 + r) * sa + 16 * h;
    LAS const unsigned char* bp = Bn + (n0 + r) * sb + 16 * h;
#pragma unroll
    for (int ks = 0; ks < KSTEPS; ++ks) {
        const bf16x8 af = *(LAS const bf16x8*)(ap + 32 * ks);
        const bf16x8 bfv = *(LAS const bf16x8*)(bp + 32 * ks);
        acc = __builtin_amdgcn_mfma_f32_32x32x16_bf16(af, bfv, acc, 0, 0, 0);
    }
}

__device__ __forceinline__ void qknorm_row(bf16* Z, int row, const float* qkg  , const float* rc, const float* rs, int lane) {
    const int b = row / TOKB, j = row - b * TOKB; const bool isctx = j < CTXL; const int t = j - CTXL, prow = t >> 6, pcol = t & 63;
    bf16* zr = Z + (size_t)row * NZ;
    v4u wv[3];
#pragma unroll
    for (int pass = 0; pass < 3; ++pass) { const int ch = lane + 64 * pass; wv[pass] = (v4u){0u, 0u, 0u, 0u}; if (ch < 160) wv[pass] = *(const GAS v4u*)(zr + ch * 8); }
    const int j16 = lane & 15; const int pos = isctx ? 0 : ((j16 & 8) ? pcol : prow); const int f0 = 8 * (j16 & 3);
    const f32x4 c0 = *(const f32x4*)(rc + pos * 32 + f0), c1 = *(const f32x4*)(rc + pos * 32 + f0 + 4), s0 = *(const f32x4*)(rs + pos * 32 + f0), s1 = *(const f32x4*)(rs + pos * 32 + f0 + 4);
    const float cs[8] = {c0.x, c0.y, c0.z, c0.w, c1.x, c1.y, c1.z, c1.w}, sn[8] = {s0.x, s0.y, s0.z, s0.w, s1.x, s1.y, s1.z, s1.w};
    const bool second = (j16 & 4) != 0;
#pragma unroll
    for (int pass = 0; pass < 3; ++pass) {
        const int ch = lane + 64 * pass; const bool act = ch < 160;
        const int head = ch >> 4;
        const v4u w = wv[pass];
        float y[8] = {bflo(w.x), bfhi(w.x), bflo(w.y), bfhi(w.y), bflo(w.z), bfhi(w.z), bflo(w.w), bfhi(w.w)};
        float ss = 0.f;
#pragma unroll
        for (int e = 0; e < 8; ++e) ss += y[e] * y[e];
        ss += __shfl_xor(ss, 1); ss += __shfl_xor(ss, 2); ss += __shfl_xor(ss, 4); ss += __shfl_xor(ss, 8);
        const float rstd = 1.0f / sqrtf(ss * (1.0f / 128.0f) + EPSN);
        const float* gp = qkg + (head < 8 ? 0 : 128) + j16 * 8;
        const f32x4 g0 = *(const f32x4*)gp, g1 = *(const f32x4*)(gp + 4);
        const float gg[8] = {g0.x, g0.y, g0.z, g0.w, g1.x, g1.y, g1.z, g1.w};
#pragma unroll
        for (int e = 0; e < 8; ++e) y[e] = y[e] * rstd * gg[e];
        float pr[8];
#pragma unroll
        for (int e = 0; e < 8; ++e) pr[e] = __shfl_xor(y[e], 4);
        if (!isctx) {
#pragma unroll
            for (int e = 0; e < 8; ++e) y[e] = second ? (pr[e] * sn[e] + y[e] * cs[e]) : (y[e] * cs[e] - pr[e] * sn[e]);
        }
        if (head < 8) {
#pragma unroll
            for (int e = 0; e < 8; ++e) y[e] *= 0.12752455f; }
        if (act) { v4u o; o.x = cvtpk(y[0], y[1]); o.y = cvtpk(y[2], y[3]); o.z = cvtpk(y[4], y[5]); o.w = cvtpk(y[6], y[7]); *(GAS v4u*)(zr + ch * 8) = o; }
    }
}

constexpr int ST272 = 272, ST144 = 144;
__device__ __forceinline__ void gmlp_unit(Frame& F, const bf16* Z, bf16* MIX, int chunk, int grp, const float* ws_l  , const float* bs_l  , const float* gm  ) {
    int tid_ = threadIdx.x; asm volatile("" : "+v"(tid_));
    const int tid = tid_, lane = tid & 63, wave = __builtin_amdgcn_readfirstlane(tid >> 6);
    const int b = chunk / CHB, c = chunk - b * CHB, r0 = b * TOKB + c * 128;
    LAS unsigned char* VN = F.lds + RING_OFF;
    LAS unsigned char* WS = VN + 128 * ST272;
    LAS float* RS = (LAS float*)(WS + 128 * ST272);
    { const int row = tid >> 2, part = tid & 3; const bf16* p = Z + (size_t)(r0 + row) * NZ + ZMV + part * 128; float ss = 0.f;
#pragma unroll
        for (int q = 0; q < 16; ++q) { const v4u w = *(const GAS v4u*)(p + q * 8);
            const float y0 = bflo(w.x), y1 = bfhi(w.x), y2 = bflo(w.y), y3 = bfhi(w.y), y4 = bflo(w.z), y5 = bfhi(w.z), y6 = bflo(w.w), y7 = bfhi(w.w);
            ss += (y0 * y0 + y1 * y1) + (y2 * y2 + y3 * y3) + (y4 * y4 + y5 * y5) + (y6 * y6 + y7 * y7); }
        ss += __shfl_xor(ss, 1); ss += __shfl_xor(ss, 2);
        if (part == 0) RS[row] = 1.0f / sqrtf(ss * (1.0f / 512.0f) + EPSN); }
#pragma unroll
    for (int q = 0; q < 8; ++q) { const int idx = tid + 512 * q, i = idx >> 5, j4 = (idx & 31) * 4; const f32x4 w = *(const f32x4*)(ws_l + (size_t)grp * 16384 + i * 128 + j4);
        u32x2 o; o.x = cvtpk(w.x, w.y); o.y = cvtpk(w.z, w.w); *(LAS u32x2*)(WS + i * ST272 + j4 * 2) = o; }
    __syncthreads();
#pragma unroll
    for (int q = 0; q < 4; ++q) { const int idx = tid + 512 * q, jrow = idx >> 4, c8 = (idx & 15) * 8; const v4u w = *(const GAS v4u*)(Z + (size_t)(r0 + jrow) * NZ + ZMV + grp * 128 + c8);
        const float rstd = RS[jrow]; const float* gp = gm + grp * 128 + c8;
        v4u o; o.x = cvtpk(bflo(w.x) * rstd * gp[0], bfhi(w.x) * rstd * gp[1]); o.y = cvtpk(bflo(w.y) * rstd * gp[2], bfhi(w.y) * rstd * gp[3]);
        o.z = cvtpk(bflo(w.z) * rstd * gp[4], bfhi(w.z) * rstd * gp[5]); o.w = cvtpk(bflo(w.w) * rstd * gp[6], bfhi(w.w) * rstd * gp[7]);
        *(LAS v4u*)(VN + jrow * ST272 + c8 * 2) = o; }
    __syncthreads();
    const int it = wave & 3, ct0 = (wave >> 2) * 2, hi = lane >> 5, i = it * 32 + (lane & 31);
    const float bias = bs_l[grp * 128 + i];
#pragma unroll
    for (int cc = 0; cc < 2; ++cc) { const int ct = ct0 + cc; f32x16 acc = {};
        mm32_tr<8>(acc, VN, ST272, ct * 32, WS, ST272, it * 32, lane);
        const bf16* mup = Z + (size_t)(r0 + i) * NZ + ZMU + grp * 128 + ct * 32 + 4 * hi; bf16* op = MIX + (size_t)(r0 + i) * DM + MXM + grp * 128 + ct * 32 + 4 * hi;
#pragma unroll
        for (int rg = 0; rg < 4; ++rg) { const u32x2 mu = *(const GAS u32x2*)(mup + 8 * rg);
            u32x2 o; o.x = cvtpk(bflo(mu.x) * (acc[4 * rg + 0] + bias), bfhi(mu.x) * (acc[4 * rg + 1] + bias)); o.y = cvtpk(bflo(mu.y) * (acc[4 * rg + 2] + bias), bfhi(mu.y) * (acc[4 * rg + 3] + bias));
            *(GAS u32x2*)(op + 8 * rg) = o; } }
    __syncthreads();
}

__device__ __forceinline__ float log_sigmoid_f(float x) { const float t = __builtin_amdgcn_exp2f(fabsf(x) * -1.4426950408889634f); return fminf(x, 0.f) - 0.6931471805599453f * __builtin_amdgcn_logf(1.0f + t); }
__device__ __forceinline__ void gla_a_unit(Frame& F, bf16* Z, bf16* QG, float* UT, float* DV, int chunk, int hd, const float* gw_l  , const float* gb_l  ) {
    int tid_ = threadIdx.x; asm volatile("" : "+v"(tid_));
    const int tid = tid_, lane = tid & 63, wave = __builtin_amdgcn_readfirstlane(tid >> 6);
    const int b = chunk / CHB, c = chunk - b * CHB, r0 = b * TOKB + c * 128;
    LAS unsigned char* QT = F.lds + RING_OFF;
    LAS unsigned char* KT = QT + 128 * ST144;
    LAS unsigned char* KTT = KT + 128 * ST144;
    LAS unsigned char* VV = KTT + 64 * ST272;
    LAS unsigned char* ATT = VV + 128 * ST272;
    LAS unsigned char* QRAW = ATT; LAS unsigned char* KRAW = ATT + 16384;
    LAS float* SEG = (LAS float*)(ATT + 128 * ST272);
    LAS unsigned char* LR = (LAS unsigned char*)(SEG + 512);
#pragma unroll
    for (int q = 0; q < 4; ++q) { const int idx = tid + 512 * q, jrow = idx >> 4, c8 = (idx & 15) * 8;
        *(LAS v4u*)(VV + jrow * ST272 + c8 * 2) = *(const GAS v4u*)(Z + (size_t)(r0 + jrow) * NZ + ZGV + hd * 128 + c8); }
#pragma unroll
    for (int q = 0; q < 2; ++q) { const int idx = tid + 512 * q, jrow = idx >> 3, c8 = (idx & 7) * 8;
        *(LAS v4u*)(QRAW + jrow * 128 + c8 * 2) = *(const GAS v4u*)(Z + (size_t)(r0 + jrow) * NZ + ZGQ + hd * 64 + c8);
        *(LAS v4u*)(KRAW + jrow * 128 + c8 * 2) = *(const GAS v4u*)(Z + (size_t)(r0 + jrow) * NZ + ZGK + hd * 64 + c8); }
    { const int jrow = tid >> 2, c8 = (tid & 3) * 8; *(LAS v4u*)(LR + jrow * 64 + c8 * 2) = *(const GAS v4u*)(Z + (size_t)(r0 + jrow) * NZ + ZLR + c8); }
    __syncthreads();
    const int d = lane, jb = wave;
    f32x16 att0 = {}, att1 = {};
    const int jt = wave & 3, it0 = (wave >> 2) * 2, hi = lane >> 5, r32 = lane & 31;
#pragma unroll
    for (int dir = 0; dir < 2; ++dir) {
        float cs[16];
        { float wv[16];
#pragma unroll
          for (int r = 0; r < 16; ++r) wv[r] = gw_l[(dir * 16 + r) * 256 + hd * 64 + d];
          const float gbias = gb_l[dir * 256 + hd * 64 + d];
#pragma unroll
          for (int i = 0; i < 16; ++i) { LAS const unsigned char* lr = LR + (jb * 16 + i) * 64 + dir * 32;
            const v4u w0 = *(LAS const v4u*)(lr), w1 = *(LAS const v4u*)(lr + 16);
            float lg = gbias;
            lg += bflo(w0.x) * wv[0] + bfhi(w0.x) * wv[1] + bflo(w0.y) * wv[2] + bfhi(w0.y) * wv[3] + bflo(w0.z) * wv[4] + bfhi(w0.z) * wv[5] + bflo(w0.w) * wv[6] + bfhi(w0.w) * wv[7];
            lg += bflo(w1.x) * wv[8] + bfhi(w1.x) * wv[9] + bflo(w1.y) * wv[10] + bfhi(w1.y) * wv[11] + bflo(w1.z) * wv[12] + bfhi(w1.z) * wv[13] + bflo(w1.w) * wv[14] + bfhi(w1.w) * wv[15];
            cs[i] = log_sigmoid_f(lg) * (1.0f / 16.0f); } }
        if (dir == 0) {
#pragma unroll
            for (int i = 1; i < 16; ++i) cs[i] += cs[i - 1];
            SEG[jb * 64 + d] = cs[15];
        } else {
#pragma unroll
            for (int i = 14; i >= 0; --i) cs[i] += cs[i + 1];
            SEG[jb * 64 + d] = cs[0];
        }
        __syncthreads();
        float offs = 0.f;
#pragma unroll
        for (int s = 0; s < 8; ++s) { const float sv = SEG[s * 64 + d]; if (dir == 0 ? (s < jb) : (s > jb)) offs += sv; }
#pragma unroll
        for (int i = 0; i < 16; ++i) { const int j = jb * 16 + i; const float cc = cs[i] + offs;
            const float qraw = bf2f(*(LAS const unsigned short*)(QRAW + j * 128 + d * 2)) * 0.125f, kraw = bf2f(*(LAS const unsigned short*)(KRAW + j * 128 + d * 2));
            const float qt = qraw * __expf(cc), kt = kraw * __expf(-cc);
            const unsigned short qb = (unsigned short)(cvtpk(qt, 0.f) & 0xffffu), kb = (unsigned short)(cvtpk(kt, 0.f) & 0xffffu);
            *(LAS unsigned short*)(QT + j * ST144 + d * 2) = qb; *(LAS unsigned short*)(KT + j * ST144 + d * 2) = kb; *(LAS unsigned short*)(KTT + d * ST272 + j * 2) = kb; }
        __syncthreads();
#pragma unroll
        for (int q = 0; q < 2; ++q) { const int idx = tid + 512 * q, jrow = idx >> 3, c8 = (idx & 7) * 8;
            *(GAS v4u*)(QG + (size_t)(r0 + jrow) * 512 + dir * 256 + hd * 64 + c8) = *(LAS const v4u*)(QT + jrow * ST144 + c8 * 2); }
#pragma unroll
        for (int cc = 0; cc < 2; ++cc) { f32x16 acc = {};
            mm32_rr<4>(acc, KT, ST144, jt * 32, QT, ST144, (it0 + cc) * 32, lane);
            const int ii = (it0 + cc) * 32 + r32;
#pragma unroll
            for (int r = 0; r < 16; ++r) { const int jj = jt * 32 + crow(r, hi); const int df = dir == 0 ? (ii - jj) : (jj - ii);
                const float v = __uint_as_float(__float_as_uint(acc[r]) & ~(unsigned)(df >> 31)); if (cc == 0) att0[r] += v; else att1[r] += v; } }
        { const int et = wave & 3, dt = wave >> 2; f32x16 acc = {};
            mm32_tr<8>(acc, VV, ST272, et * 32, KTT, ST272, dt * 32, lane);
            const int dd = dt * 32 + r32; float tot = 0.f;
#pragma unroll
            for (int s = 0; s < 8; ++s) tot += SEG[s * 64 + dd];
            const float ex = __expf(tot);
            const size_t cidx = ((size_t)(b * CHB + c) * 4 + hd) * 2 + dir;
            float* up = UT + cidx * 8192 + dd;
#pragma unroll
            for (int r = 0; r < 16; ++r) up[(et * 32 + crow(r, hi)) * 64] = acc[r] * ex;
            if (et == 0 && hi == 0) DV[cidx * 64 + dd] = ex; }
        __syncthreads();
    }
#pragma unroll
    for (int cc = 0; cc < 2; ++cc) { const int ii = (it0 + cc) * 32 + r32;
#pragma unroll
        for (int rg = 0; rg < 4; ++rg) { u32x2 o;
            if (cc == 0) { o.x = cvtpk(att0[4 * rg], att0[4 * rg + 1]); o.y = cvtpk(att0[4 * rg + 2], att0[4 * rg + 3]); } else { o.x = cvtpk(att1[4 * rg], att1[4 * rg + 1]); o.y = cvtpk(att1[4 * rg + 2], att1[4 * rg + 3]); }
            *(LAS u32x2*)(ATT + ii * ST272 + (jt * 32 + 8 * rg + 4 * hi) * 2) = o; } }
    __syncthreads();
    { const int itile = wave & 3, et0 = (wave >> 2) * 2; const int ii = itile * 32 + r32;
#pragma unroll
        for (int cc = 0; cc < 2; ++cc) { const int et = et0 + cc; f32x16 acc = {};
            mm32_tr<8>(acc, VV, ST272, et * 32, ATT, ST272, itile * 32, lane);
            bf16* op = Z + (size_t)(r0 + ii) * NZ + ZGV + hd * 128 + et * 32 + 4 * hi;
#pragma unroll
            for (int rg = 0; rg < 4; ++rg) { u32x2 o; o.x = cvtpk(acc[4 * rg], acc[4 * rg + 1]); o.y = cvtpk(acc[4 * rg + 2], acc[4 * rg + 3]); *(GAS u32x2*)(op + 8 * rg) = o; } } }
    __syncthreads();
}

__device__ __forceinline__ void gla_scan_phase(Frame& F, const float* UT, const float* DV, bf16* ST) {
    for (int gt = F.vcu * 512 + F.tid; gt < 16 * 8192; gt += F.G * 512) {
        const int chain = gt >> 13, elem = gt & 8191, d = elem & 63, dir = chain & 1, hd = (chain >> 1) & 3, b = chain >> 3;
        float state = 0.f;
#pragma unroll 1
        for (int s0 = 0; s0 < CHB; s0 += 26) {
            float u[26], dv[26]; size_t ci[26];
#pragma unroll
            for (int i = 0; i < 26; ++i) { const int s = s0 + i; const int c = dir == 0 ? s : (s == 0 ? 1 : (s == 1 ? 0 : 131 - s));
                ci[i] = ((size_t)(b * CHB + c) * 4 + hd) * 2 + dir; u[i] = UT[ci[i] * 8192 + elem]; dv[i] = DV[ci[i] * 64 + d]; }
#pragma unroll
            for (int i = 0; i < 26; ++i) { ST[ci[i] * 8192 + elem] = (bf16)(cvtpk(state, 0.f) & 0xffffu); state = dv[i] * state + u[i]; }
        }
    }
}

__device__ __forceinline__ void gla_c_item(const bf16* Z, const bf16* QG, const bf16* ST, bf16* MIX, int chunk, int hd, int itile, const float* gg  , int lane) {
    const int b = chunk / CHB, c = chunk - b * CHB, r0 = b * TOKB + c * 128, r32 = lane & 31, hi = lane >> 5;
    const size_t row = (size_t)(r0 + itile * 32 + r32);
    bf16x8 bq[2][4];
#pragma unroll
    for (int dir = 0; dir < 2; ++dir)
#pragma unroll
        for (int ks = 0; ks < 4; ++ks) bq[dir][ks] = *(const GAS bf16x8*)(QG + row * 512 + dir * 256 + hd * 64 + 16 * ks + 8 * hi);
    u32x2 oi[4][4], rw[4][4];
#pragma unroll
    for (int et = 0; et < 4; ++et)
#pragma unroll
        for (int rg = 0; rg < 4; ++rg) { const int e0 = et * 32 + 8 * rg + 4 * hi;
            oi[et][rg] = *(const GAS u32x2*)(Z + row * NZ + ZGV + hd * 128 + e0); rw[et][rg] = *(const GAS u32x2*)(Z + row * NZ + ZGR + hd * 128 + e0); }
    f32x16 acc[4] = {};
#pragma unroll
    for (int dir = 0; dir < 2; ++dir) { const size_t cidx = ((size_t)(b * CHB + c) * 4 + hd) * 2 + dir; const bf16* sp = ST + cidx * 8192 + (size_t)r32 * 64 + 8 * hi;
#pragma unroll
        for (int et = 0; et < 4; ++et)
#pragma unroll
            for (int ks = 0; ks < 4; ++ks) { const bf16x8 af = *(const GAS bf16x8*)(sp + et * 32 * 64 + 16 * ks);
                acc[et] = __builtin_amdgcn_mfma_f32_32x32x16_bf16(af, bq[dir][ks], acc[et], 0, 0, 0);
            } }
    float ss = 0.f;
#pragma unroll
    for (int et = 0; et < 4; ++et)
#pragma unroll
        for (int rg = 0; rg < 4; ++rg) { const u32x2 w = oi[et][rg];
            acc[et][4 * rg + 0] += bflo(w.x); acc[et][4 * rg + 1] += bfhi(w.x); acc[et][4 * rg + 2] += bflo(w.y); acc[et][4 * rg + 3] += bfhi(w.y);
            ss += (acc[et][4 * rg] * acc[et][4 * rg] + acc[et][4 * rg + 1] * acc[et][4 * rg + 1]) + (acc[et][4 * rg + 2] * acc[et][4 * rg + 2] + acc[et][4 * rg + 3] * acc[et][4 * rg + 3]); }
    ss += __shfl_xor(ss, 32);
    const float rstd = 1.0f / sqrtf(ss * (1.0f / 128.0f) + EPSN);
#pragma unroll
    for (int et = 0; et < 4; ++et)
#pragma unroll
        for (int rg = 0; rg < 4; ++rg) { const int e0 = et * 32 + 8 * rg + 4 * hi; const u32x2 rv = rw[et][rg]; const f32x4 g4 = *(const f32x4*)(gg + hd * 128 + e0);
            const float r0v = bflo(rv.x), r1v = bfhi(rv.x), r2v = bflo(rv.y), r3v = bfhi(rv.y);
            float y0 = acc[et][4 * rg] * rstd * g4.x * silu_rcp(r0v), y1 = acc[et][4 * rg + 1] * rstd * g4.y * silu_rcp(r1v), y2 = acc[et][4 * rg + 2] * rstd * g4.z * silu_rcp(r2v), y3 = acc[et][4 * rg + 3] * rstd * g4.w * silu_rcp(r3v);
            u32x2 o; o.x = cvtpk(y0, y1); o.y = cvtpk(y2, y3);
            *(GAS u32x2*)(MIX + row * DM + MXG + hd * 128 + e0) = o; }
}

namespace att {
constexpr int D = 128, NW = 8, QBLK = 32, KVBLK = 64;
constexpr float SCALE = 0.088388347648318440f;
constexpr float THR = 8.f;
constexpr int LDQ = NZ, LDK = NZ, LDO = DM;
constexpr int NBUF = 3, SHM_V = KVBLK * D * 2, SHM_K = KVBLK * D * 2, SHM_ATTN = NBUF * SHM_V + NBUF * SHM_K + NW * 64 * 4;
#define KSWZ(row, colB) ((row) * 256 + ((colB) ^ (((row) & 7) << 4)))
#define SBAR() __builtin_amdgcn_sched_barrier(0)
template <bool FAST>
__device__ __forceinline__ void partialSM(f32x16& p0, f32x16& p1, float& m_reg, float& mn, float& alpha) {
  if (FAST) { mn = m_reg; alpha = 1.f;
#pragma unroll
    for (int r = 0; r < 16; ++r) p0[r] = __builtin_amdgcn_exp2f(p0[r]);
    return; }
  float pmax = p0[0];
#pragma unroll
  for (int r = 1; r < 16; ++r) pmax = fmaxf(pmax, p0[r]);
#pragma unroll
  for (int r = 0; r < 16; ++r) pmax = fmaxf(pmax, p1[r]);
  { auto rr = __builtin_amdgcn_permlane32_swap(__float_as_uint(pmax), __float_as_uint(pmax), false, false);
    pmax = fmaxf(__uint_as_float(rr[0]), __uint_as_float(rr[1])); }
  float C = 1.0f; asm volatile("" : "+v"(C));
  if (__builtin_expect(__all(pmax - m_reg <= THR * 1.4426950408889634f), 1)) { mn = m_reg; alpha = 1.f; }
  else { mn = fmaxf(m_reg, pmax); alpha = __builtin_amdgcn_exp2f((m_reg - mn) * C); m_reg = mn; }
  float mnC = -mn * C;
#pragma unroll
  for (int r = 0; r < 16; ++r) p0[r] = fmaf(p0[r], C, mnC);
#pragma unroll
  for (int r = 0; r < 16; ++r) p1[r] = fmaf(p1[r], C, mnC);
#pragma unroll
  for (int r = 0; r < 16; ++r) p0[r] = __builtin_amdgcn_exp2f(p0[r]);
}
__device__ __forceinline__ void finishSM(f32x16& p0, f32x16& p1, float alpha, float& l_reg, bf16x8& pa0, bf16x8& pa1, bf16x8& pa2, bf16x8& pa3) {
#pragma unroll
  for (int r = 0; r < 16; ++r) p1[r] = __builtin_amdgcn_exp2f(p1[r]);
  float ps = 0;
#pragma unroll
  for (int r = 0; r < 16; ++r) ps += p0[r];
#pragma unroll
  for (int r = 0; r < 16; ++r) ps += p1[r];
  { auto rr = __builtin_amdgcn_permlane32_swap(__float_as_uint(ps), __float_as_uint(ps), false, false);
    ps = __uint_as_float(rr[0]) + __uint_as_float(rr[1]); }
  l_reg = l_reg * alpha + ps;
#define PK4(P, BASE, OUT) do { unsigned a0 = cvtpk(P[BASE + 0], P[BASE + 1]), a1 = cvtpk(P[BASE + 2], P[BASE + 3]);   \
    unsigned b0 = cvtpk(P[BASE + 4], P[BASE + 5]), b1 = cvtpk(P[BASE + 6], P[BASE + 7]);                              \
    auto r0 = __builtin_amdgcn_permlane32_swap(a0, b0, false, false); auto r1 = __builtin_amdgcn_permlane32_swap(a1, b1, false, false); \
    v4u w = {r0[0], r1[0], r0[1], r1[1]}; OUT = __builtin_bit_cast(bf16x8, w); } while (0)
  PK4(p0, 0, pa0); PK4(p0, 8, pa1); PK4(p1, 0, pa2); PK4(p1, 8, pa3);
#undef PK4
}
__device__ __forceinline__ void qkt(f32x16& p0, f32x16& p1, LAS const unsigned char* Ks, const bf16x8* qr, int r32, int hi) {
  p0 = f32x16{}; p1 = f32x16{};
#pragma unroll
  for (int d0 = 0; d0 < 8; ++d0) { int cb = (d0 * 16 + hi * 8) * 2;
    bf16x8 b0 = *(LAS const bf16x8*)(Ks + KSWZ(r32, cb));
    bf16x8 b1 = *(LAS const bf16x8*)(Ks + KSWZ(32 + r32, cb));
    p0 = __builtin_amdgcn_mfma_f32_32x32x16_bf16(b0, qr[d0], p0, 0, 0, 0);
    p1 = __builtin_amdgcn_mfma_f32_32x32x16_bf16(b1, qr[d0], p1, 0, 0, 0); }
}
__device__ __forceinline__ int v_st(int k, int c) { const int kk = (k & ~0xC) | ((k & 4) << 1) | ((k & 8) >> 1); return ((kk >> 3) * 4 + (c >> 5)) * 512 + ((kk & 7) * 32 + (c & 31)) * 2; }
__device__ __forceinline__ int v_rd_base(int lane) { return ((lane & 3) << 3) | (((lane >> 2) & 3) << 6) | (((lane >> 4) & 1) << 5) | (((lane >> 5) & 1) << 8); }
constexpr int v_rd_off(int d0, int ks, int half) { return d0 * 512 + ks * 4096 + half * 2048; }
template <int OFF> __device__ __forceinline__ s16x4 tr_read(int vb) {
  s16x4 r; asm volatile("ds_read_b64_tr_b16 %0, %1 offset:%2" : "=&v"(r) : "v"(vb), "i"(OFF) : "memory"); return r;
}
template <int D0> __device__ __forceinline__ void pv_one(f32x16& od, int vb, bf16x8 pa0, bf16x8 pa1, bf16x8 pa2, bf16x8 pa3) {
  const s16x4 l0 = tr_read<v_rd_off(D0, 0, 0)>(vb), h0 = tr_read<v_rd_off(D0, 0, 1)>(vb), l1 = tr_read<v_rd_off(D0, 1, 0)>(vb), h1 = tr_read<v_rd_off(D0, 1, 1)>(vb);
  const s16x4 l2 = tr_read<v_rd_off(D0, 2, 0)>(vb), h2 = tr_read<v_rd_off(D0, 2, 1)>(vb), l3 = tr_read<v_rd_off(D0, 3, 0)>(vb), h3 = tr_read<v_rd_off(D0, 3, 1)>(vb);
  asm volatile("s_waitcnt lgkmcnt(0)" ::: "memory"); SBAR();
#define PK(L, H) (bf16x8){L[0], L[1], L[2], L[3], H[0], H[1], H[2], H[3]}
  od = __builtin_amdgcn_mfma_f32_32x32x16_bf16(pa0, PK(l0, h0), od, 0, 0, 0);
  od = __builtin_amdgcn_mfma_f32_32x32x16_bf16(pa1, PK(l1, h1), od, 0, 0, 0);
  od = __builtin_amdgcn_mfma_f32_32x32x16_bf16(pa2, PK(l2, h2), od, 0, 0, 0);
  od = __builtin_amdgcn_mfma_f32_32x32x16_bf16(pa3, PK(l3, h3), od, 0, 0, 0);
#undef PK
}
__device__ __forceinline__ void pv_d0(f32x16* o, int vb, bf16x8 pa0, bf16x8 pa1, bf16x8 pa2, bf16x8 pa3) {
  pv_one<0>(o[0], vb, pa0, pa1, pa2, pa3); pv_one<1>(o[1], vb, pa0, pa1, pa2, pa3); pv_one<2>(o[2], vb, pa0, pa1, pa2, pa3); pv_one<3>(o[3], vb, pa0, pa1, pa2, pa3);
}
template <bool FAST>
__device__ __forceinline__ void attn_dense_body(const bf16* __restrict__ Qb, const bf16* __restrict__ Kh, const bf16* __restrict__ Vh, bf16* __restrict__ Ob, int seq, LAS unsigned char* lds) {
  int tid_ = threadIdx.x; asm volatile("" : "+v"(tid_));
  const int tid = tid_, wid = __builtin_amdgcn_readfirstlane(tid >> 6), lane = tid & 63, r32 = lane & 31, hi = lane >> 5;
  LAS unsigned char* V_lds = lds; LAS unsigned char* K_lds = lds + NBUF * SHM_V;
  LAS float* wsp = (LAS float*)(lds + NBUF * SHM_V + NBUF * SHM_K) + wid * 64; LAS float* li_l = wsp; LAS float* al_l = wsp + 32;
  float m_reg = FAST ? 0.f : -1e30f, l_reg = 0; f32x16 o[4] = {}; bf16x8 qr[8];
  const bf16* Qw = Qb + (long)(wid * QBLK + r32) * LDQ + hi * 8;
#pragma unroll
  for (int d0 = 0; d0 < 8; ++d0) qr[d0] = *(const GAS bf16x8*)(Qw + d0 * 16);
  const int sr = tid >> 4, sc = (tid & 15) * 8, vst0 = v_st(sr, sc), vst1 = v_st(32 + sr, sc);
  const int vb0 = (int)(unsigned)(uintptr_t)V_lds + v_rd_base(lane);
  struct { bf16x8 vs0, vs1, ks0, ks1; } sr_[2];
#define SLOAD(i, k0) do { sr_[i].vs0 = *(const GAS bf16x8*)(&Vh[(long)((k0) + sr) * LDK + sc]); sr_[i].vs1 = *(const GAS bf16x8*)(&Vh[(long)((k0) + 32 + sr) * LDK + sc]); \
    sr_[i].ks0 = *(const GAS bf16x8*)(&Kh[(long)((k0) + sr) * LDK + sc]); sr_[i].ks1 = *(const GAS bf16x8*)(&Kh[(long)((k0) + 32 + sr) * LDK + sc]); } while (0)
#define SWRITE(b, i) do { *(LAS bf16x8*)(V_lds + (b) * SHM_V + vst0) = sr_[i].vs0;          \
    *(LAS bf16x8*)(V_lds + (b) * SHM_V + vst1) = sr_[i].vs1; int kc = sc * 2;               \
    *(LAS bf16x8*)(K_lds + (b) * SHM_K + KSWZ(sr, kc)) = sr_[i].ks0;                       \
    *(LAS bf16x8*)(K_lds + (b) * SHM_K + KSWZ(32 + sr, kc)) = sr_[i].ks1; } while (0)
#define SWAIT() asm volatile("s_waitcnt vmcnt(4)" ::: "memory")
#define RESC(a) do { if (__any((a) < 1.f)) { if (hi == 0) al_l[r32] = (a); asm volatile("s_waitcnt lgkmcnt(0)" ::: "memory"); \
    _Pragma("unroll") for (int d = 0; d < 4; ++d) _Pragma("unroll") for (int r = 0; r < 16; ++r) o[d][r] *= al_l[crow(r, hi)]; } } while (0)
  f32x16 pA0, pA1, pB0, pB1; float mnA, mnB, alA, alB; bf16x8 pa0, pa1, pa2, pa3; const int NT = seq / KVBLK;
  constexpr int SE = 0, SO = 1;
  int bc = 1, bp = 0, bn = 2;
#define ROT() do { const int t_ = bp; bp = bc; bc = bn; bn = t_; } while (0)
  SLOAD(SE, 0); asm volatile("s_waitcnt vmcnt(0)" ::: "memory"); SWRITE(0, SE); __syncthreads();
  qkt(pA0, pA1, K_lds, qr, r32, hi); partialSM<FAST>(pA0, pA1, m_reg, mnA, alA);
  SLOAD(SO, KVBLK); if (2 < NT) SLOAD(SE, 2 * KVBLK);
  SWAIT(); SWRITE(1, SO); __syncthreads();
  for (int j = 1; j + 1 < NT; j += 2) {
    SBAR(); qkt(pB0, pB1, K_lds + bc * SHM_K, qr, r32, hi);
    finishSM(pA0, pA1, alA, l_reg, pa0, pa1, pa2, pa3); SBAR();
    SLOAD(SO, (j + 2) * KVBLK); SBAR();
    pv_d0(o, vb0 + bp * (int)SHM_V, pa0, pa1, pa2, pa3); partialSM<FAST>(pB0, pB1, m_reg, mnB, alB);
    SWAIT(); SWRITE(bn, SE);
    if (!FAST) RESC(alB);
    __syncthreads(); ROT();
    SBAR(); qkt(pA0, pA1, K_lds + bc * SHM_K, qr, r32, hi);
    finishSM(pB0, pB1, alB, l_reg, pa0, pa1, pa2, pa3); SBAR();
    if (j + 3 < NT) SLOAD(SE, (j + 3) * KVBLK); SBAR();
    pv_d0(o, vb0 + bp * (int)SHM_V, pa0, pa1, pa2, pa3); partialSM<FAST>(pA0, pA1, m_reg, mnA, alA);
    SWAIT(); SWRITE(bn, SO);
    if (!FAST) RESC(alA);
    __syncthreads(); ROT();
  }
  SBAR(); qkt(pB0, pB1, K_lds + bc * SHM_K, qr, r32, hi);
  finishSM(pA0, pA1, alA, l_reg, pa0, pa1, pa2, pa3); SBAR();
  pv_d0(o, vb0 + bp * (int)SHM_V, pa0, pa1, pa2, pa3); partialSM<FAST>(pB0, pB1, m_reg, mnB, alB);
  if (!FAST) RESC(alB);
  finishSM(pB0, pB1, alB, l_reg, pa0, pa1, pa2, pa3); SBAR();
  pv_d0(o, vb0 + bc * (int)SHM_V, pa0, pa1, pa2, pa3);
  if (hi == 0) li_l[r32] = l_reg; asm volatile("s_waitcnt lgkmcnt(0)" ::: "memory");
  float rli[16];
#pragma unroll
  for (int r = 0; r < 16; ++r) rli[r] = __builtin_amdgcn_rcpf(li_l[crow(r, hi)]);
  bf16* Ow = Ob + (long)(wid * QBLK) * LDO;
#pragma unroll
  for (int r = 0; r < 16; ++r) { int orow = crow(r, hi);
#pragma unroll
    for (int d0 = 0; d0 < 4; ++d0) Ow[(long)orow * LDO + d0 * 32 + r32] = (bf16)(cvtpk(o[d0][r] * rli[r], 0.f) & 0xffffu); }
  __syncthreads();
#undef SLOAD
#undef SWRITE
#undef SWAIT
#undef RESC
#undef ROT
}
constexpr int V16_LD = 288, SHM_V16 = KVBLK * V16_LD, SHM_K16 = KVBLK * D * 2;
#define KSWZ16(row, colB) ((row) * 256 + ((colB) ^ (((row) & 15) << 4)))
struct H16 { f32x4 s[2][2]; };
template <int PART, int KL> __device__ __forceinline__ void kload16(bf16x8 (&kf)[4], LAS const unsigned char* Ks, int li, int g) {
#pragma unroll
  for (int ks = 0; ks < 4; ++ks) kf[ks] = *(LAS const bf16x8*)(Ks + KSWZ16(16 * (2 * PART + KL) + li, 64 * ks + 16 * g));
}
template <int PART> __device__ __forceinline__ void qkmma16(H16& S, const bf16x8 (&ka)[4], LAS const unsigned char* Ks, const bf16x8 (&qf)[2][4], int li, int g) {
  bf16x8 kb[4]; kload16<PART, 1>(kb, Ks, li, g);
#pragma unroll
  for (int kl = 0; kl < 2; ++kl) { S.s[kl][0] = (f32x4){0.f, 0.f, 0.f, 0.f}; S.s[kl][1] = (f32x4){0.f, 0.f, 0.f, 0.f}; }
#pragma unroll
  for (int ks = 0; ks < 4; ++ks) {
    S.s[0][0] = __builtin_amdgcn_mfma_f32_16x16x32_bf16(ka[ks], qf[0][ks], S.s[0][0], 0, 0, 0);
    S.s[0][1] = __builtin_amdgcn_mfma_f32_16x16x32_bf16(ka[ks], qf[1][ks], S.s[0][1], 0, 0, 0); }
#pragma unroll
  for (int ks = 0; ks < 4; ++ks) {
    S.s[1][0] = __builtin_amdgcn_mfma_f32_16x16x32_bf16(kb[ks], qf[0][ks], S.s[1][0], 0, 0, 0);
    S.s[1][1] = __builtin_amdgcn_mfma_f32_16x16x32_bf16(kb[ks], qf[1][ks], S.s[1][1], 0, 0, 0); }
}
#define QK_SCHED() do { __builtin_amdgcn_sched_group_barrier(0x100, 4, 0); _Pragma("unroll") for (int i_ = 0; i_ < 16; ++i_) { __builtin_amdgcn_sched_group_barrier(0x008, 1, 0); __builtin_amdgcn_sched_group_barrier(0x002, 3, 0); } } while (0)
__device__ __forceinline__ void eh16(H16& S, float (&lsum)[2], bf16x8 (&pf)[2]) {
#pragma unroll
  for (int kl = 0; kl < 2; ++kl)
#pragma unroll
    for (int qb = 0; qb < 2; ++qb)
#pragma unroll
      for (int r = 0; r < 4; ++r) S.s[kl][qb][r] = __builtin_amdgcn_exp2f(S.s[kl][qb][r]);
#pragma unroll
  for (int qb = 0; qb < 2; ++qb) { const f32x4 a = S.s[0][qb], b = S.s[1][qb];
    lsum[qb] += ((a[0] + a[1]) + (a[2] + a[3])) + ((b[0] + b[1]) + (b[2] + b[3]));
    v4u w = {cvtpk(a[0], a[1]), cvtpk(a[2], a[3]), cvtpk(b[0], b[1]), cvtpk(b[2], b[3])}; pf[qb] = __builtin_bit_cast(bf16x8, w); }
}
constexpr int v16_off(int db, int part, int t) { return (32 * part + 16 * t) * V16_LD + db * 32; }
struct VF4 { s16x4 a0, a1, b0, b1, c0, c1, d0, d1; };
template <int PART, int G> __device__ __forceinline__ void vrd16(VF4& f, int vb) {
  f.a0 = tr_read<v16_off(4 * G, PART, 0)>(vb); f.a1 = tr_read<v16_off(4 * G, PART, 1)>(vb); f.b0 = tr_read<v16_off(4 * G + 1, PART, 0)>(vb); f.b1 = tr_read<v16_off(4 * G + 1, PART, 1)>(vb);
  f.c0 = tr_read<v16_off(4 * G + 2, PART, 0)>(vb); f.c1 = tr_read<v16_off(4 * G + 2, PART, 1)>(vb); f.d0 = tr_read<v16_off(4 * G + 3, PART, 0)>(vb); f.d1 = tr_read<v16_off(4 * G + 3, PART, 1)>(vb);
}
template <int G> __device__ __forceinline__ void vmma16(f32x4 (&o)[2][8], const VF4& f, const bf16x8 (&pf)[2]) {
#define PK(L, H) (bf16x8){L[0], L[1], L[2], L[3], H[0], H[1], H[2], H[3]}
  o[0][4 * G] = __builtin_amdgcn_mfma_f32_16x16x32_bf16(pf[0], PK(f.a0, f.a1), o[0][4 * G], 0, 0, 0);
  o[1][4 * G] = __builtin_amdgcn_mfma_f32_16x16x32_bf16(pf[1], PK(f.a0, f.a1), o[1][4 * G], 0, 0, 0);
  o[0][4 * G + 1] = __builtin_amdgcn_mfma_f32_16x16x32_bf16(pf[0], PK(f.b0, f.b1), o[0][4 * G + 1], 0, 0, 0);
  o[1][4 * G + 1] = __builtin_amdgcn_mfma_f32_16x16x32_bf16(pf[1], PK(f.b0, f.b1), o[1][4 * G + 1], 0, 0, 0);
  o[0][4 * G + 2] = __builtin_amdgcn_mfma_f32_16x16x32_bf16(pf[0], PK(f.c0, f.c1), o[0][4 * G + 2], 0, 0, 0);
  o[1][4 * G + 2] = __builtin_amdgcn_mfma_f32_16x16x32_bf16(pf[1], PK(f.c0, f.c1), o[1][4 * G + 2], 0, 0, 0);
  o[0][4 * G + 3] = __builtin_amdgcn_mfma_f32_16x16x32_bf16(pf[0], PK(f.d0, f.d1), o[0][4 * G + 3], 0, 0, 0);
  o[1][4 * G + 3] = __builtin_amdgcn_mfma_f32_16x16x32_bf16(pf[1], PK(f.d0, f.d1), o[1][4 * G + 3], 0, 0, 0);
#undef PK
}
typedef short v4i16_t __attribute__((ext_vector_type(4)));
__device__ __forceinline__ s16x4 vtr(LAS const unsigned char* p) { return __builtin_bit_cast(s16x4, __builtin_amdgcn_ds_read_tr16_b64_v4i16((LAS v4i16_t*)p)); }
template <int PART, int G> __device__ __forceinline__ void vld16(VF4& f, LAS const unsigned char* vp) {
  f.a0 = vtr(vp + v16_off(4 * G, PART, 0)); f.a1 = vtr(vp + v16_off(4 * G, PART, 1)); f.b0 = vtr(vp + v16_off(4 * G + 1, PART, 0)); f.b1 = vtr(vp + v16_off(4 * G + 1, PART, 1));
  f.c0 = vtr(vp + v16_off(4 * G + 2, PART, 0)); f.c1 = vtr(vp + v16_off(4 * G + 2, PART, 1)); f.d0 = vtr(vp + v16_off(4 * G + 3, PART, 0)); f.d1 = vtr(vp + v16_off(4 * G + 3, PART, 1));
}
template <int PART, int KPART> __device__ __forceinline__ void pvh16(f32x4 (&o)[2][8], LAS const unsigned char* vp, const bf16x8 (&pf)[2], bf16x8 (&kf)[4], LAS const unsigned char* Ks, int li, int g) {
  VF4 f0, f1;
  vld16<PART, 0>(f0, vp); vld16<PART, 1>(f1, vp);
  vmma16<0>(o, f0, pf); vmma16<1>(o, f1, pf);
  kload16<KPART, 0>(kf, Ks, li, g);
  __builtin_amdgcn_sched_group_barrier(0x100, 16, 0); __builtin_amdgcn_sched_group_barrier(0x008, 16, 0); __builtin_amdgcn_sched_group_barrier(0x100, 4, 0);
}
__device__ __forceinline__ void attn16_body(const bf16* __restrict__ Qb, const bf16* __restrict__ Kh, const bf16* __restrict__ Vh, bf16* __restrict__ Ob, int seq, LAS unsigned char* lds) {
  int tid_ = threadIdx.x; asm volatile("" : "+v"(tid_));
  const int tid = tid_, wid = __builtin_amdgcn_readfirstlane(tid >> 6), lane = tid & 63, li = lane & 15, g = lane >> 4;
  LAS unsigned char* V_lds = lds; LAS unsigned char* K_lds = lds + NBUF * SHM_V16;
  LAS float* li_l = (LAS float*)(lds + NBUF * SHM_V16 + NBUF * SHM_K16) + wid * 64;
  float lsum[2] = {0.f, 0.f}; f32x4 o[2][8]; bf16x8 qf[2][4];
#pragma unroll
  for (int qb = 0; qb < 2; ++qb)
#pragma unroll
    for (int db = 0; db < 8; ++db) o[qb][db] = (f32x4){0.f, 0.f, 0.f, 0.f};
#pragma unroll
  for (int qb = 0; qb < 2; ++qb)
#pragma unroll
    for (int ks = 0; ks < 4; ++ks) qf[qb][ks] = *(const GAS bf16x8*)(Qb + (long)(wid * QBLK + 16 * qb + li) * LDQ + 32 * ks + 8 * g);
  const int sr = tid >> 4, sc = (tid & 15) * 8;
  LAS const unsigned char* vp0 = V_lds + (4 * g + (li >> 2)) * V16_LD + (li & 3) * 8;
  bf16x8 vs0, vs1, ks0, ks1;
#define SLOAD(k0) do { vs0 = *(const GAS bf16x8*)(&Vh[(long)((k0) + sr) * LDK + sc]); vs1 = *(const GAS bf16x8*)(&Vh[(long)((k0) + 32 + sr) * LDK + sc]); \
    ks0 = *(const GAS bf16x8*)(&Kh[(long)((k0) + sr) * LDK + sc]); ks1 = *(const GAS bf16x8*)(&Kh[(long)((k0) + 32 + sr) * LDK + sc]); } while (0)
#define SWRITE(b) do { *(LAS bf16x8*)(V_lds + (b) * SHM_V16 + sr * V16_LD + sc * 2) = vs0; *(LAS bf16x8*)(V_lds + (b) * SHM_V16 + (32 + sr) * V16_LD + sc * 2) = vs1; const int kc = sc * 2; \
    *(LAS bf16x8*)(K_lds + (b) * SHM_K16 + KSWZ16(sr, kc)) = ks0; *(LAS bf16x8*)(K_lds + (b) * SHM_K16 + KSWZ16(32 + sr, kc)) = ks1; } while (0)
  H16 S0, S1; bf16x8 pf[2]; const int NT = seq / KVBLK;
  SLOAD(0); SWRITE(0); SLOAD(KVBLK); SWRITE(1); __syncthreads();
  bf16x8 kf[4];
  SBAR(); kload16<0, 0>(kf, K_lds, li, g); qkmma16<0>(S0, kf, K_lds, qf, li, g); kload16<1, 0>(kf, K_lds, li, g); SBAR();
  int bc = 0, bnx = 1, bw = 2;
  for (int j = 0; j < NT; ++j) {
    if (j + 2 < NT) SLOAD((j + 2) * KVBLK);
    SBAR(); qkmma16<1>(S1, kf, K_lds + bc * SHM_K16, qf, li, g); eh16(S0, lsum, pf); QK_SCHED(); SBAR();
    pvh16<0, 0>(o, vp0 + bc * SHM_V16, pf, kf, K_lds + bnx * SHM_K16, li, g); SBAR();
    if (j + 1 < NT) { qkmma16<0>(S0, kf, K_lds + bnx * SHM_K16, qf, li, g); eh16(S1, lsum, pf); QK_SCHED(); } else { eh16(S1, lsum, pf); } SBAR();
    pvh16<1, 1>(o, vp0 + bc * SHM_V16, pf, kf, K_lds + bnx * SHM_K16, li, g); SBAR();
    if (j + 2 < NT) SWRITE(bw);
    __syncthreads();
    { const int t_ = bc; bc = bnx; bnx = bw; bw = t_; }
  }
#pragma unroll
  for (int qb = 0; qb < 2; ++qb) { float v = lsum[qb]; v += __shfl_xor(v, 16); v += __shfl_xor(v, 32); if (g == 0) li_l[16 * qb + li] = v; }
  asm volatile("s_waitcnt lgkmcnt(0)" ::: "memory");
  bf16* Ow = Ob + (long)(wid * QBLK) * LDO;
#pragma unroll
  for (int qb = 0; qb < 2; ++qb)
#pragma unroll
    for (int r = 0; r < 4; ++r) { const int qrow = 16 * qb + 4 * g + r; const float rl = __builtin_amdgcn_rcpf(li_l[qrow]);
#pragma unroll
      for (int db = 0; db < 8; ++db) Ow[(long)qrow * LDO + 16 * db + li] = (bf16)(cvtpk(o[qb][db][r] * rl, 0.f) & 0xffffu); }
  __syncthreads();
#undef SLOAD
#undef SWRITE
}
#undef QK_SCHED
#undef KSWZ16
#undef KSWZ
#undef SBAR
}

constexpr int N_PHASES = 27;
template <int V> struct ICON { static constexpr int value = V; };
#ifndef MK_ONE_LAUNCH
#define MK_ONE_LAUNCH 1
#endif
__global__ void __launch_bounds__(NWAVES * 64, 2) fwd_kernel(Args args) {
    extern __shared__ __attribute__((aligned(16))) unsigned char lds[];
    Frame F;
    F.lds = (LAS unsigned char*)lds;
    F.MISC = (volatile LAS unsigned*)(F.lds + MISC_OFF);
    F.tid = threadIdx.x; F.lane = F.tid & 63; F.wave = __builtin_amdgcn_readfirstlane(F.tid >> 6);
    F.G = gridDim.x; { const int bx = blockIdx.x; F.vcu = (F.G % 8 == 0) ? (bx % 8) * (F.G / 8) + bx / 8 : bx; }
    const int vcu0 = F.vcu; int bidx = (int)blockIdx.x;
    F.ctl = (gu32*)(args.ws + WS_CTL);
    for (int u = F.tid; u < (LDS_BYTES - LDSCTL_OFF) / 4; u += NWAVES * 64) ((LAS unsigned*)(F.lds + LDSCTL_OFF))[u] = 0u;
    __syncthreads();
    const int lo = args.ph_lo, hi = args.ph_hi;
    XcdBarrier bar; bar.bar = (unsigned*)(F.ctl + CW_BAR); bar.x = 0; bar.st = nullptr;
    if (hi - lo > 1) bar = xcd_barrier_post((unsigned*)(F.ctl + CW_BAR), F.MISC + 8);
#if MK_ONE_LAUNCH
#define IN(k) true
#else
#define IN(k) (lo <= (k) && (k) < hi)
#endif
#define SEAM(k) do { if (IN(k) && IN((k) + 1)) { XcdBarrier bb_ = bar; asm volatile("" : "+s"(bb_.x)); unsigned* bp_ = bb_.bar; asm volatile("" : "+s"(bp_)); bb_.bar = bp_; xcd_barrier(bb_); } } while (0)
#define FRESH() do { int t_ = threadIdx.x; asm volatile("" : "+v"(t_)); F.tid = t_; F.lane = t_ & 63; F.wave = __builtin_amdgcn_readfirstlane(t_ >> 6); } while (0)

    const int NGW = F.G * NWAVES;
#define KARG_AS __attribute__((address_space(4)))
#define WSP() const KARG_AS Args* ka_ = (const KARG_AS Args*)__builtin_amdgcn_kernarg_segment_ptr(); asm volatile("" : "+s"(ka_)); unsigned char* ws = ka_->ws; asm volatile("" : "+s"(ws)); \
    { int v_ = vcu0; asm volatile("" : "+s"(v_)); F.vcu = v_; int b_ = (int)blockIdx.x; asm volatile("" : "+s"(b_)); bidx = b_; }
#define WSP0() unsigned char* ws = args.ws; asm volatile("" : "+s"(ws))
    if (IN(0)) { FRESH(); p0_prologue(F, args); }
    SEAM(0);
    if (IN(1)) { FRESH(); p1_modreduce(F, args); }
    SEAM(1);

    auto layer_half = [&](auto LC_, auto HC_) __attribute__((always_inline)) {
        constexpr int l = decltype(LC_)::value, half = decltype(HC_)::value;
        constexpr int pb = 2 + 12 * l; constexpr int last = (l == DEPTH - 1) ? 1 : 0;
        {
            if (half == 1) {
                if (IN(pb + 3)) { FRESH(); WSP(); norm_phase<l == 0>(F, (const float*)nullptr, l == 0 ? ka_->in[2] : (const float*)nullptr, (bf16*)(ws + WS_RES), ka_->in[6] + (size_t)(l * 3 + 1) * DM, (const float*)(ws + WS_MOD) + (size_t)l * 3 * MODW, 1, (bf16*)ka_->out, 0, (const float*)(ws + WS_PART)); }
                SEAM(pb + 3);
                if (IN(pb + 4)) { WSP();
                    pg8::Gemm g{(const bf16*)ka_->out, (const bf16*)(ws + WS_W + (size_t)l * W_LAYER + W_IN), M_ALL, NZ, DM, DM}; pg8::PanelOrder S; S.init(NPAN, NZ / 256, F.G, bidx, 0);
                    pg8::EpiBf16Plain E{(bf16*)(ws + WS_Z), NZ};
                    pg8::gemm_phase<pg8::EpiBf16Plain, pg8::PanelOrder, true, true>(F.lds + RING_OFF, g, S, E);
                }
                SEAM(pb + 4);
                if (IN(pb + 5)) { FRESH(); WSP(); const int gw = F.vcu * NWAVES + F.wave;
                    bf16* Z = (bf16*)(ws + WS_Z); bf16* MIX = (bf16*)(ws + WS_MIX);
                    const float* gw_l = ka_->in[14] + (size_t)l * 2 * 16 * 256; const float* gb_l = ka_->in[15] + (size_t)l * 2 * 256;
                    const float* wsl = ka_->in[17] + (size_t)l * 4 * 128 * 128; const float* bsl = ka_->in[18] + (size_t)l * 4 * 128; const float* gml = ka_->in[19] + (size_t)l * 512;
                    const float* qkg = ka_->in[13] + (size_t)l * 256; const float* rope_c = (const float*)(ws + WS_ROPE);
                    {
                    for (int U = F.vcu; U < NCH * 4; U += F.G) gla_a_unit(F, Z, (bf16*)(ws + WS_QG), (float*)(ws + WS_UT), (float*)(ws + WS_DV), U >> 2, U & 3, gw_l, gb_l);
                    for (int row = gw; row < M_ALL; row += NGW) qknorm_row(Z, row, qkg, rope_c, rope_c + 256 * 32, F.lane);
                    }
                }
                SEAM(pb + 5);
                if (IN(pb + 6)) { FRESH(); WSP(); gla_scan_phase(F, (const float*)(ws + WS_UT), (const float*)(ws + WS_DV), (bf16*)(ws + WS_ST)); }
                SEAM(pb + 6);
                if (IN(pb + 7)) { FRESH(); WSP();
                    bf16* Z = (bf16*)(ws + WS_Z); bf16* MIX = (bf16*)(ws + WS_MIX);
                    float nbl2;
                    { const float* qkg = ka_->in[13] + (size_t)l * 256; float gq = fmaxf(fabsf(qkg[F.lane]), fabsf(qkg[64 + F.lane])), gk = fmaxf(fabsf(qkg[128 + F.lane]), fabsf(qkg[192 + F.lane]));
#pragma unroll
                      for (int o = 1; o < 64; o <<= 1) { gq = fmaxf(gq, __shfl_xor(gq, o)); gk = fmaxf(gk, __shfl_xor(gk, o)); }
                      nbl2 = -11.313708499f * gq * gk * 1.4426950408889634f; nbl2 = __builtin_bit_cast(float, __builtin_amdgcn_readfirstlane(__builtin_bit_cast(int, nbl2))); }
                    { const int nU = last ? 1024 : 1040;
#define ATT_UNITS(FASTP) for (int U = F.vcu; U < nU; U += F.G) { \
                            int b, hq, kvh, seq; size_t row0; \
                            if (U < 1024) { const int i = U >> 8, v = U & 255, grp = v >> 6; b = grp >> 1; kvh = grp & 1; hq = kvh * 4 + i; row0 = (size_t)b * TOKB + CTXL + (size_t)(v & 63) * 256; seq = TOKB; } \
                            else { const int V = U - 1024; b = V >> 3; hq = V & 7; kvh = hq >> 2; row0 = (size_t)b * TOKB; seq = CTXL; } \
                            const size_t kv0 = (size_t)b * TOKB; \
                            if (FASTP) att::attn16_body(Z + row0 * NZ + ZQ + hq * 128, Z + kv0 * NZ + ZK + kvh * 128, Z + kv0 * NZ + ZV + kvh * 128, MIX + row0 * DM + MXA + hq * 128, seq, F.lds + RING_OFF); \
                            else att::attn_dense_body<false>(Z + row0 * NZ + ZQ + hq * 128, Z + kv0 * NZ + ZK + kvh * 128, Z + kv0 * NZ + ZV + kvh * 128, MIX + row0 * DM + MXA + hq * 128, seq, F.lds + RING_OFF); }
                        if (nbl2 >= -100.0f) { ATT_UNITS(true) } else { ATT_UNITS(false) }
#undef ATT_UNITS
                    }
                    FRESH(); const int gw = F.vcu * NWAVES + F.wave;
                    const float* gg = ka_->in[16] + (size_t)l * 512;
                    { unsigned* gcnt = (unsigned*)(ws + WS_CTL + 61440 + 64 * (12 + l)); volatile LAS unsigned* gslot = (volatile LAS unsigned*)(F.lds + MISC_OFF + 1032);
                      (void)gw;
                      unsigned nx_ = 0u; if (threadIdx.x == 0) nx_ = __hip_atomic_fetch_add(gcnt, 1u, __ATOMIC_RELAXED, __HIP_MEMORY_SCOPE_AGENT);
                      for (int it_ = 0;; ++it_) {
                          if (threadIdx.x == 0) gslot[it_ & 1] = nx_;
                          __syncthreads();
                          const unsigned bi = gslot[it_ & 1];
                          if (bi >= (unsigned)(NCH * 2)) break;
                          if (threadIdx.x == 0) nx_ = __hip_atomic_fetch_add(gcnt, 1u, __ATOMIC_RELAXED, __HIP_MEMORY_SCOPE_AGENT);
                          const int w = (int)bi * 8 + F.wave; const int chunk = w >> 4, c = chunk % CHB; if (last && c < 2) continue;
                          gla_c_item(Z, (const bf16*)(ws + WS_QG), (const bf16*)(ws + WS_ST), MIX, chunk, (w >> 2) & 3, w & 3, gg, F.lane); } }
                    { const float* wsl = ka_->in[17] + (size_t)l * 4 * 128 * 128; const float* bsl = ka_->in[18] + (size_t)l * 4 * 128; const float* gml = ka_->in[19] + (size_t)l * 512;
                      unsigned* qb = (unsigned*)(ws + WS_CTL + 61440 + 64 * (14 + l)); volatile LAS unsigned* qs = (volatile LAS unsigned*)(F.lds + MISC_OFF + 1040);
                      __syncthreads();
                      unsigned nx_ = 0u; if (threadIdx.x == 0) nx_ = __hip_atomic_fetch_add(qb, 1u, __ATOMIC_RELAXED, __HIP_MEMORY_SCOPE_AGENT);
                      for (int it_ = 0;; ++it_) {
                          if (threadIdx.x == 0) qs[it_ & 1] = nx_;
                          __syncthreads();
                          const int V = (int)qs[it_ & 1]; if (V >= NCH * 4) break;
                          if (threadIdx.x == 0) nx_ = __hip_atomic_fetch_add(qb, 1u, __ATOMIC_RELAXED, __HIP_MEMORY_SCOPE_AGENT);
                          const int chunk = V >> 2; if (!(last && (chunk % CHB) < 2)) gmlp_unit(F, Z, MIX, chunk, V & 3, wsl, bsl, gml); } }
                }
                SEAM(pb + 7);
                if (IN(pb + 8)) { WSP();
                    pg8::Gemm g{(const bf16*)(ws + WS_MIX), (const bf16*)(ws + WS_W + (size_t)l * W_LAYER + W_OUT), M_ALL, DM, DM, DM}; pg8::PanelOrder S; S.init(NPAN - 2, DM / 256, F.G, bidx, 1);
                    { pg8::EpiResid E{(const float*)nullptr, (float*)nullptr, (bf16*)(ws + WS_RES), (const float*)(ws + WS_MOD) + (size_t)l * 3 * MODW, 5, 1.0f};
                    pg8::gemm_phase<pg8::EpiResid, pg8::PanelOrder, true, true>(F.lds + RING_OFF, g, S, E); }
                    if (!last) {
                        pg8::Gemm gc{(const bf16*)(ws + WS_MIX), (const bf16*)(ws + WS_W + (size_t)l * W_LAYER + W_OUT), M_ALL, DM, DM / CTX_NS, DM}; pg8::CtxSplitOrder Sc; Sc.init(DM / 256, CTX_NS, DM / CTX_NS, F.G, bidx); Sc.dyn = (unsigned*)(ws + WS_CTL + 61440 + 64 * (10 + l)); Sc.slot = (volatile LAS unsigned*)(F.lds + MISC_OFF + 1028);
                        pg8::EpiCtxPartial Ec{(float*)(ws + WS_PART), (const float*)(ws + WS_MOD) + (size_t)l * 3 * MODW, 5, 1.0f};
                        pg8::gemm_phase<pg8::EpiCtxPartial, pg8::CtxSplitOrder, true, true>(F.lds + RING_OFF, gc, Sc, Ec); }
                }
                SEAM(pb + 8);
            }
            const int pf = pb + 9 * half, sub = 2 * half, first = (l == 0 && half == 0) ? 1 : 0, skipc = (last && half == 1) ? 1 : 0;
            if (IN(pf + 0)) { FRESH(); WSP();
                norm_phase(F, first ? ka_->in[0] : (const float*)nullptr, first ? ka_->in[2] : (const float*)nullptr, (bf16*)(ws + WS_RES), ka_->in[6] + (size_t)(l * 3 + sub) * DM, (const float*)(ws + WS_MOD) + (size_t)l * 3 * MODW, sub, (bf16*)ka_->out, skipc,
                           (half == 1 ? !last : l > 0) ? (const float*)(ws + WS_PART) : (const float*)nullptr); }
            SEAM(pf + 0);
            if (IN(pf + 1)) { WSP();
                pg8::Gemm g{(const bf16*)ka_->out, (const bf16*)(ws + WS_W + (size_t)l * W_LAYER + (half ? W_GU2 : W_GU1)), M_ALL, NGU, DM, DM}; pg8::PanelOrder S; S.init(skipc ? NPAN - 2 : NPAN, NGU / 256, F.G, bidx, skipc); S.dyn = (unsigned*)(ws + WS_CTL + 61440 + 64 * (l * 2 + half)); S.slot = (volatile LAS unsigned*)(F.lds + MISC_OFF + 1024);
                pg8::EpiSwiglu E{(bf16*)(ws + WS_H), DFF};
                pg8::gemm_phase<pg8::EpiSwiglu, pg8::PanelOrder, true, true>(F.lds + RING_OFF, g, S, E);
            }
            SEAM(pf + 1);
            if (IN(pf + 2)) { WSP();
                pg8::Gemm g{(const bf16*)(ws + WS_H), (const bf16*)(ws + WS_W + (size_t)l * W_LAYER + (half ? W_D2 : W_D1)), M_ALL, DM, DFF, DFF}; pg8::PanelOrder S; S.init(NPAN - 2, DM / 256, F.G, bidx, 1); S.reverse_rounds();
                { pg8::EpiResid E{first ? ka_->in[0] : (const float*)nullptr, (float*)nullptr, (bf16*)(ws + WS_RES), (const float*)(ws + WS_MOD) + (size_t)l * 3 * MODW, 3 * sub + 2, 0.5f};
                pg8::gemm_phase<pg8::EpiResid, pg8::PanelOrder, true, true>(F.lds + RING_OFF, g, S, E); }
                if (!skipc) {
                    pg8::Gemm gc{(const bf16*)(ws + WS_H), (const bf16*)(ws + WS_W + (size_t)l * W_LAYER + (half ? W_D2 : W_D1)), M_ALL, DM, DFF / CTX_NS, DFF}; pg8::CtxSplitOrder Sc; Sc.init(DM / 256, CTX_NS, DFF / CTX_NS, F.G, bidx); Sc.dyn = (unsigned*)(ws + WS_CTL + 61440 + 64 * (6 + l * 2 + half)); Sc.slot = (volatile LAS unsigned*)(F.lds + MISC_OFF + 1028);
                    pg8::EpiCtxPartial Ec{(float*)(ws + WS_PART), (const float*)(ws + WS_MOD) + (size_t)l * 3 * MODW, 3 * sub + 2, 0.5f};
                    pg8::gemm_phase<pg8::EpiCtxPartial, pg8::CtxSplitOrder, true, true>(F.lds + RING_OFF, gc, Sc, Ec); }
            }
            SEAM(pf + 2);
        }
    };
    static_assert(DEPTH == 2, "the four instantiations below");
    layer_half(ICON<0>{}, ICON<0>{}); layer_half(ICON<0>{}, ICON<1>{}); layer_half(ICON<1>{}, ICON<0>{}); layer_half(ICON<1>{}, ICON<1>{});
    if (IN(26)) { FRESH(); WSP(); final_norm_phase(F, (const bf16*)(ws + WS_RES), ka_->out, ka_->in[20]); }
#undef IN
#undef SEAM
}

extern "C" void kernel_launch(void* const* d_in, const int* in_sizes, int n_in, void* d_out, int out_size, void* d_ws, size_t ws_size, hipStream_t stream) {
    static int grid = 0;
    if (grid == 0) {
        if (n_in != 21 || in_sizes[0] != NB * SEQ * DM || out_size != NB * SEQ * DM || ws_size < WS_END) {
            fprintf(stderr, "kernel_launch: shape mismatch: n_in %d in0 %d out %d ws %zu (need %zu)\n", n_in, n_in > 0 ? in_sizes[0] : -1, out_size, ws_size, (size_t)WS_END); grid = -1; return; }
        int dev = 0, cus = 0, per_cu = 0;
        if (hipGetDevice(&dev) != hipSuccess || hipDeviceGetAttribute(&cus, hipDeviceAttributeMultiprocessorCount, dev) != hipSuccess) { fprintf(stderr, "kernel_launch: device query failed\n"); grid = -1; return; }
        if (hipFuncSetAttribute((const void*)fwd_kernel, hipFuncAttributeMaxDynamicSharedMemorySize, LDS_BYTES) != hipSuccess) { fprintf(stderr, "kernel_launch: hipFuncSetAttribute failed\n"); grid = -1; return; }
        if (hipOccupancyMaxActiveBlocksPerMultiprocessor(&per_cu, (const void*)fwd_kernel, NWAVES * 64, LDS_BYTES) != hipSuccess || per_cu < 1)
            fprintf(stderr, "kernel_launch: note: occupancy query reports %d workgroups per CU\n", per_cu);
        (void)hipGetLastError();
        grid = cus;
    }
    if (grid < 0) return;
    if (hipMemsetAsync((char*)d_ws + WS_CTL, 0, CTL_ZERO_BYTES, stream) != hipSuccess) { fprintf(stderr, "kernel_launch: memset failed\n"); return; }
    Args a{};
    for (int i = 0; i < 21; ++i) a.in[i] = (const float*)d_in[i];
    a.out = (float*)d_out; a.ws = (unsigned char*)d_ws;
#if MK_ONE_LAUNCH
    a.ph_lo = 0; a.ph_hi = N_PHASES;
    hipLaunchKernelGGL(fwd_kernel, dim3(grid), dim3(NWAVES * 64), LDS_BYTES, stream, a);
#else
    for (int p = 0; p < N_PHASES; ++p) { a.ph_lo = p; a.ph_hi = p + 1; hipLaunchKernelGGL(fwd_kernel, dim3(grid), dim3(NWAVES * 64), LDS_BYTES, stream, a); }
#endif
    const hipError_t le = hipPeekAtLastError();
    if (le != hipSuccess) fprintf(stderr, "kernel_launch: launch failed: %s\n", hipGetErrorName(le));
}
```
